# Optimizing an MI355X kernel written in HIP

```python
import math
import jax, jax.numpy as jnp
from jax import lax
import numpy as np

D_MODEL = 1024
BATCH = 4
SEQ = 8192
DEPTH = 1

HEAD_DIM = D_MODEL // 16
N_HEADS_SGU = 8
N_HEADS_FOX = 8
D_SGU = N_HEADS_SGU * HEAD_DIM
D_FOX = N_HEADS_FOX * HEAD_DIM
D_MIX = D_SGU + D_FOX
D_IN_PROJ = 2 * D_SGU + 3 * D_FOX + N_HEADS_FOX
CHUNK = 128
Q_BLOCK = 128
N_GROUPS = 4
EXPERTS_PER_GROUP = 4
N_EXPERTS = N_GROUPS * EXPERTS_PER_GROUP
TOP_K_INNER = 2
D_EXPERT = D_MODEL // 2
N_ADA = 6
EPS = 1e-6

kernel_name = "hybrid_sgu_fox_hmoe_adaln"


def rms_norm(x, g):
    xf = x.astype(jnp.float32)
    y = xf * lax.rsqrt(jnp.mean(xf * xf, axis=-1, keepdims=True) + EPS)
    return (y * g.astype(jnp.float32)).astype(x.dtype)


def sgu_mixer(u, v, g_sgu, w_spatial, b_spatial):
    B, S, _ = u.shape
    u = jax.nn.gelu(u)
    v = jax.nn.gelu(v).reshape(B, S // CHUNK, CHUNK, N_HEADS_SGU, HEAD_DIM)
    v = rms_norm(v, g_sgu.reshape(N_HEADS_SGU, HEAD_DIM))
    mask = jnp.tril(jnp.ones((CHUNK, CHUNK), dtype=bool))
    ws = jnp.where(mask[None], w_spatial, jnp.zeros((), w_spatial.dtype)).astype(v.dtype)
    z = jnp.einsum('hts,bnshd->bnthd', ws, v) + b_spatial.T[None, None, :, :, None].astype(v.dtype)
    return u * z.reshape(B, S, D_SGU)


def fox_attention(q, k, v, f_logit, b_forget):
    B, S, H, hd = q.shape
    log_f = jax.nn.log_sigmoid(f_logit.astype(jnp.float32) + b_forget.astype(jnp.float32))
    F = jnp.cumsum(log_f, axis=1).transpose(0, 2, 1)
    q = q.transpose(0, 2, 1, 3)
    k = k.transpose(0, 2, 1, 3)
    v = v.transpose(0, 2, 1, 3)
    scale = 1.0 / math.sqrt(hd)
    kpos = jnp.arange(S)

    def block(i):
        start = i * Q_BLOCK
        qi = lax.dynamic_slice_in_dim(q, start, Q_BLOCK, axis=2)
        Fi = lax.dynamic_slice_in_dim(F, start, Q_BLOCK, axis=2)
        s = jnp.einsum('bhqd,bhkd->bhqk', qi, k, preferred_element_type=jnp.float32) * scale
        s = s + Fi[..., :, None] - F[..., None, :]
        qpos = start + jnp.arange(Q_BLOCK)
        s = jnp.where(kpos[None, :] <= qpos[:, None], s, -jnp.inf)
        p = jax.nn.softmax(s, axis=-1).astype(v.dtype)
        return jnp.einsum('bhqk,bhkd->bhqd', p, v)

    out = lax.map(block, jnp.arange(S // Q_BLOCK))
    return out.transpose(1, 0, 3, 2, 4).reshape(B, S, H, hd)


def hybrid_mixer(h, w_in, g_sgu, w_spatial, b_spatial, b_forget, g_out_sgu, g_out_fox, w_out):
    B, S, _ = h.shape
    proj = h @ w_in
    splits = np.cumsum([D_SGU, D_SGU, D_FOX, D_FOX, D_FOX]).tolist()
    u, vs, q, k, vf, fl = jnp.split(proj, splits, axis=-1)
    y_sgu = sgu_mixer(u, vs, g_sgu, w_spatial, b_spatial)
    shp = (B, S, N_HEADS_FOX, HEAD_DIM)
    y_fox = fox_attention(q.reshape(shp), k.reshape(shp), vf.reshape(shp), fl, b_forget).reshape(B, S, D_FOX)
    y = jnp.concatenate([rms_norm(y_sgu, g_out_sgu), rms_norm(y_fox, g_out_fox)], axis=-1)
    return y @ w_out


def hier_moe(h, w_rg, b_rg, w_re, b_re, w_gate, w_up, w_down):
    B, S, D = h.shape
    t = h.reshape(-1, D)
    lg = (t @ w_rg + b_rg).astype(jnp.float32)
    p_group = jax.nn.softmax(lg, axis=-1)
    g_sel = jnp.argmax(lg, axis=-1)
    p_sel = jnp.take_along_axis(p_group, g_sel[:, None], axis=1)
    le = (jnp.einsum('nd,gde->nge', t, w_re) + b_re).astype(jnp.float32)
    le_sel = jnp.take_along_axis(le, g_sel[:, None, None], axis=1)[:, 0]
    top_v, top_i = lax.top_k(le_sel, TOP_K_INNER)
    w_k = p_sel * jax.nn.softmax(top_v, axis=-1)
    expert_idx = g_sel[:, None] * EXPERTS_PER_GROUP + top_i
    combine = jnp.sum(jax.nn.one_hot(expert_idx, N_EXPERTS, dtype=jnp.float32) * w_k[..., None],
                      axis=1).astype(h.dtype)
    y = jnp.zeros_like(t)
    for e in range(N_EXPERTS):
        a = jax.nn.silu(t @ w_gate[e]) * (t @ w_up[e])
        y = y + combine[:, e:e + 1] * (a @ w_down[e])
    return y.reshape(B, S, D)


def setup_inputs(seed: int = 0) -> dict:
    key = jax.random.key(seed)
    ks = jax.random.split(key, 24)
    n = lambda k, shape, s: jax.random.normal(k, shape, jnp.float32) * s
    L = DEPTH
    return {
        "x": n(ks[0], (BATCH, SEQ, D_MODEL), 1.0),
        "c": n(ks[1], (BATCH, D_MODEL), 1.0),
        "w_ada": n(ks[2], (L, D_MODEL, N_ADA * D_MODEL), 0.02),
        "b_ada": n(ks[3], (L, N_ADA * D_MODEL), 0.02),
        "g_norm_mix": 1.0 + n(ks[4], (L, D_MODEL), 0.02),
        "w_in": n(ks[5], (L, D_MODEL, D_IN_PROJ), D_MODEL ** -0.5),
        "g_sgu": 1.0 + n(ks[6], (L, D_SGU), 0.02),
        "w_spatial": n(ks[7], (L, N_HEADS_SGU, CHUNK, CHUNK), 0.5 * CHUNK ** -0.5),
        "b_spatial": 1.0 + n(ks[8], (L, N_HEADS_SGU, CHUNK), 0.1),
        "b_forget": 3.0 + n(ks[9], (L, N_HEADS_FOX), 0.1),
        "g_out_sgu": 1.0 + n(ks[10], (L, D_SGU), 0.02),
        "g_out_fox": 1.0 + n(ks[11], (L, D_FOX), 0.02),
        "w_out": n(ks[12], (L, D_MIX, D_MODEL), D_MIX ** -0.5),
        "g_norm_ffn": 1.0 + n(ks[13], (L, D_MODEL), 0.02),
        "w_router_group": n(ks[14], (L, D_MODEL, N_GROUPS), D_MODEL ** -0.5),
        "b_router_group": n(ks[15], (L, N_GROUPS), 0.01),
        "w_router_expert": n(ks[16], (L, N_GROUPS, D_MODEL, EXPERTS_PER_GROUP), D_MODEL ** -0.5),
        "b_router_expert": n(ks[17], (L, N_GROUPS, EXPERTS_PER_GROUP), 0.01),
        "w_gate": n(ks[18], (L, N_EXPERTS, D_MODEL, D_EXPERT), D_MODEL ** -0.5),
        "w_up": n(ks[19], (L, N_EXPERTS, D_MODEL, D_EXPERT), D_MODEL ** -0.5),
        "w_down": n(ks[20], (L, N_EXPERTS, D_EXPERT, D_MODEL), D_EXPERT ** -0.5),
        "g_final": 1.0 + n(ks[21], (D_MODEL,), 0.02),
    }


def reference(x, c, w_ada, b_ada, g_norm_mix, w_in, g_sgu, w_spatial, b_spatial, b_forget,
              g_out_sgu, g_out_fox, w_out, g_norm_ffn, w_router_group, b_router_group,
              w_router_expert, b_router_expert, w_gate, w_up, w_down, g_final):
    c_act = jax.nn.silu(c)
    for l in range(DEPTH):
        ada = (c_act @ w_ada[l] + b_ada[l])[:, None, :]
        sh1, sc1, gt1, sh2, sc2, gt2 = jnp.split(ada, N_ADA, axis=-1)
        h = rms_norm(x, g_norm_mix[l]) * (1 + sc1) + sh1
        x = x + gt1 * hybrid_mixer(h, w_in[l], g_sgu[l], w_spatial[l], b_spatial[l], b_forget[l],
                                   g_out_sgu[l], g_out_fox[l], w_out[l])
        h = rms_norm(x, g_norm_ffn[l]) * (1 + sc2) + sh2
        x = x + gt2 * hier_moe(h, w_router_group[l], b_router_group[l], w_router_expert[l],
                               b_router_expert[l], w_gate[l], w_up[l], w_down[l])
    return rms_norm(x, g_final)
```

```cpp
#include <hip/hip_runtime.h>
#include <hip/hip_bf16.h>
#include <cstdio>
#include <cstdint>
#include <cmath>

#ifndef MK_N_LAUNCHES
#define MK_N_LAUNCHES 11
#endif
#ifndef NAIVE_ATTN
#define NAIVE_ATTN 1
#endif

constexpr int BATCH = 4, T = 8192, D = 1024, NH = 8, HD = 64, DH = 512;
constexpr int M = BATCH * T;
constexpr int NPROJ = 2560;
constexpr int LDW_IN = 2568;
constexpr int NADA = 6 * D;
constexpr int NEXP = 16, DEXP = 512, NCLS = 24;
constexpr int MAXTILES = 152;
constexpr float EPS = 1e-6f;
constexpr float C2 = 0.125f * 1.4426950408889634f;
constexpr float LOG2E = 1.4426950408889634f;

namespace pg8 {
#define PG8_LAS __attribute__((address_space(3)))
typedef unsigned short bf16_t;
typedef short bf16x8 __attribute__((ext_vector_type(8)));
typedef float f32x4 __attribute__((ext_vector_type(4)));
typedef unsigned u32x4 __attribute__((ext_vector_type(4)));
constexpr int BM = 256, BK = 64, HALF = 128, HTB = HALF * BK * 2  , STAGE_BYTES = 8 * HTB, NXCD = 8, WGM = 8;

__host__ __device__ __forceinline__ int lds_byte(int r, int c) { const int st = (r >> 4) * 2 + (c >> 5), rr = r & 15, cc = c & 31, ob = rr * 64 + cc * 2; return st * 1024 + (ob ^ (((ob >> 9) & 1) << 5)); }
__host__ __device__ __forceinline__ void stage_rc(int b, int& R, int& C) { const int st = b / 1024, sb = b % 1024, swz = sb ^ (((sb >> 9) & 1) << 5); R = (st >> 1) * 16 + swz / 64; C = (st & 1) * 32 + (swz % 64) / 2; }
__host__ __device__ __forceinline__ int perm32(int rho) { const int n = rho >> 4, i = rho & 15; return 8 * (i >> 2) + 4 * n + (i & 3); }

struct Unit { int pm, pn, aux; };
struct Gemm { const bf16_t* A; const bf16_t* Bt; int M, N, K; };

struct StaticOrder {
    int nM, nN, nwg, G, c;
    __host__ __device__ void init(int M, int N, int G_, int c_) { nM = M / BM; nN = N / BM; nwg = nM * nN; G = G_; c = c_; }
    __host__ __device__ bool next(int i, Unit& u) const {
        const long L = (long)i * G + c; if (L >= nwg) return false;
        int wgid = (int)L; { const int q = nwg / NXCD, r = nwg % NXCD, xcd = wgid % NXCD, off = wgid / NXCD; wgid = (xcd < r ? xcd * (q + 1) : r * (q + 1) + (xcd - r) * q) + off; }
        const int nig = WGM * nN, gid = wgid / nig, fm = gid * WGM, gsz = (nM - fm) < WGM ? (nM - fm) : WGM;
        u.pm = fm + ((wgid % nig) % gsz); u.pn = (wgid % nig) / gsz; u.aux = 0; return true;
    }
    __device__ __forceinline__ void a_ready(const Unit&) const {}
    __device__ __forceinline__ void done(const Unit&) const {}
};


__device__ __forceinline__ unsigned cvt_pk_bf16(float lo, float hi) { unsigned r; asm volatile("v_cvt_pk_bf16_f32 %0, %1, %2" : "=v"(r) : "v"(lo), "v"(hi)); return r; }
__device__ __forceinline__ float gelu_tanh(float v) {
    const float u = v * (1.5957691216057308f + 0.0713548162726f * v * v);
    return v * __builtin_amdgcn_rcpf(1.0f + __builtin_amdgcn_exp2f(-1.4426950408889634f * u));
}
__device__ __forceinline__ float silu_f(float v) { return v * __builtin_amdgcn_rcpf(1.0f + __builtin_amdgcn_exp2f(-1.4426950408889634f * v)); }

struct EpiProj {
    static constexpr bool PERM = true, AFTER_DRAIN = false;
    bf16_t* O;
    __device__ __forceinline__ void operator()(const f32x4 (&acc)[2][2][4][2], const Unit& u, int wr, int wc, int fr, int fq) const {
        const int row0 = u.pm * BM + wr * 64 + fr; const int seg = u.pn >> 1;
        bf16_t* base = O + (size_t)seg * ((size_t)M * 512);
        const int col0 = (u.pn & 1) * 256 + wc * 32 + 8 * fq;
#pragma unroll
        for (int ai = 0; ai < 2; ++ai)
#pragma unroll
            for (int m = 0; m < 4; ++m) { bf16_t* rowp = base + (size_t)(row0 + ai * HALF + m * 16) * 512 + col0;
#pragma unroll
                for (int bj = 0; bj < 2; ++bj) { f32x4 v0 = acc[ai][bj][m][0], v1 = acc[ai][bj][m][1];
                    if (seg < 2) {
#pragma unroll
                        for (int j = 0; j < 4; ++j) { v0[j] = gelu_tanh(v0[j]); v1[j] = gelu_tanh(v1[j]); }
                    } else if (seg == 2) { v0 = v0 * C2; v1 = v1 * C2; }
                    u32x4 w; w.x = cvt_pk_bf16(v0[0], v0[1]); w.y = cvt_pk_bf16(v0[2], v0[3]); w.z = cvt_pk_bf16(v1[0], v1[1]); w.w = cvt_pk_bf16(v1[2], v1[3]);
                    *(u32x4*)(rowp + bj * HALF) = w; } }
    }
};
struct EpiOut {
    static constexpr bool PERM = false, AFTER_DRAIN = false;
    const float* x; float* out; const float* gt; float* ssq;
    __device__ __forceinline__ void operator()(const f32x4 (&acc)[2][2][4][2], const Unit& u, int wr, int wc, int fr, int fq) const {
        const int b = (u.pm * BM) / T; const int col0 = u.pn * BM + wc * 32 + 4 * fq;
        f32x4 gv[2][2];
#pragma unroll
        for (int bj = 0; bj < 2; ++bj)
#pragma unroll
            for (int n = 0; n < 2; ++n) gv[bj][n] = *(const f32x4*)(gt + (size_t)b * NADA + col0 + bj * HALF + n * 16);
#pragma unroll
        for (int ai = 0; ai < 2; ++ai)
#pragma unroll
            for (int m = 0; m < 4; ++m) { const int r = u.pm * BM + ai * HALF + wr * 64 + m * 16 + fr; const size_t off = (size_t)r * D + col0; float s = 0.f;
#pragma unroll
                for (int bj = 0; bj < 2; ++bj)
#pragma unroll
                    for (int n = 0; n < 2; ++n) { const f32x4 xv = *(const f32x4*)(x + off + bj * HALF + n * 16); const f32x4 o = xv + gv[bj][n] * acc[ai][bj][m][n];
                        *(f32x4*)(out + off + bj * HALF + n * 16) = o; s += (o[0] * o[0] + o[1] * o[1]) + (o[2] * o[2] + o[3] * o[3]); }
                s += __shfl_xor(s, 16); s += __shfl_xor(s, 32);
                if (fq == 0) ssq[(size_t)r * 16 + u.pn * 4 + wc] = s;
                if (m & 1) asm volatile("" ::: "memory"); }
    }
};
struct EpiUp {
    static constexpr bool PERM = true, AFTER_DRAIN = false;
    bf16_t* ACT; const float* SW;
    __device__ __forceinline__ void operator()(const f32x4 (&acc)[2][2][4][2], const Unit& u, int wr, int wc, int fr, int fq) const {
        const int s = u.aux >> 2, t = u.aux & 3; const int col0 = s * 512 + t * 128 + wc * 32 + 8 * fq;
#pragma unroll
        for (int ai = 0; ai < 2; ++ai)
#pragma unroll
            for (int m = 0; m < 4; ++m) { const int r = u.pm * BM + ai * HALF + wr * 64 + m * 16 + fr; const float w = SW[(size_t)r * 2 + s];
                float a[8];
#pragma unroll
                for (int n = 0; n < 2; ++n)
#pragma unroll
                    for (int j = 0; j < 4; ++j) a[n * 4 + j] = silu_f(acc[ai][0][m][n][j]) * acc[ai][1][m][n][j] * w;
                u32x4 o; o.x = cvt_pk_bf16(a[0], a[1]); o.y = cvt_pk_bf16(a[2], a[3]); o.z = cvt_pk_bf16(a[4], a[5]); o.w = cvt_pk_bf16(a[6], a[7]);
                *(u32x4*)(ACT + (size_t)r * D + col0) = o; }
    }
};
struct EpiDown {
    static constexpr bool PERM = false, AFTER_DRAIN = false;
    float* out; const float* gt; const int* TOK; float* ssq;
    __device__ __forceinline__ void operator()(const f32x4 (&acc)[2][2][4][2], const Unit& u, int wr, int wc, int fr, int fq) const {
        const int nt = u.aux; const int col0 = nt * BM + wc * 32 + 4 * fq;
#pragma unroll
        for (int ai = 0; ai < 2; ++ai)
#pragma unroll
            for (int m = 0; m < 4; ++m) { const int slot = u.pm * BM + ai * HALF + wr * 64 + m * 16 + fr; const int tok = TOK[slot]; float s = 0.f;
                if (tok >= 0) { const int b = tok / T; const size_t off = (size_t)tok * D + col0;
#pragma unroll
                    for (int bj = 0; bj < 2; ++bj)
#pragma unroll
                        for (int n = 0; n < 2; ++n) { const f32x4 g = *(const f32x4*)(gt + (size_t)b * NADA + col0 + bj * HALF + n * 16);
                            const f32x4 xv = *(const f32x4*)(out + off + bj * HALF + n * 16); const f32x4 o = xv + g * acc[ai][bj][m][n];
                            *(f32x4*)(out + off + bj * HALF + n * 16) = o; s += (o[0] * o[0] + o[1] * o[1]) + (o[2] * o[2] + o[3] * o[3]); } }
                s += __shfl_xor(s, 16); s += __shfl_xor(s, 32);
                if (fq == 0 && tok >= 0) ssq[(size_t)tok * 16 + nt * 4 + wc] = s;
                if (m & 1) asm volatile("" ::: "memory"); }
    }
};
__device__ __forceinline__ int cls_expert(int cls, int s) { const int g = cls / 6, p = cls % 6; const int a = p < 3 ? 0 : (p < 5 ? 1 : 2); const int b = p < 3 ? p + 1 : (p < 5 ? p - 1 : 3); return g * 4 + (s ? b : a); }
struct MoeUpOrder {
    int G, c, NT; const PG8_LAS unsigned char* tcls;
    __device__ __forceinline__ bool next(int i, Unit& u) const {
        const int x = c & 7, j = (c >> 3) + (G >> 3) * i; const int pm = 8 * (j >> 3) + x; if (pm >= NT) return false;
        const int st = j & 7; u.pm = pm; u.aux = st; u.pn = cls_expert((int)tcls[pm], st >> 2) * 4 + (st & 3); return true;
    }
    __device__ __forceinline__ void a_ready(const Unit&) const {}
    __device__ __forceinline__ void done(const Unit&) const {}
};
struct MoeDownOrder {
    int G, c, NT; const PG8_LAS unsigned char* tcls;
    __device__ __forceinline__ bool next(int i, Unit& u) const {
        const int x = c & 7, j = (c >> 3) + (G >> 3) * i; const int pm = 8 * (j >> 2) + x; if (pm >= NT) return false;
        const int nt = j & 3; u.pm = pm; u.aux = nt; u.pn = (int)tcls[pm] * 4 + nt; return true;
    }
    __device__ __forceinline__ void a_ready(const Unit&) const {}
    __device__ __forceinline__ void done(const Unit&) const {}
};

template <class Epi, class Sched, bool ALIGN_EPI = false, bool SP2 = false>
__device__ __forceinline__ void gemm_phase(PG8_LAS unsigned char* lds, const Gemm g, const Sched& S, const Epi& E) {
    const int tid = threadIdx.x, wid = __builtin_amdgcn_readfirstlane(tid >> 6), lane = tid & 63, wr = wid >> 2, wc = wid & 3, fr = lane & 15, fq = lane >> 4;
    const int K = g.K, nt = K / BK;
    unsigned voffA[2], voffB[2];
#pragma unroll
    for (int i = 0; i < 2; ++i) { int R, C; stage_rc(tid * 16 + i * 8192, R, C); const int Rb = Epi::PERM ? ((R & ~31) + perm32(R & 31)) : R;
        voffA[i] = (unsigned)(R * K + C) * 2u; voffB[i] = (unsigned)(Rb * K + C) * 2u; }
    const size_t kstep = (size_t)(BK * 2);
    const size_t hstep = (size_t)HALF * K * 2;
    const size_t tstep = 2 * hstep;
    const unsigned ldsw = (unsigned)wid * 1024u;
    const int aoff = lds_byte(wr * 64 + fr, fq * 8), boff = lds_byte(wc * 32 + fr, fq * 8);
#define PG8_SA(b, h) (((b) * 2 + (h)) * HTB)
#define PG8_SB(b, h) ((4 + (b) * 2 + (h)) * HTB)
#define PG8_STAGE(bufoff, gbase, voff) do { _Pragma("unroll") for (int _i = 0; _i < 2; ++_i) \
        __builtin_amdgcn_global_load_lds((const unsigned*)((const char*)(gbase) + (voff)[_i]), (PG8_LAS unsigned*)(lds + (bufoff) + ldsw + _i * 8192), 16, 0, 0); } while (0)
#define PG8_LDA(dst, b, h) do { _Pragma("unroll") for (int m = 0; m < 4; ++m) _Pragma("unroll") for (int k = 0; k < 2; ++k) dst[m][k] = *(const PG8_LAS bf16x8*)(lds + PG8_SA(b, h) + aoff + m * 2048 + k * 1024); } while (0)
#define PG8_LDB(dst, b, h) do { _Pragma("unroll") for (int n = 0; n < 2; ++n) _Pragma("unroll") for (int k = 0; k < 2; ++k) dst[n][k] = *(const PG8_LAS bf16x8*)(lds + PG8_SB(b, h) + boff + n * 2048 + k * 1024); } while (0)
#define PG8_MMA(ai, bj, At, Bt) do { __builtin_amdgcn_s_setprio(1); _Pragma("unroll") for (int m = 0; m < 4; ++m) _Pragma("unroll") for (int n = 0; n < 2; ++n) _Pragma("unroll") for (int k = 0; k < 2; ++k) \
        acc[ai][bj][m][n] = __builtin_amdgcn_mfma_f32_16x16x32_bf16(Bt[n][k], At[m][k], acc[ai][bj][m][n], 0, 0, 0); __builtin_amdgcn_s_setprio(0); } while (0)
#define PG8_WAIT_V(n) asm volatile("s_waitcnt vmcnt(" #n ")" ::: "memory")
#define PG8_WAIT_L(n) asm volatile("s_waitcnt lgkmcnt(" #n ")" ::: "memory")
#define PG8_BAR __builtin_amdgcn_s_barrier()
#define PG8_SCHED __builtin_amdgcn_sched_barrier(0)
    Unit cur, nxt; int ui = 0;
    if (!S.next(0, cur)) return;
    f32x4 acc[2][2][4][2];
#pragma unroll
    for (int a = 0; a < 2; ++a)
#pragma unroll
        for (int b = 0; b < 2; ++b)
#pragma unroll
            for (int m = 0; m < 4; ++m)
#pragma unroll
                for (int n = 0; n < 2; ++n) acc[a][b][m][n] = (f32x4){0.f, 0.f, 0.f, 0.f};
    bf16x8 At[4][2], B0[2][2], B1[2][2];
    const char* cA = (const char*)g.A + (size_t)cur.pm * tstep; const char* cB = (const char*)g.Bt + (size_t)cur.pn * tstep;
    S.a_ready(cur);
    if constexpr (SP2) {
        PG8_STAGE(PG8_SB(0, 0), cB, voffB); PG8_STAGE(PG8_SB(0, 1), cB + hstep, voffB); PG8_STAGE(PG8_SA(0, 0), cA, voffA); PG8_STAGE(PG8_SA(0, 1), cA + hstep, voffA);
        if (wr == 1) PG8_BAR;
        PG8_WAIT_V(2); PG8_BAR;
        PG8_STAGE(PG8_SB(1, 0), cB + kstep, voffB); PG8_STAGE(PG8_SA(1, 0), cA + kstep, voffA); PG8_STAGE(PG8_SB(1, 1), cB + hstep + kstep, voffB);
        PG8_WAIT_V(6); PG8_BAR;
    } else {
        PG8_STAGE(PG8_SB(0, 0), cB, voffB); PG8_STAGE(PG8_SA(0, 0), cA, voffA); PG8_STAGE(PG8_SB(0, 1), cB + hstep, voffB); PG8_STAGE(PG8_SA(0, 1), cA + hstep, voffA);
        if (wr == 1) PG8_BAR;
        PG8_WAIT_V(4); PG8_BAR;
        PG8_STAGE(PG8_SB(1, 0), cB + kstep, voffB); PG8_STAGE(PG8_SA(1, 0), cA + kstep, voffA); PG8_STAGE(PG8_SB(1, 1), cB + hstep + kstep, voffB);
        PG8_WAIT_V(6); PG8_BAR;
    }
    for (;;) {
        const bool has_next = S.next(ui + 1, nxt);
        const char* nA = has_next ? (const char*)g.A + (size_t)nxt.pm * tstep : cA; const char* nB = has_next ? (const char*)g.Bt + (size_t)nxt.pn * tstep : cB;
        for (int t = 0; t < nt; t += 2) {
            const bool last = (t == nt - 2);
            const char* a1 = cA + (size_t)(t + 1) * kstep;
            const char* a2 = last ? nA : cA + (size_t)(t + 2) * kstep; const char* b2 = last ? nB : cB + (size_t)(t + 2) * kstep;
            const char* a3 = a2 + kstep; const char* b3 = b2 + kstep;
            if (last && has_next) S.a_ready(nxt);
            if constexpr (SP2) {
            PG8_LDB(B0, 0, 0); PG8_LDB(B1, 0, 1); PG8_SCHED; PG8_LDA(At, 0, 0); PG8_STAGE(PG8_SA(1, 1), a1 + hstep, voffA);
            PG8_WAIT_V(8); PG8_WAIT_L(0); PG8_BAR; PG8_MMA(0, 0, At, B0); PG8_MMA(0, 1, At, B1); PG8_BAR; PG8_SCHED;
            PG8_LDA(At, 0, 1); PG8_STAGE(PG8_SB(0, 0), b2, voffB); PG8_STAGE(PG8_SB(0, 1), b2 + hstep, voffB); PG8_STAGE(PG8_SA(0, 0), a2, voffA);
            PG8_WAIT_V(8); PG8_WAIT_L(0); PG8_BAR; PG8_MMA(1, 0, At, B0); PG8_MMA(1, 1, At, B1); PG8_BAR; PG8_SCHED;
            PG8_LDB(B0, 1, 0); PG8_LDB(B1, 1, 1); PG8_SCHED; PG8_LDA(At, 1, 0); PG8_STAGE(PG8_SA(0, 1), a2 + hstep, voffA);
            PG8_WAIT_V(8); PG8_WAIT_L(0); PG8_BAR; PG8_MMA(0, 0, At, B0); PG8_MMA(0, 1, At, B1); PG8_BAR; PG8_SCHED;
            PG8_LDA(At, 1, 1); PG8_STAGE(PG8_SB(1, 0), b3, voffB); PG8_STAGE(PG8_SB(1, 1), b3 + hstep, voffB); PG8_STAGE(PG8_SA(1, 0), a3, voffA);
            PG8_WAIT_V(8); PG8_WAIT_L(0); PG8_BAR; PG8_MMA(1, 0, At, B0); PG8_MMA(1, 1, At, B1); PG8_BAR; PG8_SCHED;
            } else {
            PG8_LDB(B0, 0, 0); PG8_SCHED; PG8_LDA(At, 0, 0); PG8_STAGE(PG8_SA(1, 1), a1 + hstep, voffA);
            PG8_WAIT_L(8); PG8_BAR; PG8_WAIT_L(0); PG8_MMA(0, 0, At, B0); PG8_BAR; PG8_SCHED;
            PG8_LDB(B1, 0, 1); PG8_STAGE(PG8_SB(0, 0), b2, voffB);
            PG8_BAR; PG8_WAIT_L(0); PG8_MMA(0, 1, At, B1); PG8_BAR;
            PG8_LDA(At, 0, 1); PG8_STAGE(PG8_SA(0, 0), a2, voffA);
            PG8_BAR; PG8_WAIT_L(0); PG8_MMA(1, 0, At, B0); PG8_BAR; PG8_SCHED;
            PG8_STAGE(PG8_SB(0, 1), b2 + hstep, voffB);
            PG8_WAIT_V(6); PG8_BAR; PG8_MMA(1, 1, At, B1); PG8_BAR;
            PG8_LDB(B0, 1, 0); PG8_SCHED; PG8_LDA(At, 1, 0); PG8_STAGE(PG8_SA(0, 1), a2 + hstep, voffA);
            PG8_WAIT_L(8); PG8_BAR; PG8_WAIT_L(0); PG8_MMA(0, 0, At, B0); PG8_BAR; PG8_SCHED;
            PG8_LDB(B1, 1, 1); PG8_STAGE(PG8_SB(1, 0), b3, voffB);
            PG8_BAR; PG8_WAIT_L(0); PG8_MMA(0, 1, At, B1); PG8_BAR;
            PG8_LDA(At, 1, 1); PG8_STAGE(PG8_SA(1, 0), a3, voffA);
            PG8_BAR; PG8_WAIT_L(0); PG8_MMA(1, 0, At, B0); PG8_BAR; PG8_SCHED;
            PG8_STAGE(PG8_SB(1, 1), b3 + hstep, voffB);
            PG8_WAIT_V(6); PG8_BAR; PG8_MMA(1, 1, At, B1); PG8_BAR;
            }
        }
        if constexpr (ALIGN_EPI) { if (wr == 0) PG8_BAR; }
        if constexpr (!Epi::AFTER_DRAIN) { E(acc, cur, wr, wc, fr, fq); S.done(cur); }
        if (!has_next) break;
#pragma unroll
        for (int a = 0; a < 2; ++a)
#pragma unroll
            for (int b = 0; b < 2; ++b)
#pragma unroll
                for (int m = 0; m < 4; ++m)
#pragma unroll
                    for (int n = 0; n < 2; ++n) acc[a][b][m][n] = (f32x4){0.f, 0.f, 0.f, 0.f};
        cur = nxt; cA = nA; cB = nB; ++ui;
        if constexpr (ALIGN_EPI) { if (wr == 1) PG8_BAR; }
    }
    PG8_WAIT_V(0);
    if constexpr (!ALIGN_EPI) { if (wr == 0) PG8_BAR; }
    PG8_BAR;
    if constexpr (Epi::AFTER_DRAIN) { E.fused(acc, cur, wr, wc, fr, fq, lds, wid, lane); S.done(cur); }
#undef PG8_SA
#undef PG8_SB
#undef PG8_STAGE
#undef PG8_LDA
#undef PG8_LDB
#undef PG8_MMA
#undef PG8_WAIT_V
#undef PG8_WAIT_L
#undef PG8_BAR
#undef PG8_SCHED
}
}

constexpr int NWAVES = 8;
constexpr int N_PHASES = 11;
constexpr int N_LAUNCHES = MK_N_LAUNCHES;

constexpr size_t MiB = 1u << 20;
constexpr size_t WS_CTL = 0, CTL_ZERO_BYTES = 64 * 1024;
constexpr size_t WS_ADAP = 1 * MiB;
constexpr size_t WS_ADA = 2 * MiB;
constexpr size_t WS_WSM = WS_ADA + 128 * 1024;
constexpr size_t WS_LC = 3 * MiB;
constexpr size_t WS_CT = 4 * MiB;
constexpr size_t WS_TOKC = WS_CT + 64 * 1024;
constexpr size_t WS_TW = WS_TOKC + 256 * 1024;
constexpr size_t WS_SSQY = 5 * MiB;
constexpr size_t WS_SSQ1 = 7 * MiB;
constexpr size_t WS_SSQ2 = 9 * MiB;
constexpr size_t WS_INV = 11 * MiB;
constexpr size_t WS_TOK = 14 * MiB;
constexpr size_t WS_SW = WS_TOK + 256 * 1024;
constexpr size_t WS_WIN = 16 * MiB;
constexpr size_t WS_WOUT = 22 * MiB;
constexpr size_t WS_WGU = 24 * MiB;
constexpr size_t WS_WDC = 56 * MiB;
constexpr size_t WS_XN = 104 * MiB;
constexpr size_t WS_U = 168 * MiB;
constexpr size_t WS_Y = 328 * MiB;
constexpr size_t WS_H2 = WS_XN;
constexpr size_t WS_H2S = 168 * MiB;
constexpr size_t WS_ACT = 244 * MiB;
constexpr size_t WS_END = 392 * MiB;
static_assert(WS_ACT + (size_t)MAXTILES * 256 * 1024 * 2 <= WS_Y && WS_H2S + (size_t)MAXTILES * 256 * 1024 * 2 <= WS_ACT, "d_ws map");
constexpr int CW_TMO = 0, CW_CODE = 1;
constexpr int CW_CNT = 64;
constexpr int CW_BAR = 4096;
constexpr int RING_OFF = 0, RING_BYTES = 131072;
constexpr int LDSCTL_OFF = RING_BYTES, MISC_OFF = LDSCTL_OFF + 320;
constexpr int TCLS_OFF = LDSCTL_OFF + 512;
constexpr int TFIRST_OFF = LDSCTL_OFF + 704;
constexpr int LDS_BYTES = 147456;

#define GAS __attribute__((address_space(1)))
#define LAS __attribute__((address_space(3)))
typedef unsigned short bf16;
typedef unsigned v4u __attribute__((ext_vector_type(4)));
typedef float f32x4 __attribute__((ext_vector_type(4)));
typedef short bf16x8 __attribute__((ext_vector_type(8)));
typedef GAS unsigned gu32;
typedef GAS unsigned long long gu64;
#define RLX_AGENT __ATOMIC_RELAXED, __HIP_MEMORY_SCOPE_AGENT
#define LDS_WAIT() asm volatile("s_waitcnt lgkmcnt(0)" ::: "memory")
#define VM_WAIT() asm volatile("s_waitcnt vmcnt(0)" ::: "memory")
__device__ __forceinline__ unsigned long long rt() { return __builtin_amdgcn_s_memrealtime(); }
__device__ __forceinline__ unsigned f2bf(float f) { unsigned u = __builtin_bit_cast(unsigned, f); return (u + 0x7fffu + ((u >> 16) & 1u)) >> 16; }
__device__ __forceinline__ unsigned pk2(float lo, float hi) { return f2bf(lo) | (f2bf(hi) << 16); }

#define XB_TMO      128
#define XB_XCNT(j)  (256  + 64 * (j))
#define XB_XSUB(j)  (1280 + 64 * (j))
#define XB_XGEN(j)  (2304 + 64 * (j))
#define XB_TOP      3328
#define XB_TOPGEN   3392
#define XCD_BAR_WORDS 3456
#define XB_SPIN_CAP (1u << 18)

__device__ __forceinline__ unsigned xb_ld(unsigned* p)              { return __hip_atomic_load(p, __ATOMIC_RELAXED, __HIP_MEMORY_SCOPE_AGENT); }
__device__ __forceinline__ unsigned xb_add(unsigned* p, unsigned v) { return __hip_atomic_fetch_add(p, v, __ATOMIC_RELAXED, __HIP_MEMORY_SCOPE_AGENT); }
__device__ __forceinline__ unsigned xb_xcc_id() { return (unsigned)__builtin_amdgcn_s_getreg((3 << 11) | 20) & 0xFu; }
#define XB_SPIN(cond, bar) do { unsigned _sp = 0; while (cond) { __builtin_amdgcn_s_sleep(1); \
    if ((++_sp & 255u) == 0u) { if (xb_ld(&(bar)[XB_TMO])) break; if (_sp > XB_SPIN_CAP) { atomicAdd(&(bar)[XB_TMO], 1u); break; } } } } while (0)

struct XcdBarrier {
    unsigned* bar; unsigned x;
    volatile LAS unsigned* st;
};

__device__ __forceinline__ XcdBarrier xcd_barrier_post(unsigned* bar, volatile LAS unsigned* st) {
    XcdBarrier b; b.bar = bar; b.x = xb_xcc_id(); b.st = st;
    if (threadIdx.x == 0) (void)xb_add(&bar[XB_XCNT(b.x)], 1u);
    return b;
}
__device__ __forceinline__ void xcd_barrier_complete(unsigned* bar, unsigned x, unsigned& nloc, unsigned& nx) {
    const unsigned G = gridDim.x * gridDim.y * gridDim.z;
    unsigned sum, cnt, mine, sp = 0u;
    for (;;) {
        sum = 0u; cnt = 0u; mine = 0u;
#pragma unroll
        for (unsigned j = 0; j < 16; ++j) { const unsigned c = xb_ld(&bar[XB_XCNT(j)]); sum += c; cnt += (c > 0u) ? 1u : 0u; mine = (j == x) ? c : mine; }
        if (sum == G) break;
        __builtin_amdgcn_s_sleep(1);
        if ((++sp & 255u) == 0u) { if (xb_ld(&bar[XB_TMO])) break; if (sp > XB_SPIN_CAP) { atomicAdd(&bar[XB_TMO], 1u); break; } }
    }
    nloc = mine > 0u ? mine : 1u; nx = cnt > 0u ? cnt : 1u;
}

__device__ __forceinline__ void xcd_barrier(const XcdBarrier& b) {
    asm volatile("s_waitcnt vmcnt(0)" ::: "memory");
    __syncthreads();
    if (threadIdx.x == 0) {
        unsigned* bar = b.bar;
        __builtin_amdgcn_s_waitcnt(0);
        unsigned nloc = b.st[0], nx = b.st[1];
        if (nloc == 0u) { xcd_barrier_complete(bar, b.x, nloc, nx); b.st[0] = nloc; b.st[1] = nx; }
        const unsigned old = xb_add(&bar[XB_XSUB(b.x)], 1u);
        const unsigned gen = old / nloc;
        if (old + 1u == (gen + 1u) * nloc) {
            __builtin_amdgcn_fence(__ATOMIC_RELEASE, "agent");
            asm volatile("s_waitcnt vmcnt(0)" ::: "memory");
            const unsigned og = xb_add(&bar[XB_TOP], 1u);
            const unsigned tg = og / nx;
            if (og + 1u == (tg + 1u) * nx) xb_add(&bar[XB_TOPGEN], 1u);
            else XB_SPIN(xb_ld(&bar[XB_TOPGEN]) == tg, bar);
            __builtin_amdgcn_fence(__ATOMIC_ACQUIRE, "agent");
            xb_add(&bar[XB_XGEN(b.x)], 1u);
            asm volatile("s_waitcnt vmcnt(0)" ::: "memory");
        } else {
            XB_SPIN(xb_ld(&bar[XB_XGEN(b.x)]) == gen, bar);
            __builtin_amdgcn_fence(__ATOMIC_ACQUIRE, "agent");
            asm volatile("s_waitcnt vmcnt(0)" ::: "memory");
        }
    }
    __syncthreads();
}

struct Frame {
    LAS unsigned char* lds;
    volatile LAS unsigned* MISC;
    gu32* ctl;
    int tid, lane, wave;
    int vcu, G;
    unsigned char* ws;
    const float *x, *c, *w_ada, *b_ada, *g_mix, *w_in, *g_sgu, *w_sp, *b_sp, *b_fg, *g_osgu, *g_ofox, *w_out, *g_ffn, *w_rg, *b_rg, *w_re, *b_re, *w_gate, *w_up, *w_down, *g_fin;
    float* out;
};
__device__ __forceinline__ float wave_sum(float v) {
#pragma unroll
    for (int o = 1; o < 64; o <<= 1) v += __shfl_xor(v, o);
    return v;
}
__device__ __forceinline__ float wave_max(float v) {
#pragma unroll
    for (int o = 1; o < 64; o <<= 1) v = fmaxf(v, __shfl_xor(v, o));
    return v;
}
__device__ __forceinline__ float bf2f(unsigned short h) { return __uint_as_float((unsigned)h << 16); }

__device__ __forceinline__ void p0_tr_item(const float* W, int ldw, int k0, int n0, bf16* dst, int ldt, const float* kscale, LAS float* scr, int lane) {
#pragma unroll 8
    for (int i = 0; i < 32; ++i) { const int kk = 2 * i + (lane >> 5); float v = W[(size_t)(k0 + kk) * ldw + n0 + (lane & 31)]; if (kscale) v *= kscale[k0 + kk]; scr[kk * 33 + (lane & 31)] = v; }
    LDS_WAIT(); asm volatile("" ::: "memory");
    const int c = lane & 7;
#pragma unroll
    for (int j = 0; j < 4; ++j) { const int n = (lane >> 3) + 8 * j; const LAS float* s = scr + (8 * c) * 33 + n;
        v4u o; o.x = pk2(s[0 * 33], s[1 * 33]); o.y = pk2(s[2 * 33], s[3 * 33]); o.z = pk2(s[4 * 33], s[5 * 33]); o.w = pk2(s[6 * 33], s[7 * 33]);
        *(GAS v4u*)(dst + (size_t)n * ldt + 8 * c) = o; }
    LDS_WAIT(); asm volatile("" ::: "memory");
}
__device__ __forceinline__ void p0_prologue(Frame& F) {
    LAS float* scr = (LAS float*)(F.lds + RING_OFF + F.wave * 16384);
    const int gw = F.vcu * NWAVES + F.wave, NGW = F.G * NWAVES;
    bf16* WIN = (bf16*)(F.ws + WS_WIN); bf16* WOUT = (bf16*)(F.ws + WS_WOUT); bf16* WGU = (bf16*)(F.ws + WS_WGU); bf16* WDC = (bf16*)(F.ws + WS_WDC);
    constexpr int I_ADA = 8 * 24;
    constexpr int I_IN = (D / 64) * (NPROJ / 32);
    constexpr int I_OUT = (D / 64) * (D / 32);
    constexpr int I_GU1 = (D / 64) * (DEXP / 32);
    constexpr int I_GU = NEXP * 2 * I_GU1;
    constexpr int I_DC1 = (DEXP / 64) * (D / 32);
    constexpr int I_DC = NCLS * 2 * I_DC1;
    constexpr int I_SM = 8 * 128 * 128 / 512;
    constexpr int NITEMS = I_ADA + I_IN + I_OUT + I_GU + I_DC + I_SM;
    for (int it = gw; it < NITEMS; it += NGW) {
        int r = it;
        if (r < I_ADA) {
            const int kp = r / 24, cg = r % 24; const int n = cg * 256 + F.lane * 4;
            f32x4 a0 = {0.f, 0.f, 0.f, 0.f}, a1 = a0, a2 = a0, a3 = a0;
            for (int k = kp * 128; k < kp * 128 + 128; ++k) {
                const f32x4 w = *(const f32x4*)(F.w_ada + (size_t)k * NADA + n);
                const float c0 = F.c[k], c1 = F.c[D + k], c2 = F.c[2 * D + k], c3 = F.c[3 * D + k];
                a0 += w * (c0 / (1.f + __expf(-c0))); a1 += w * (c1 / (1.f + __expf(-c1))); a2 += w * (c2 / (1.f + __expf(-c2))); a3 += w * (c3 / (1.f + __expf(-c3)));
            }
            float* P = (float*)(F.ws + WS_ADAP) + (size_t)kp * 4 * NADA + n;
            *(f32x4*)(P) = a0; *(f32x4*)(P + NADA) = a1; *(f32x4*)(P + 2 * NADA) = a2; *(f32x4*)(P + 3 * NADA) = a3;
            continue; }
        r -= I_ADA;
        if (r < I_IN) { const int kb = r / (NPROJ / 32), nb = r % (NPROJ / 32); p0_tr_item(F.w_in, LDW_IN, 64 * kb, 32 * nb, WIN + (size_t)(32 * nb) * D + 64 * kb, D, nullptr, scr, F.lane); continue; }
        r -= I_IN;
        if (r < I_OUT) { const int kb = r / (D / 32), nb = r % (D / 32); const int k0 = 64 * kb;
            p0_tr_item(F.w_out, D, k0, 32 * nb, WOUT + (size_t)(32 * nb) * D + k0, D, k0 < DH ? F.g_osgu : F.g_ofox - DH, scr, F.lane); continue; }
        r -= I_OUT;
        if (r < I_GU) { const int e = r / (2 * I_GU1), r2 = r % (2 * I_GU1), isup = r2 / I_GU1, r3 = r2 % I_GU1; const int kb = r3 / (DEXP / 32), nb = r3 % (DEXP / 32); const int n0 = 32 * nb;
            const float* W = (isup ? F.w_up : F.w_gate) + (size_t)e * D * DEXP; const int drow = (n0 >> 7) * 256 + isup * 128 + (n0 & 127);
            p0_tr_item(W, DEXP, 64 * kb, n0, WGU + ((size_t)e * 1024 + drow) * D + 64 * kb, D, nullptr, scr, F.lane); continue; }
        r -= I_GU;
        if (r < I_DC) { const int cs = r / I_DC1, r3 = r % I_DC1; const int cls = cs >> 1, s = cs & 1; const int e = pg8::cls_expert(cls, s); const int kb = r3 / (D / 32), nb = r3 % (D / 32);
            p0_tr_item(F.w_down + (size_t)e * DEXP * D, D, 64 * kb, 32 * nb, WDC + ((size_t)cls * 1024 + 32 * nb) * D + s * DEXP + 64 * kb, D, nullptr, scr, F.lane); continue; }
        r -= I_DC;
        { bf16* WSM = (bf16*)(F.ws + WS_WSM);
#pragma unroll
          for (int j = 0; j < 8; ++j) { const int idx = r * 512 + j * 64 + F.lane; const int tt = (idx >> 7) & 127, ss = idx & 127; const float v = F.w_sp[idx]; WSM[idx] = (bf16)f2bf(ss <= tt ? v : 0.f); } }
    }
}

__device__ __forceinline__ void p1_prenorm(Frame& F) {
    const float* ADAP = (const float*)(F.ws + WS_ADAP); float* ADA = (float*)(F.ws + WS_ADA);
    for (int i = blockIdx.x * (NWAVES * 64) + F.tid; i < BATCH * NADA; i += F.G * NWAVES * 64) { float s = F.b_ada[i % NADA];
#pragma unroll
        for (int p = 0; p < 8; ++p) s += ADAP[(size_t)p * BATCH * NADA + i];
        ADA[i] = s; }
    LAS float* modA = (LAS float*)(F.lds);
    LAS float* modB = modA + 1024;
    LAS float* wf = modB + 1024;
    LAS float* gi = wf + 8192;
    bf16* XN = (bf16*)(F.ws + WS_XN); float* LC = (float*)(F.ws + WS_LC); float* CT = (float*)(F.ws + WS_CT);
    for (int ch = blockIdx.x; ch < M / 128; ch += F.G) {
        const int b = ch / (T / 128);
        __syncthreads();
        for (int k = F.tid; k < D; k += NWAVES * 64) { float sh = F.b_ada[k], sc = F.b_ada[D + k];
#pragma unroll
            for (int p = 0; p < 8; ++p) { sh += ADAP[((size_t)p * BATCH + b) * NADA + k]; sc += ADAP[((size_t)p * BATCH + b) * NADA + D + k]; }
            modA[k] = F.g_mix[k] * (1.f + sc); modB[k] = sh; }
        for (int i = F.tid; i < D * 8; i += NWAVES * 64) wf[(i & 7) * D + (i >> 3)] = F.w_in[(size_t)(i >> 3) * LDW_IN + NPROJ + (i & 7)];
        __syncthreads();
        for (int rl = F.wave; rl < 128; rl += NWAVES) {
            const int m = ch * 128 + rl;
            const f32x4* xr = (const f32x4*)(F.x + (size_t)m * D) + F.lane;
            f32x4 v[4]; float s = 0.f;
#pragma unroll
            for (int j = 0; j < 4; ++j) { v[j] = xr[64 * j]; s += (v[j].x * v[j].x + v[j].y * v[j].y) + (v[j].z * v[j].z + v[j].w * v[j].w); }
            const float rstd = 1.f / sqrtf(wave_sum(s) * (1.f / D) + EPS);
            float fl[8];
#pragma unroll
            for (int q = 0; q < 8; ++q) fl[q] = 0.f;
            unsigned long long* o8 = (unsigned long long*)(XN + (size_t)m * D) + F.lane;
#pragma unroll
            for (int j = 0; j < 4; ++j) { const int k0 = 4 * F.lane + 256 * j; float h[4];
#pragma unroll
                for (int e = 0; e < 4; ++e) { h[e] = v[j][e] * rstd * modA[k0 + e] + modB[k0 + e];
#pragma unroll
                    for (int q = 0; q < 8; ++q) fl[q] += h[e] * wf[q * D + k0 + e]; }
                o8[64 * j] = (unsigned long long)pk2(h[0], h[1]) | ((unsigned long long)pk2(h[2], h[3]) << 32); }
#pragma unroll
            for (int q = 0; q < 8; ++q) fl[q] = wave_sum(fl[q]);
            if (F.lane < 8) { float z = 0.f;
#pragma unroll
                for (int q = 0; q < 8; ++q) z = (F.lane == q) ? fl[q] : z;
                z += F.b_fg[F.lane];
                const float sp = fmaxf(-z, 0.f) + log1pf(expf(-fabsf(z)));
                gi[rl * 8 + F.lane] = sp * LOG2E; }
        }
        __syncthreads();
        { const int h = F.wave; float* lc = LC + ((size_t)b * NH + h) * T + (ch % (T / 128)) * 128;
            const float a0 = gi[(2 * F.lane) * 8 + h], a1 = gi[(2 * F.lane + 1) * 8 + h]; float sc = a0 + a1;
#pragma unroll
            for (int o = 1; o < 64; o <<= 1) { const float t = __shfl_up(sc, o); if (F.lane >= o) sc += t; }
            lc[2 * F.lane] = sc - a1; lc[2 * F.lane + 1] = sc;
            if (F.lane == 63) CT[((size_t)b * NH + h) * (T / 128) + (ch % (T / 128))] = sc; }
    }
    __syncthreads();
}

__device__ __forceinline__ void p3_sgu_naive(Frame& F) {
    const bf16* U = (const bf16*)(F.ws + WS_U); const bf16* VS = U + (size_t)M * DH; const bf16* WSM = (const bf16*)(F.ws + WS_WSM);
    bf16* Y = (bf16*)(F.ws + WS_Y); float* SSQY = (float*)(F.ws + WS_SSQY);
    LAS bf16* vn = (LAS bf16*)(F.lds);
    const int h = F.wave, c = F.tid;
    for (int ch = blockIdx.x; ch < M / 128; ch += F.G) {
        __syncthreads();
        const float gs = F.g_sgu[h * 64 + F.lane];
        for (int s = 0; s < 128; ++s) { const size_t m = (size_t)ch * 128 + s; const float val = bf2f(VS[m * DH + c]); const float q = wave_sum(val * val);
            vn[s * DH + c] = (bf16)f2bf(val * (1.f / sqrtf(q * (1.f / 64.f) + EPS)) * gs); }
        __syncthreads();
        for (int t = 0; t < 128; ++t) { float z = F.b_sp[h * 128 + t]; const bf16* wrow = WSM + ((size_t)h * 128 + t) * 128;
            for (int s = 0; s <= t; ++s) z += bf2f(wrow[s]) * bf2f(vn[s * DH + c]);
            const size_t m = (size_t)ch * 128 + t; const float y = bf2f(U[m * DH + c]) * z;
            Y[m * D + c] = (bf16)f2bf(y); const float q = wave_sum(y * y); if (F.lane == 0) SSQY[m * 16 + h] = q; }
    }
    __syncthreads();
}
__device__ __forceinline__ void p3_attn_naive(Frame& F) {
    const bf16* Q = (const bf16*)(F.ws + WS_U) + (size_t)2 * M * DH; const bf16* K = Q + (size_t)M * DH; const bf16* V = K + (size_t)M * DH;
    const float* LC = (const float*)(F.ws + WS_LC); const float* CT = (const float*)(F.ws + WS_CT);
    bf16* Y = (bf16*)(F.ws + WS_Y); float* SSQY = (float*)(F.ws + WS_SSQY);
    LAS float* Gabs = (LAS float*)(F.lds);
    LAS float* pre = Gabs + T;
    for (int item = blockIdx.x; item < BATCH * NH * 8; item += F.G) {
        const int bh = item >> 3, r = item & 7, b = bh / NH, h = bh % NH;
        __syncthreads();
        if (F.tid < 64) { float a = 0.f; for (int c2 = 0; c2 < F.tid; ++c2) a += CT[bh * 64 + c2]; pre[F.tid] = a; }
        __syncthreads();
        for (int t = F.tid; t < T; t += NWAVES * 64) Gabs[t] = pre[t >> 7] + LC[(size_t)bh * T + t];
        __syncthreads();
        for (int n = F.wave; n < T / 8; n += NWAVES) {
            const int i = 8 * n + r; const size_t rowi = (size_t)b * T + i;
            float qf[64];
            { const uint4* q4 = (const uint4*)(Q + rowi * DH + h * HD);
#pragma unroll
              for (int c4 = 0; c4 < 8; ++c4) { const uint4 w = q4[c4]; const unsigned ww[4] = {w.x, w.y, w.z, w.w};
#pragma unroll
                  for (int e = 0; e < 4; ++e) { qf[c4 * 8 + 2 * e] = __uint_as_float(ww[e] << 16); qf[c4 * 8 + 2 * e + 1] = __uint_as_float(ww[e] & 0xffff0000u); } } }
            const float Gi = Gabs[i];
            float mx = -1e30f, l = 0.f; float o[64];
#pragma unroll
            for (int d = 0; d < 64; ++d) o[d] = 0.f;
            for (int j = F.lane; j <= i; j += 64) {
                const size_t rowj = (size_t)b * T + j; const uint4* k4 = (const uint4*)(K + rowj * DH + h * HD); const uint4* v4 = (const uint4*)(V + rowj * DH + h * HD);
                float s = 0.f;
#pragma unroll
                for (int c4 = 0; c4 < 8; ++c4) { const uint4 w = k4[c4]; const unsigned ww[4] = {w.x, w.y, w.z, w.w};
#pragma unroll
                    for (int e = 0; e < 4; ++e) { s += qf[c4 * 8 + 2 * e] * __uint_as_float(ww[e] << 16); s += qf[c4 * 8 + 2 * e + 1] * __uint_as_float(ww[e] & 0xffff0000u); } }
                s += Gabs[j] - Gi;
                if (s > mx) { const float f = __builtin_amdgcn_exp2f(mx - s); l *= f;
#pragma unroll
                    for (int d = 0; d < 64; ++d) o[d] *= f;
                    mx = s; }
                const float p = __builtin_amdgcn_exp2f(s - mx); l += p;
#pragma unroll
                for (int c4 = 0; c4 < 8; ++c4) { const uint4 w = v4[c4]; const unsigned ww[4] = {w.x, w.y, w.z, w.w};
#pragma unroll
                    for (int e = 0; e < 4; ++e) { o[c4 * 8 + 2 * e] += p * __uint_as_float(ww[e] << 16); o[c4 * 8 + 2 * e + 1] += p * __uint_as_float(ww[e] & 0xffff0000u); } }
            }
            const float Mx = wave_max(mx); const float f = __builtin_amdgcn_exp2f(mx - Mx); l *= f; const float L = wave_sum(l);
            float y = 0.f;
#pragma unroll
            for (int d = 0; d < 64; ++d) { const float od = wave_sum(o[d] * f); y = (F.lane == d) ? od : y; }
            y = y / L;
            Y[rowi * D + DH + h * HD + F.lane] = (bf16)f2bf(y);
            const float q = wave_sum(y * y); if (F.lane == 0) SSQY[rowi * 16 + 8 + h] = q;
        }
    }
    __syncthreads();
}
__device__ __forceinline__ void p4_ynorm(Frame& F) {
    bf16* Y = (bf16*)(F.ws + WS_Y); const float* SSQY = (const float*)(F.ws + WS_SSQY);
    const int gw = F.vcu * NWAVES + F.wave, NGW = F.G * NWAVES;
    for (int m = gw; m < M; m += NGW) {
        const float* sq = SSQY + (size_t)m * 16; float a = 0.f, c = 0.f;
#pragma unroll
        for (int q = 0; q < 8; ++q) { a += sq[q]; c += sq[8 + q]; }
        const float rs = 1.f / sqrtf(a * (1.f / DH) + EPS), rf = 1.f / sqrtf(c * (1.f / DH) + EPS);
        v4u* p = (v4u*)(Y + (size_t)m * D) + F.lane;
        v4u a4 = p[0], b4 = p[64];
        unsigned aa[4] = {a4.x, a4.y, a4.z, a4.w}, bb[4] = {b4.x, b4.y, b4.z, b4.w};
#pragma unroll
        for (int e = 0; e < 4; ++e) { aa[e] = pk2(__uint_as_float(aa[e] << 16) * rs, __uint_as_float(aa[e] & 0xffff0000u) * rs); bb[e] = pk2(__uint_as_float(bb[e] << 16) * rf, __uint_as_float(bb[e] & 0xffff0000u) * rf); }
        a4.x = aa[0]; a4.y = aa[1]; a4.z = aa[2]; a4.w = aa[3]; b4.x = bb[0]; b4.y = bb[1]; b4.z = bb[2]; b4.w = bb[3];
        p[0] = a4; p[64] = b4;
    }
}
__device__ __forceinline__ void p6_route(Frame& F) {
    const float* ADA = (const float*)(F.ws + WS_ADA); const float* SSQ1 = (const float*)(F.ws + WS_SSQ1);
    bf16* H2 = (bf16*)(F.ws + WS_H2); int* INV = (int*)(F.ws + WS_INV); float* TW = (float*)(F.ws + WS_TW); int* TOKC = (int*)(F.ws + WS_TOKC);
    const int gw = F.vcu * NWAVES + F.wave, NGW = F.G * NWAVES;
    for (int m = gw; m < M; m += NGW) {
        const int b = m / T; const float* sq = SSQ1 + (size_t)m * 16; float a = 0.f;
#pragma unroll
        for (int q = 0; q < 16; ++q) a += sq[q];
        const float rstd = 1.f / sqrtf(a * (1.f / D) + EPS);
        const f32x4* xr = (const f32x4*)(F.out + (size_t)m * D) + F.lane;
        const float* sh2 = ADA + (size_t)b * NADA + 3 * D; const float* sc2 = ADA + (size_t)b * NADA + 4 * D;
        float hv[16]; float lg[4] = {0.f, 0.f, 0.f, 0.f};
        unsigned long long* o8 = (unsigned long long*)(H2 + (size_t)m * D) + F.lane;
#pragma unroll
        for (int j = 0; j < 4; ++j) { const int k0 = 4 * F.lane + 256 * j; const f32x4 v = xr[64 * j]; const f32x4 g = *(const f32x4*)(F.g_ffn + k0); const f32x4 sc = *(const f32x4*)(sc2 + k0); const f32x4 sh = *(const f32x4*)(sh2 + k0);
#pragma unroll
            for (int e = 0; e < 4; ++e) { const float hh = v[e] * rstd * g[e] * (1.f + sc[e]) + sh[e]; hv[j * 4 + e] = hh; const f32x4 wr = *(const f32x4*)(F.w_rg + (size_t)(k0 + e) * 4);
                lg[0] += hh * wr[0]; lg[1] += hh * wr[1]; lg[2] += hh * wr[2]; lg[3] += hh * wr[3]; }
            o8[64 * j] = (unsigned long long)pk2(hv[j * 4], hv[j * 4 + 1]) | ((unsigned long long)pk2(hv[j * 4 + 2], hv[j * 4 + 3]) << 32); }
#pragma unroll
        for (int q = 0; q < 4; ++q) lg[q] = wave_sum(lg[q]) + F.b_rg[q];
        int gs = 0; float best = lg[0];
#pragma unroll
        for (int q = 1; q < 4; ++q) if (lg[q] > best) { best = lg[q]; gs = q; }
        float den = 0.f;
#pragma unroll
        for (int q = 0; q < 4; ++q) den += expf(lg[q] - best);
        const float psel = 1.f / den;
        float le[4] = {0.f, 0.f, 0.f, 0.f}; const float* wre = F.w_re + (size_t)gs * D * 4;
#pragma unroll
        for (int j = 0; j < 4; ++j) { const int k0 = 4 * F.lane + 256 * j;
#pragma unroll
            for (int e = 0; e < 4; ++e) { const f32x4 wr = *(const f32x4*)(wre + (size_t)(k0 + e) * 4); const float hh = hv[j * 4 + e];
                le[0] += hh * wr[0]; le[1] += hh * wr[1]; le[2] += hh * wr[2]; le[3] += hh * wr[3]; } }
#pragma unroll
        for (int q = 0; q < 4; ++q) le[q] = wave_sum(le[q]) + F.b_re[gs * 4 + q];
        int i0 = 0; float v0 = le[0];
#pragma unroll
        for (int q = 1; q < 4; ++q) if (le[q] > v0) { v0 = le[q]; i0 = q; }
        int i1 = -1; float v1 = -INFINITY;
#pragma unroll
        for (int q = 0; q < 4; ++q) if (q != i0 && le[q] > v1) { v1 = le[q]; i1 = q; }
        const float e1 = expf(v1 - v0); const float w0 = psel / (1.f + e1), w1 = psel * e1 / (1.f + e1);
        const int ea = i0 < i1 ? i0 : i1, eb = i0 < i1 ? i1 : i0; const float wa = i0 < i1 ? w0 : w1, wb = i0 < i1 ? w1 : w0;
        const int pair = ea == 0 ? eb - 1 : (ea == 1 ? eb + 1 : 5); const int cls = gs * 6 + pair;
        if (F.lane == 0) { const unsigned tk = __hip_atomic_fetch_add((unsigned*)(F.ctl + CW_CNT + cls), 1u, __ATOMIC_RELAXED, __HIP_MEMORY_SCOPE_AGENT);
            INV[(size_t)cls * M + tk] = m; TW[(size_t)m * 2] = wa; TW[(size_t)m * 2 + 1] = wb; TOKC[m] = cls; }
    }
}
__device__ __forceinline__ void moe_tables(Frame& F) {
    __syncthreads();
    if (F.tid == 0) { LAS unsigned char* tcls = F.lds + TCLS_OFF; LAS unsigned char* tfirst = F.lds + TFIRST_OFF; int nt = 0;
        for (int c = 0; c < NCLS; ++c) { const int n = ((int)__hip_atomic_load(F.ctl + CW_CNT + c, RLX_AGENT) + 255) >> 8; tfirst[c] = (unsigned char)nt; for (int k = 0; k < n && nt < MAXTILES; ++k) tcls[nt++] = (unsigned char)c; }
        F.MISC[16] = (unsigned)nt; }
    __syncthreads();
}
__device__ __forceinline__ void p7_gather(Frame& F) {
    const bf16* H2 = (const bf16*)(F.ws + WS_H2); bf16* H2S = (bf16*)(F.ws + WS_H2S); const int* INV = (const int*)(F.ws + WS_INV); const float* TW = (const float*)(F.ws + WS_TW);
    int* TOK = (int*)(F.ws + WS_TOK); float* SW = (float*)(F.ws + WS_SW);
    const LAS unsigned char* tcls = F.lds + TCLS_OFF; const LAS unsigned char* tfirst = F.lds + TFIRST_OFF; const int NT = (int)F.MISC[16];
    const int gw = F.vcu * NWAVES + F.wave, NGW = F.G * NWAVES;
    for (int slot = gw; slot < NT * 256; slot += NGW) {
        const int pm = slot >> 8, cls = tcls[pm]; const int rank = ((pm - (int)tfirst[cls]) << 8) + (slot & 255);
        const int cnt = (int)__hip_atomic_load(F.ctl + CW_CNT + cls, RLX_AGENT);
        v4u* dst = (v4u*)(H2S + (size_t)slot * D) + F.lane;
        if (rank < cnt) { const int tok = INV[(size_t)cls * M + rank]; const v4u* src = (const v4u*)(H2 + (size_t)tok * D) + F.lane; dst[0] = src[0]; dst[64] = src[64];
            if (F.lane == 0) { TOK[slot] = tok; SW[(size_t)slot * 2] = TW[(size_t)tok * 2]; SW[(size_t)slot * 2 + 1] = TW[(size_t)tok * 2 + 1]; } }
        else { const v4u z = {0u, 0u, 0u, 0u}; dst[0] = z; dst[64] = z; if (F.lane == 0) { TOK[slot] = -1; SW[(size_t)slot * 2] = 0.f; SW[(size_t)slot * 2 + 1] = 0.f; } }
    }
}
__device__ __forceinline__ void p10_final(Frame& F) {
    const float* SSQ2 = (const float*)(F.ws + WS_SSQ2);
    const int gw = F.vcu * NWAVES + F.wave, NGW = F.G * NWAVES;
    for (int m = gw; m < M; m += NGW) {
        const float* sq = SSQ2 + (size_t)m * 16; float a = 0.f;
#pragma unroll
        for (int q = 0; q < 16; ++q) a += sq[q];
        const float rstd = 1.f / sqrtf(a * (1.f / D) + EPS);
        f32x4* xr = (f32x4*)(F.out + (size_t)m * D) + F.lane;
#pragma unroll
        for (int j = 0; j < 4; ++j) { const f32x4 g = *(const f32x4*)(F.g_fin + 4 * F.lane + 256 * j); xr[64 * j] = xr[64 * j] * rstd * g; }
    }
}

struct Args { const float* in[22]; float* out; unsigned char* ws; int ph_lo, ph_hi; };
__global__ void __launch_bounds__(NWAVES * 64, 2) mk_fwd(Args args) {
    extern __shared__ __attribute__((aligned(16))) unsigned char lds[];
    Frame F;
    F.lds = (LAS unsigned char*)lds;
    F.MISC = (volatile LAS unsigned*)(F.lds + MISC_OFF);
    F.tid = threadIdx.x; F.lane = F.tid & 63; F.wave = __builtin_amdgcn_readfirstlane(F.tid >> 6);
    F.G = gridDim.x; { const int bx = blockIdx.x; F.vcu = (F.G % 8 == 0) ? (bx % 8) * (F.G / 8) + bx / 8 : bx; }
    F.ws = args.ws; F.ctl = (gu32*)(args.ws + WS_CTL); F.out = args.out;
    F.x = args.in[0]; F.c = args.in[1]; F.w_ada = args.in[2]; F.b_ada = args.in[3]; F.g_mix = args.in[4]; F.w_in = args.in[5]; F.g_sgu = args.in[6]; F.w_sp = args.in[7]; F.b_sp = args.in[8]; F.b_fg = args.in[9];
    F.g_osgu = args.in[10]; F.g_ofox = args.in[11]; F.w_out = args.in[12]; F.g_ffn = args.in[13]; F.w_rg = args.in[14]; F.b_rg = args.in[15]; F.w_re = args.in[16]; F.b_re = args.in[17];
    F.w_gate = args.in[18]; F.w_up = args.in[19]; F.w_down = args.in[20]; F.g_fin = args.in[21];
    for (int u = F.tid; u < (LDS_BYTES - LDSCTL_OFF) / 4; u += NWAVES * 64) ((LAS unsigned*)(F.lds + LDSCTL_OFF))[u] = 0u;
    __syncthreads();
    XcdBarrier bar; bar.bar = (unsigned*)(F.ctl + CW_BAR); bar.x = 0; bar.st = nullptr;
    if (N_LAUNCHES == 1) bar = xcd_barrier_post((unsigned*)(F.ctl + CW_BAR), F.MISC + 8);
#define GRID_BAR() do { if (N_LAUNCHES == 1) xcd_barrier(bar); } while (0)
    const int lo = args.ph_lo, hi = args.ph_hi;
#define IN(k) (lo <= (k) && (k) < hi)
#define BOTH(k) (IN(k) && IN((k) + 1))
    bf16* const XN = (bf16*)(F.ws + WS_XN); bf16* const U = (bf16*)(F.ws + WS_U); bf16* const Y = (bf16*)(F.ws + WS_Y);
    float* const ADA = (float*)(F.ws + WS_ADA);

    if (IN(0)) { p0_prologue(F); if (BOTH(0)) GRID_BAR(); }
    if (IN(1)) { p1_prenorm(F); if (BOTH(1)) GRID_BAR(); }
    if (IN(2)) {
        pg8::Gemm g{XN, (const bf16*)(F.ws + WS_WIN), M, NPROJ, D}; pg8::StaticOrder S; S.init(M, NPROJ, F.G, (int)blockIdx.x);
        pg8::EpiProj E{U};
        pg8::gemm_phase<pg8::EpiProj, pg8::StaticOrder, true, true>(F.lds + RING_OFF, g, S, E);
        if (BOTH(2)) GRID_BAR();
    }
    if (IN(3)) { p3_sgu_naive(F); p3_attn_naive(F); if (BOTH(3)) GRID_BAR(); }
    if (IN(4)) { p4_ynorm(F); if (BOTH(4)) GRID_BAR(); }
    if (IN(5)) {
        pg8::Gemm g{Y, (const bf16*)(F.ws + WS_WOUT), M, D, D}; pg8::StaticOrder S; S.init(M, D, F.G, (int)blockIdx.x);
        pg8::EpiOut E{F.x, F.out, ADA + 2 * D, (float*)(F.ws + WS_SSQ1)};
        pg8::gemm_phase<pg8::EpiOut, pg8::StaticOrder, true, true>(F.lds + RING_OFF, g, S, E);
        if (BOTH(5)) GRID_BAR();
    }
    if (IN(6)) { p6_route(F); if (BOTH(6)) GRID_BAR(); }
    if (IN(7)) { moe_tables(F); p7_gather(F); if (BOTH(7)) GRID_BAR(); }
    if (IN(8)) {
        if (!IN(7)) moe_tables(F);
        pg8::Gemm g{(const bf16*)(F.ws + WS_H2S), (const bf16*)(F.ws + WS_WGU), 0, 0, D};
        pg8::MoeUpOrder S{F.G, (int)blockIdx.x, (int)F.MISC[16], F.lds + TCLS_OFF};
        pg8::EpiUp E{(bf16*)(F.ws + WS_ACT), (const float*)(F.ws + WS_SW)};
        pg8::gemm_phase<pg8::EpiUp, pg8::MoeUpOrder, true, true>(F.lds + RING_OFF, g, S, E);
        if (BOTH(8)) GRID_BAR();
    }
    if (IN(9)) {
        if (!IN(7)) moe_tables(F);
        pg8::Gemm g{(const bf16*)(F.ws + WS_ACT), (const bf16*)(F.ws + WS_WDC), 0, 0, D};
        pg8::MoeDownOrder S{F.G, (int)blockIdx.x, (int)F.MISC[16], F.lds + TCLS_OFF};
        pg8::EpiDown E{F.out, ADA + 5 * D, (const int*)(F.ws + WS_TOK), (float*)(F.ws + WS_SSQ2)};
        pg8::gemm_phase<pg8::EpiDown, pg8::MoeDownOrder, true, true>(F.lds + RING_OFF, g, S, E);
        if (BOTH(9)) GRID_BAR();
    }
    if (IN(10)) { p10_final(F); }
#undef IN
#undef BOTH
}

extern "C" void kernel_launch(void* const* d_in, const int* in_sizes, int n_in, void* d_out, int out_size, void* d_ws, size_t ws_size, hipStream_t stream) {
    static int grid = 0;
    if (grid == 0) {
        if (n_in != 22 || in_sizes[0] != M * D || out_size != M * D || ws_size < WS_END) { fprintf(stderr, "kernel_launch: unexpected shapes (n_in %d, in0 %d, out %d, ws %zu); nothing launched\n", n_in, n_in > 0 ? in_sizes[0] : -1, out_size, ws_size); grid = -1; return; }
        int dev = 0, cus = 0, per_cu = 0;
        if (hipGetDevice(&dev) != hipSuccess || hipDeviceGetAttribute(&cus, hipDeviceAttributeMultiprocessorCount, dev) != hipSuccess) { fprintf(stderr, "kernel_launch: device query failed\n"); grid = -1; return; }
        if (hipFuncSetAttribute((const void*)mk_fwd, hipFuncAttributeMaxDynamicSharedMemorySize, LDS_BYTES) != hipSuccess) { fprintf(stderr, "kernel_launch: hipFuncSetAttribute failed\n"); grid = -1; return; }
        if (hipOccupancyMaxActiveBlocksPerMultiprocessor(&per_cu, (const void*)mk_fwd, NWAVES * 64, LDS_BYTES) != hipSuccess || per_cu < 1) { fprintf(stderr, "kernel_launch: occupancy query reports %d workgroups per CU\n", per_cu); (void)hipGetLastError(); grid = -1; return; }
        grid = cus;
        if (grid % 8 != 0 || grid > 256) { fprintf(stderr, "kernel_launch: unexpected CU count %d\n", cus); grid = (grid / 8) * 8; if (grid > 256) grid = 256; if (grid < 8) { grid = -1; return; } }
    }
    if (grid < 0) return;
    if (hipMemsetAsync((char*)d_ws + WS_CTL, 0, CTL_ZERO_BYTES, stream) != hipSuccess) { fprintf(stderr, "kernel_launch: hipMemsetAsync failed\n"); return; }
    Args a{};
    for (int i = 0; i < 22; ++i) a.in[i] = (const float*)d_in[i];
    a.out = (float*)d_out; a.ws = (unsigned char*)d_ws;
    if (N_LAUNCHES == 1) {
        a.ph_lo = 0; a.ph_hi = N_PHASES;
        void* kargs[] = {&a};
        const hipError_t le = hipLaunchCooperativeKernel((const void*)mk_fwd, dim3(grid), dim3(NWAVES * 64), kargs, LDS_BYTES, stream);
        if (le != hipSuccess) fprintf(stderr, "kernel_launch: cooperative launch failed: %s (grid %d)\n", hipGetErrorName(le), grid);
    } else {
        for (int li = 0; li < N_PHASES; ++li) { a.ph_lo = li; a.ph_hi = li + 1;
            hipLaunchKernelGGL(mk_fwd, dim3(grid), dim3(NWAVES * 64), LDS_BYTES, stream, a);
            const hipError_t le = hipPeekAtLastError();
            if (le != hipSuccess) { fprintf(stderr, "kernel_launch: launch %d failed: %s\n", li, hipGetErrorName(le)); break; } }
    }
}
```

```cpp
#include <hip/hip_runtime.h>
#include <hip/hip_bf16.h>
#include <cstdio>
#include <cstdint>
#include <cmath>

#ifndef MK_N_LAUNCHES
#define MK_N_LAUNCHES 1
#endif
#ifndef PROBE_MASK
#define PROBE_MASK 0
#endif
#ifndef PROBE_MULT
#define PROBE_MULT 4
#endif
#ifndef MOE_FP8
#define MOE_FP8 1
#endif
#define MOE_ESZ (MOE_FP8 ? 1 : 2)
#ifndef NAIVE_SGU
#define NAIVE_SGU 0
#endif
#ifndef NAIVE_ATTN
#define NAIVE_ATTN 0
#endif

constexpr int BATCH = 4, T = 8192, D = 1024, NH = 8, HD = 64, DH = 512;
constexpr int M = BATCH * T;
constexpr int NPROJ = 2560;
constexpr int LDW_IN = 2568;
constexpr int NADA = 6 * D;
constexpr int NEXP = 16, DEXP = 512, NCLS = 24;
constexpr int MAXTILES = 152;
constexpr float EPS = 1e-6f;
constexpr float C2 = 0.125f * 1.4426950408889634f;
constexpr float LOG2E = 1.4426950408889634f;

namespace pg8 {
#define PG8_LAS __attribute__((address_space(3)))
typedef unsigned short bf16_t;
typedef short bf16x8 __attribute__((ext_vector_type(8)));
typedef float f32x4 __attribute__((ext_vector_type(4)));
typedef unsigned u32x4 __attribute__((ext_vector_type(4)));
constexpr int BM = 256, BK = 64, HALF = 128, HTB = HALF * BK * 2  , STAGE_BYTES = 8 * HTB, NXCD = 8, WGM = 8;

__host__ __device__ __forceinline__ int lds_byte(int r, int c) { const int st = (r >> 4) * 2 + (c >> 5), rr = r & 15, cc = c & 31, ob = rr * 64 + cc * 2; return st * 1024 + (ob ^ (((ob >> 9) & 1) << 5)); }
__host__ __device__ __forceinline__ void stage_rc(int b, int& R, int& C) { const int st = b / 1024, sb = b % 1024, swz = sb ^ (((sb >> 9) & 1) << 5); R = (st >> 1) * 16 + swz / 64; C = (st & 1) * 32 + (swz % 64) / 2; }
__host__ __device__ __forceinline__ int perm32(int rho) { const int n = rho >> 4, i = rho & 15; return 8 * (i >> 2) + 4 * n + (i & 3); }

struct Unit { int pm, pn, aux; long aoff, boff, dboff; int cls, rank0, cnt, ord; };
struct Gemm { const bf16_t* A; const bf16_t* Bt; int lda, ldb, K; int scA, scB; };

struct StaticOrder {
    static constexpr bool GATHER = false;
    int nM, nN, nwg, G, c; long ta, tb;
    __host__ __device__ void init(int M, int N, int lda, int ldb, int G_, int c_) { nM = M / BM; nN = N / BM; nwg = nM * nN; G = G_; c = c_; ta = (long)BM * lda * 2; tb = (long)BM * ldb * 2; }
    __host__ __device__ bool next(int i, Unit& u) const {
        const long L = (long)i * G + c; if (L >= nwg) return false;
        int wgid = (int)L; { const int q = nwg / NXCD, r = nwg % NXCD, xcd = wgid % NXCD, off = wgid / NXCD; wgid = (xcd < r ? xcd * (q + 1) : r * (q + 1) + (xcd - r) * q) + off; }
        const int nig = WGM * nN, gid = wgid / nig, fm = gid * WGM, gsz = (nM - fm) < WGM ? (nM - fm) : WGM;
        u.pm = fm + ((wgid % nig) % gsz); u.pn = (wgid % nig) / gsz; u.aux = 0; u.aoff = u.pm * ta; u.boff = u.pn * tb; u.dboff = 0; u.cls = 0; u.rank0 = 0; u.cnt = 0; u.ord = i; return true;
    }
    __device__ __forceinline__ void a_ready(const Unit&) const {}
    __device__ __forceinline__ void done(const Unit&) const {}
};


__device__ __forceinline__ unsigned cvt_pk_bf16(float lo, float hi) { unsigned r; asm volatile("v_cvt_pk_bf16_f32 %0, %1, %2" : "=v"(r) : "v"(lo), "v"(hi)); return r; }
__device__ __forceinline__ float gelu_tanh(float v) {
    const float u = v * (1.5957691216057308f + 0.0713548162726f * v * v);
    return v * __builtin_amdgcn_rcpf(1.0f + __builtin_amdgcn_exp2f(-1.4426950408889634f * u));
}
__device__ __forceinline__ float silu_f(float v) { return v * __builtin_amdgcn_rcpf(1.0f + __builtin_amdgcn_exp2f(-1.4426950408889634f * v)); }

struct NoState {};
#define PG8_DPP_MAX(v, ctrl) fmaxf((v), __builtin_bit_cast(float, __builtin_amdgcn_update_dpp(0, __builtin_bit_cast(int, (v)), (ctrl), 0xf, 0xf, false)))
__device__ __forceinline__ float wave_max_nonneg(float v) {
    v = PG8_DPP_MAX(v, 0xB1); v = PG8_DPP_MAX(v, 0x4E); v = PG8_DPP_MAX(v, 0x141); v = PG8_DPP_MAX(v, 0x140);
    const int iv = __builtin_bit_cast(int, v);
    return fmaxf(fmaxf(__builtin_bit_cast(float, __builtin_amdgcn_readlane(iv, 0)), __builtin_bit_cast(float, __builtin_amdgcn_readlane(iv, 16))), fmaxf(__builtin_bit_cast(float, __builtin_amdgcn_readlane(iv, 32)), __builtin_bit_cast(float, __builtin_amdgcn_readlane(iv, 48))));
}
struct EpiProj {
    static constexpr bool PERM = true, AFTER_DRAIN = false, MID = false; typedef NoState State;
    bf16_t* O; unsigned* qkb;
    __device__ __forceinline__ void operator()(const f32x4 (&acc)[2][2][4][2], const State&, const Unit& u, int wr, int wc, int fr, int fq) const {
        const int row0 = u.pm * BM + wr * 64 + fr; const int seg = u.pn >> 1; float nmx[2] = {0.f, 0.f};
        bf16_t* base = O + (size_t)seg * ((size_t)M * 512);
        const int col0 = (u.pn & 1) * 256 + wc * 32 + 8 * fq;
#pragma unroll
        for (int ai = 0; ai < 2; ++ai)
#pragma unroll
            for (int m = 0; m < 4; ++m) { bf16_t* rowp = base + (size_t)(row0 + ai * HALF + m * 16) * 512 + col0;
#pragma unroll
                for (int bj = 0; bj < 2; ++bj) { f32x4 v0 = acc[ai][bj][m][0], v1 = acc[ai][bj][m][1];
                    if (seg < 2) {
#pragma unroll
                        for (int j = 0; j < 4; ++j) { v0[j] = gelu_tanh(v0[j]); v1[j] = gelu_tanh(v1[j]); }
                    } else if (seg == 2) { v0 = v0 * C2; v1 = v1 * C2; }
                    if (seg == 2 || seg == 3) { float s8 = ((v0[0] * v0[0] + v0[1] * v0[1]) + (v0[2] * v0[2] + v0[3] * v0[3])) + ((v1[0] * v1[0] + v1[1] * v1[1]) + (v1[2] * v1[2] + v1[3] * v1[3]));
                        { const auto r16 = __builtin_amdgcn_permlane16_swap(__float_as_uint(s8), __float_as_uint(s8), false, false); s8 = __uint_as_float(r16[0]) + __uint_as_float(r16[1]);
                          const auto r32 = __builtin_amdgcn_permlane32_swap(__float_as_uint(s8), __float_as_uint(s8), false, false); s8 = __uint_as_float(r32[0]) + __uint_as_float(r32[1]); }
                        nmx[bj] = fmaxf(nmx[bj], s8); }
                    u32x4 w; w.x = cvt_pk_bf16(v0[0], v0[1]); w.y = cvt_pk_bf16(v0[2], v0[3]); w.z = cvt_pk_bf16(v1[0], v1[1]); w.w = cvt_pk_bf16(v1[2], v1[3]);
                    *(u32x4*)(rowp + bj * HALF) = w; } }
        if (seg == 2 || seg == 3) {
#pragma unroll
            for (int bj = 0; bj < 2; ++bj) { const float wm = wave_max_nonneg(nmx[bj]); const int bh = (u.pm >> 5) * 8 + 4 * (u.pn & 1) + 2 * bj + (wc >> 1);
                if (fr == 0 && fq == 0) __hip_atomic_fetch_max(qkb + (seg == 3 ? bh * 16 + (u.pm & 15) : 512 + bh * 32 + (u.pm & 31)), __float_as_uint(wm), __ATOMIC_RELAXED, __HIP_MEMORY_SCOPE_AGENT); } }
    }
};
struct EpiMix {
    static constexpr bool PERM = true, AFTER_DRAIN = false, MID = true; struct State { float rs[2][4]; };
    bf16_t* O; const float* ssq;
    __device__ __forceinline__ void mid(f32x4 (&acc)[2][2][4][2], State& st, const Unit& u, int wr, int fr) const {
        int rb = u.pm * BM + wr * 64 + fr; asm volatile("" : "+v"(rb));
#pragma unroll
        for (int ai = 0; ai < 2; ++ai)
#pragma unroll
            for (int m = 0; m < 4; ++m) { const int r = rb + ai * HALF + m * 16; const f32x4* p = (const f32x4*)(ssq + (size_t)r * 16);
                const f32x4 s0 = p[0], s1 = p[1], f0 = p[2], f1 = p[3];
                const float a = ((s0[0] + s0[1]) + (s0[2] + s0[3])) + ((s1[0] + s1[1]) + (s1[2] + s1[3])), c = ((f0[0] + f0[1]) + (f0[2] + f0[3])) + ((f1[0] + f1[1]) + (f1[2] + f1[3]));
                const float rs = 1.f / sqrtf(a * (1.f / 512.f) + EPS), rf = 1.f / sqrtf(c * (1.f / 512.f) + EPS); st.rs[ai][m] = rs; const float ratio = rf / rs;
#pragma unroll
                for (int bj = 0; bj < 2; ++bj)
#pragma unroll
                    for (int n = 0; n < 2; ++n) acc[ai][bj][m][n] = acc[ai][bj][m][n] * ratio; }
    }
    __device__ __forceinline__ void operator()(const f32x4 (&acc)[2][2][4][2], const State& st, const Unit& u, int wr, int wc, int fr, int fq) const {
        const int row0 = u.pm * BM + wr * 64 + fr; const int col0 = u.pn * BM + wc * 32 + 8 * fq;
#pragma unroll
        for (int ai = 0; ai < 2; ++ai)
#pragma unroll
            for (int m = 0; m < 4; ++m) { bf16_t* rowp = O + (size_t)(row0 + ai * HALF + m * 16) * D + col0; const float rs = st.rs[ai][m];
#pragma unroll
                for (int bj = 0; bj < 2; ++bj) { const f32x4 v0 = acc[ai][bj][m][0] * rs, v1 = acc[ai][bj][m][1] * rs;
                    u32x4 w; w.x = cvt_pk_bf16(v0[0], v0[1]); w.y = cvt_pk_bf16(v0[2], v0[3]); w.z = cvt_pk_bf16(v1[0], v1[1]); w.w = cvt_pk_bf16(v1[2], v1[3]);
                    *(u32x4*)(rowp + bj * HALF) = w; } }
    }
};
struct EpiUp {
    static constexpr bool PERM = true, AFTER_DRAIN = false, MID = false; typedef NoState State;
    bf16_t* ACT; const float* TW; const int* INV;
    __device__ __forceinline__ void operator()(const f32x4 (&acc)[2][2][4][2], const State&, const Unit& u, int wr, int wc, int fr, int fq) const {
        const int s = u.aux >> 2, t = u.aux & 3; const int col0 = s * 512 + t * 128 + wc * 32 + 8 * fq; const int* inv = INV + (size_t)u.cls * M + u.rank0;
#pragma unroll
        for (int ai = 0; ai < 2; ++ai)
#pragma unroll
            for (int m = 0; m < 4; ++m) { const int rl = ai * HALF + wr * 64 + m * 16 + fr; const int r = u.pm * BM + rl; float w = 0.f;
                if (u.rank0 + rl < u.cnt) w = TW[(size_t)inv[rl] * 2 + s];
                float a[8];
#pragma unroll
                for (int n = 0; n < 2; ++n)
#pragma unroll
                    for (int j = 0; j < 4; ++j) a[n * 4 + j] = silu_f(acc[ai][0][m][n][j]) * acc[ai][1][m][n][j] * w;
#if MOE_FP8
                int p0 = 0, p1 = 0;
                p0 = __builtin_amdgcn_cvt_pk_fp8_f32(a[0] * 16.f, a[1] * 16.f, p0, false); p0 = __builtin_amdgcn_cvt_pk_fp8_f32(a[2] * 16.f, a[3] * 16.f, p0, true);
                p1 = __builtin_amdgcn_cvt_pk_fp8_f32(a[4] * 16.f, a[5] * 16.f, p1, false); p1 = __builtin_amdgcn_cvt_pk_fp8_f32(a[6] * 16.f, a[7] * 16.f, p1, true);
                typedef int v2i_t __attribute__((ext_vector_type(2)));
                *(v2i_t*)((unsigned char*)ACT + (size_t)r * D + col0) = (v2i_t){p0, p1}; }
#else
                u32x4 o; o.x = cvt_pk_bf16(a[0], a[1]); o.y = cvt_pk_bf16(a[2], a[3]); o.z = cvt_pk_bf16(a[4], a[5]); o.w = cvt_pk_bf16(a[6], a[7]);
                *(u32x4*)(ACT + (size_t)r * D + col0) = o; }
#endif
    }
};
struct EpiDown {
    static constexpr bool PERM = true, AFTER_DRAIN = false, MID = false; typedef NoState State;
    bf16_t* O; const int* INV;
    __device__ __forceinline__ void operator()(const f32x4 (&acc)[2][2][4][2], const State&, const Unit& u, int wr, int wc, int fr, int fq) const {
        const int col0 = u.aux * BM + wc * 32 + 8 * fq; const int* inv = INV + (size_t)u.cls * M + u.rank0;
#pragma unroll
        for (int ai = 0; ai < 2; ++ai)
#pragma unroll
            for (int m = 0; m < 4; ++m) { const int rl = ai * HALF + wr * 64 + m * 16 + fr;
                if (u.rank0 + rl < u.cnt) { const int tok = inv[rl]; bf16_t* rowp = O + (size_t)tok * D + col0;
#pragma unroll
                    for (int bj = 0; bj < 2; ++bj) { const f32x4 v0 = acc[ai][bj][m][0], v1 = acc[ai][bj][m][1];
                        u32x4 w; w.x = cvt_pk_bf16(v0[0], v0[1]); w.y = cvt_pk_bf16(v0[2], v0[3]); w.z = cvt_pk_bf16(v1[0], v1[1]); w.w = cvt_pk_bf16(v1[2], v1[3]);
                        *(u32x4*)(rowp + bj * HALF) = w; } } }
    }
};
__device__ __forceinline__ int cls_expert(int cls, int s) { const int g = cls / 6, p = cls % 6; const int a = p < 3 ? 0 : (p < 5 ? 1 : 2); const int b = p < 3 ? p + 1 : (p < 5 ? p - 1 : 3); return g * 4 + (s ? b : a); }
struct MoeUpOrder {
    static constexpr bool GATHER = true;
    int G, c, NT; const PG8_LAS unsigned char* tcls; const PG8_LAS unsigned char* tfirst; const PG8_LAS unsigned* lcnt; const PG8_LAS unsigned* toku;
    __device__ __forceinline__ bool next(int i, Unit& u) const {
        const int x = c & 7, j = (c >> 3) + (G >> 3) * i; const int pm = 8 * (j >> 3) + x; if (pm >= NT) return false;
        const int st = j & 7; const int cls = (int)tcls[pm]; u.pm = pm; u.aux = st; u.pn = cls_expert(cls, st >> 2) * 4 + (st & 3);
        u.aoff = 0; u.boff = (long)u.pn * (BM * D * MOE_ESZ); u.dboff = 0; u.cls = cls; u.rank0 = (pm - (int)tfirst[cls]) * BM; u.cnt = (int)lcnt[cls]; u.ord = i; return true;
    }
    __device__ __forceinline__ unsigned row_off(const Unit& u, int r) const { return toku[u.ord * BM + r]; }
    __device__ __forceinline__ void a_ready(const Unit&) const {}
    __device__ __forceinline__ void done(const Unit&) const {}
};
struct MoeDownOrder {
    static constexpr bool GATHER = false;
    int G, c, NT; const PG8_LAS unsigned char* tcls; const PG8_LAS unsigned char* tfirst; const PG8_LAS unsigned* lcnt;
    __device__ __forceinline__ bool next(int i, Unit& u) const {
        const int x = c & 7, j = (c >> 3) + (G >> 3) * i; const int pm = 8 * (j >> 2) + x; if (pm >= NT) return false;
        const int nt = j & 3; const int cls = (int)tcls[pm]; const int ea = cls_expert(cls, 0), eb = cls_expert(cls, 1); u.pm = pm; u.aux = nt; u.pn = 0;
        u.aoff = (long)pm * (BM * D * MOE_ESZ); u.boff = ((long)ea * D + nt * BM) * (DEXP * MOE_ESZ); u.dboff = (long)(eb - ea) * D * (DEXP * MOE_ESZ) - DEXP * MOE_ESZ;
        u.cls = cls; u.rank0 = (pm - (int)tfirst[cls]) * BM; u.cnt = (int)lcnt[cls]; u.ord = i; return true;
    }
    __device__ __forceinline__ void a_ready(const Unit&) const {}
    __device__ __forceinline__ void done(const Unit&) const {}
};

template <class Epi, class Sched, bool ALIGN_EPI = false, bool SP2 = false, bool FP8 = false>
__device__ __forceinline__ void gemm_phase(PG8_LAS unsigned char* lds, const Gemm g, const Sched& S, const Epi& E, const int tid) {
    typedef int v4i_t __attribute__((ext_vector_type(4))); typedef int v8i_t __attribute__((ext_vector_type(8)));
    const int wid = __builtin_amdgcn_readfirstlane(tid >> 6), lane = tid & 63, wr = wid >> 2, wc = wid & 3, fr = lane & 15, fq = lane >> 4;
    const int K = g.K, nt = K / BK;
    static_assert(SP2, "only the two-super-phase loop is kept");
    const int nth = nt / 2;
    unsigned voffB[2]; int RR[2], CC2[2];
    unsigned cvo[2][2];
#pragma unroll
    for (int i = 0; i < 2; ++i) { int R, C; stage_rc(tid * 16 + i * 8192, R, C); const int Rb = Epi::PERM ? ((R & ~31) + perm32(R & 31)) : R;
        RR[i] = R; CC2[i] = C * 2; voffB[i] = (unsigned)(Rb * g.ldb + C) * 2u; }
#define PG8_AOFFS(dst, u) do { _Pragma("unroll") for (int _h = 0; _h < 2; ++_h) _Pragma("unroll") for (int _i = 0; _i < 2; ++_i) { \
        if constexpr (Sched::GATHER) dst[_h][_i] = S.row_off(u, _h * HALF + RR[_i]) + (unsigned)CC2[_i]; else dst[_h][_i] = (unsigned)((_h * HALF + RR[_i]) * g.lda) * 2u + (unsigned)CC2[_i]; } } while (0)
    const size_t kstep = (size_t)(BK * 2);
    const size_t hstep = (size_t)HALF * g.ldb * 2;
    const unsigned ldsw = (unsigned)wid * 1024u;
    int aofs[2], bofs[2];
    if constexpr (FP8) { aofs[0] = lds_byte(wr * 64 + fr, 16 * (fq & 1)) + (fq >> 1) * 1024; aofs[1] = lds_byte(wr * 64 + fr, 16 * (fq & 1) + 8) + (fq >> 1) * 1024;
                         bofs[0] = lds_byte(wc * 32 + fr, 16 * (fq & 1)) + (fq >> 1) * 1024; bofs[1] = lds_byte(wc * 32 + fr, 16 * (fq & 1) + 8) + (fq >> 1) * 1024; }
    else { aofs[0] = lds_byte(wr * 64 + fr, fq * 8); aofs[1] = aofs[0] + 1024; bofs[0] = lds_byte(wc * 32 + fr, fq * 8); bofs[1] = bofs[0] + 1024; }
#define PG8_SA(b, h) (((b) * 2 + (h)) * HTB)
#define PG8_SB(b, h) ((4 + (b) * 2 + (h)) * HTB)
#define PG8_STAGE(bufoff, gbase, voff) do { _Pragma("unroll") for (int _i = 0; _i < 2; ++_i) \
        __builtin_amdgcn_global_load_lds((const unsigned*)((const char*)(gbase) + (voff)[_i]), (PG8_LAS unsigned*)(lds + (bufoff) + ldsw + _i * 8192), 16, 0, 0); } while (0)
#define PG8_LD16(off) (*(const PG8_LAS v4i_t*)(lds + (off)))
#define PG8_LDA(dst, b, h) do { if constexpr (FP8) { _Pragma("unroll") for (int m = 0; m < 4; ++m) dst##8[m] = *(const PG8_LAS v8i_t*)(lds + PG8_SA(b, h) + aofs[0] + m * 2048); }     \
        else { _Pragma("unroll") for (int m = 0; m < 4; ++m) _Pragma("unroll") for (int k = 0; k < 2; ++k) dst[m][k] = *(const PG8_LAS bf16x8*)(lds + PG8_SA(b, h) + aofs[k] + m * 2048); } } while (0)
#define PG8_LDB(dst, b, h) do { if constexpr (FP8) { _Pragma("unroll") for (int n = 0; n < 2; ++n) dst##8[n] = *(const PG8_LAS v8i_t*)(lds + PG8_SB(b, h) + bofs[0] + n * 2048); } \
        else { _Pragma("unroll") for (int n = 0; n < 2; ++n) _Pragma("unroll") for (int k = 0; k < 2; ++k) dst[n][k] = *(const PG8_LAS bf16x8*)(lds + PG8_SB(b, h) + bofs[k] + n * 2048); } } while (0)
#define PG8_PINACC(ai, bj) do { if constexpr (FP8) { _Pragma("unroll") for (int m = 0; m < 4; ++m) _Pragma("unroll") for (int n = 0; n < 2; ++n) asm volatile("" : "+v"(acc[ai][bj][m][n])); } } while (0)
#define PG8_MMA(ai, bj, At, Bt) do { PG8_PINACC(ai, bj); __builtin_amdgcn_s_setprio(1); _Pragma("unroll") for (int m = 0; m < 4; ++m) _Pragma("unroll") for (int n = 0; n < 2; ++n) { \
        if constexpr (FP8) acc[ai][bj][m][n] = __builtin_amdgcn_mfma_scale_f32_16x16x128_f8f6f4(Bt##8[n], At##8[m], acc[ai][bj][m][n], 0, 0, 0, g.scB, 0, g.scA); \
        else { _Pragma("unroll") for (int k = 0; k < 2; ++k) acc[ai][bj][m][n] = __builtin_amdgcn_mfma_f32_16x16x32_bf16(Bt[n][k], At[m][k], acc[ai][bj][m][n], 0, 0, 0); } } \
        PG8_PINACC(ai, bj); __builtin_amdgcn_s_setprio(0); } while (0)
#define PG8_WAIT_V(n) asm volatile("s_waitcnt vmcnt(" #n ")" ::: "memory")
#define PG8_WAIT_L(n) asm volatile("s_waitcnt lgkmcnt(" #n ")" ::: "memory")
#define PG8_BAR __builtin_amdgcn_s_barrier()
#define PG8_SCHED __builtin_amdgcn_sched_barrier(0)
    Unit cur, nxt; int ui = 0;
    if (!S.next(0, cur)) return;
    f32x4 acc[2][2][4][2]; typename Epi::State est;
#pragma unroll
    for (int a = 0; a < 2; ++a)
#pragma unroll
        for (int b = 0; b < 2; ++b)
#pragma unroll
            for (int m = 0; m < 4; ++m)
#pragma unroll
                for (int n = 0; n < 2; ++n) acc[a][b][m][n] = (f32x4){0.f, 0.f, 0.f, 0.f};
    bf16x8 At[4][2], B0[2][2], B1[2][2]; v8i_t At8[4], B08[2], B18[2];
    const char* cA = (const char*)g.A + cur.aoff; const char* cB = (const char*)g.Bt + cur.boff;
    S.a_ready(cur);
    PG8_AOFFS(cvo, cur);
    if constexpr (SP2) {
        PG8_STAGE(PG8_SB(0, 0), cB, voffB); PG8_STAGE(PG8_SB(0, 1), cB + hstep, voffB); PG8_STAGE(PG8_SA(0, 0), cA, cvo[0]); PG8_STAGE(PG8_SA(0, 1), cA, cvo[1]);
        if (wr == 1) PG8_BAR;
        PG8_WAIT_V(2); PG8_BAR;
        PG8_STAGE(PG8_SB(1, 0), cB + kstep, voffB); PG8_STAGE(PG8_SA(1, 0), cA + kstep, cvo[0]); PG8_STAGE(PG8_SB(1, 1), cB + hstep + kstep, voffB);
        PG8_WAIT_V(6); PG8_BAR;
    }
    for (;;) {
        const bool has_next = S.next(ui + 1, nxt);
        const char* nA = has_next ? (const char*)g.A + nxt.aoff : cA; const char* nB = has_next ? (const char*)g.Bt + nxt.boff : cB;
#pragma unroll 1
        for (int t = 0; t < nt; t += 2) {
            if constexpr (Epi::MID) { if (t == nt / 2) E.mid(acc, est, cur, wr, fr); }
            const bool last = (t == nt - 2);
            const char* a1 = cA + (size_t)(t + 1) * kstep;
            const char* a2 = last ? nA : cA + (size_t)(t + 2) * kstep; const char* b2 = last ? nB : cB + (size_t)(t + 2) * kstep + ((t + 2 >= nth) ? cur.dboff : 0);
            unsigned xo[2][2];
            if constexpr (Sched::GATHER) { if (last && has_next) { PG8_AOFFS(xo, nxt); } else { xo[0][0] = cvo[0][0]; xo[0][1] = cvo[0][1]; xo[1][0] = cvo[1][0]; xo[1][1] = cvo[1][1]; } }
            else { xo[0][0] = cvo[0][0]; xo[0][1] = cvo[0][1]; xo[1][0] = cvo[1][0]; xo[1][1] = cvo[1][1]; }
            const char* a3 = a2 + kstep; const char* b3 = b2 + kstep;
            if (last && has_next) S.a_ready(nxt);
            if constexpr (SP2) {
            PG8_LDB(B0, 0, 0); PG8_LDB(B1, 0, 1); PG8_SCHED; PG8_LDA(At, 0, 0); PG8_STAGE(PG8_SA(1, 1), a1, cvo[1]);
            PG8_WAIT_V(8); PG8_WAIT_L(0); PG8_BAR; PG8_MMA(0, 0, At, B0); PG8_MMA(0, 1, At, B1); PG8_BAR; PG8_SCHED;
            PG8_LDA(At, 0, 1); PG8_STAGE(PG8_SB(0, 0), b2, voffB); PG8_STAGE(PG8_SB(0, 1), b2 + hstep, voffB); PG8_STAGE(PG8_SA(0, 0), a2, xo[0]);
            PG8_WAIT_V(8); PG8_WAIT_L(0); PG8_BAR; PG8_MMA(1, 0, At, B0); PG8_MMA(1, 1, At, B1); PG8_BAR; PG8_SCHED;
            PG8_LDB(B0, 1, 0); PG8_LDB(B1, 1, 1); PG8_SCHED; PG8_LDA(At, 1, 0); PG8_STAGE(PG8_SA(0, 1), a2, xo[1]);
            PG8_WAIT_V(8); PG8_WAIT_L(0); PG8_BAR; PG8_MMA(0, 0, At, B0); PG8_MMA(0, 1, At, B1); PG8_BAR; PG8_SCHED;
            PG8_LDA(At, 1, 1); PG8_STAGE(PG8_SB(1, 0), b3, voffB); PG8_STAGE(PG8_SB(1, 1), b3 + hstep, voffB); PG8_STAGE(PG8_SA(1, 0), a3, xo[0]);
            if constexpr (Sched::GATHER) { if (last) { cvo[0][0] = xo[0][0]; cvo[0][1] = xo[0][1]; cvo[1][0] = xo[1][0]; cvo[1][1] = xo[1][1]; } }
            PG8_WAIT_V(8); PG8_WAIT_L(0); PG8_BAR; PG8_MMA(1, 0, At, B0); PG8_MMA(1, 1, At, B1); PG8_BAR; PG8_SCHED;
            }
        }
        if constexpr (ALIGN_EPI) { if (wr == 0) PG8_BAR; }
        if constexpr (!Epi::AFTER_DRAIN) { E(acc, est, cur, wr, wc, fr, fq); S.done(cur); }
        if (!has_next) break;
#pragma unroll
        for (int a = 0; a < 2; ++a)
#pragma unroll
            for (int b = 0; b < 2; ++b)
#pragma unroll
                for (int m = 0; m < 4; ++m)
#pragma unroll
                    for (int n = 0; n < 2; ++n) acc[a][b][m][n] = (f32x4){0.f, 0.f, 0.f, 0.f};
        cur = nxt; cA = nA; cB = nB; ++ui;
        if constexpr (ALIGN_EPI) { if (wr == 1) PG8_BAR; }
    }
    PG8_WAIT_V(0);
    if constexpr (!ALIGN_EPI) { if (wr == 0) PG8_BAR; }
    PG8_BAR;
#undef PG8_SA
#undef PG8_SB
#undef PG8_STAGE
#undef PG8_AOFFS
#undef PG8_LDA
#undef PG8_LD16
#undef PG8_LDB
#undef PG8_MMA
#undef PG8_PINACC
#undef PG8_WAIT_V
#undef PG8_WAIT_L
#undef PG8_BAR
#undef PG8_SCHED
}
}
namespace attn_body {
using bf16=__hip_bfloat16;
using bf16x8=__attribute__((ext_vector_type(8)))short;
using s16x4=__attribute__((ext_vector_type(4)))short;
using f32x16=__attribute__((ext_vector_type(16)))float;
using u32x4=__attribute__((ext_vector_type(4)))unsigned;
constexpr int BATCH=4,NHEAD=8,SEQ=8192,D=64,DM=NHEAD*D,OPITCH=1024;
constexpr int NW=8,QBLK=32,QB=QBLK*NW,KVBLK=64,NQB=SEQ/QB;
constexpr int ATTN_PITCH=DM, ATTN_UNIT_ROWS=QB;
__device__ __forceinline__ int crow(int r,int hi){return (r&3)+8*(r>>2)+4*hi;}
#define SBAR() __builtin_amdgcn_sched_barrier(0)
__device__ __forceinline__ void cmask(f32x16&p0,f32x16&p1,int jb,int qrel,int hi){
  const float NEG=-INFINITY; int kb=64*jb+4*hi-qrel; asm volatile("":"+v"(kb));
  #pragma unroll
  for(int r=0;r<16;++r){const int c=(r&3)+8*(r>>2); if(kb>-c)p0[r]=NEG; if(kb>-c-32)p1[r]=NEG;}
}

constexpr int NSLOT=3, SLOTB=8192;
constexpr float TCUT=45.f;
constexpr int LDS_K=0, LDS_V=NSLOT*SLOTB, LDS_WS=2*NSLOT*SLOTB, LDS_OST=LDS_WS+NW*64*4, LDS_TAB=LDS_OST+NW*4096, LDS_BYTES=LDS_TAB+SEQ*8;
__device__ __forceinline__ void glds16(const void*gsrc,unsigned lds_dst){unsigned keep;
  asm volatile("s_mov_b32 %0, m0\n\ts_mov_b32 m0, %2\n\ts_nop 0\n\tglobal_load_lds_dwordx4 %1, off\n\ts_mov_b32 m0, %0":"=&s"(keep):"v"(gsrc),"s"(lds_dst):"memory");}
__device__ __forceinline__ void glds16s(const void*sbase,unsigned voff,unsigned lds_dst){unsigned keep;
  asm volatile("s_nop 4\n\ts_mov_b32 %0, m0\n\ts_mov_b32 m0, %3\n\ts_nop 0\n\tglobal_load_lds_dwordx4 %1, %2\n\ts_mov_b32 m0, %0":"=&s"(keep):"v"(voff),"s"(sbase),"s"(lds_dst):"memory");}
__device__ __forceinline__ float max3f(float a,float b,float c){float r;asm("v_max3_f32 %0, %1, %2, %3":"=v"(r):"v"(a),"v"(b),"v"(c));return r;}
__device__ __forceinline__ float max2f(float a,float b){float r;asm("v_max_f32_e32 %0, %1, %2":"=v"(r):"v"(a),"v"(b));return r;}
__device__ __forceinline__ float fadd_s(float a,float b){float r;asm("v_add_f32_e32 %0, %1, %2":"=v"(r):"v"(a),"v"(b));return r;}
__device__ __forceinline__ float fsub_s(float a,float b){float r;asm("v_sub_f32_e32 %0, %1, %2":"=v"(r):"v"(a),"v"(b));return r;}
typedef float f32x2_t __attribute__((ext_vector_type(2))); typedef __bf16 bf16x2_t __attribute__((ext_vector_type(2)));
__device__ __forceinline__ unsigned cvtpk_s(float lo,float hi){f32x2_t v={lo,hi};bf16x2_t b=__builtin_convertvector(v,bf16x2_t);return __builtin_bit_cast(unsigned,b);}
#define WAIT_BAR(N) asm volatile("s_waitcnt vmcnt(" #N ") lgkmcnt(0)\n\ts_barrier":::"memory")

__device__ __forceinline__ void qkt(f32x16&p0,f32x16&p1,const char*Kslot,const bf16x8*qr,const bf16x8 qx,const bf16x8 kx0,const bf16x8 kx1,int r32,int hi){
  const f32x16 negm=f32x16{};
  const char*kb=Kslot+hi*1024+r32*16;
  #pragma unroll
  for(int d0=0;d0<4;++d0){
    const bf16x8 b0=*reinterpret_cast<const bf16x8*>(kb+d0*2048);
    const bf16x8 b1=*reinterpret_cast<const bf16x8*>(kb+d0*2048+512);
    if(d0==0){p0=__builtin_amdgcn_mfma_f32_32x32x16_bf16(b0,qr[0],negm,0,0,0);p1=__builtin_amdgcn_mfma_f32_32x32x16_bf16(b1,qr[0],negm,0,0,0);}
    else{p0=__builtin_amdgcn_mfma_f32_32x32x16_bf16(b0,qr[d0],p0,0,0,0);p1=__builtin_amdgcn_mfma_f32_32x32x16_bf16(b1,qr[d0],p1,0,0,0);}}
  p0=__builtin_amdgcn_mfma_f32_32x32x16_bf16(kx0,qx,p0,0,0,0);p1=__builtin_amdgcn_mfma_f32_32x32x16_bf16(kx1,qx,p1,0,0,0);
}
typedef __attribute__((address_space(3))) const char* lds_cptr;
typedef short v4i16_t __attribute__((ext_vector_type(4)));
__device__ __forceinline__ void kload8(bf16x8*kf,lds_cptr kp){
  kf[0]=*(const __attribute__((address_space(3))) bf16x8*)(kp);      kf[1]=*(const __attribute__((address_space(3))) bf16x8*)(kp+512);
  kf[2]=*(const __attribute__((address_space(3))) bf16x8*)(kp+2048); kf[3]=*(const __attribute__((address_space(3))) bf16x8*)(kp+2560);
  kf[4]=*(const __attribute__((address_space(3))) bf16x8*)(kp+4096); kf[5]=*(const __attribute__((address_space(3))) bf16x8*)(kp+4608);
  kf[6]=*(const __attribute__((address_space(3))) bf16x8*)(kp+6144); kf[7]=*(const __attribute__((address_space(3))) bf16x8*)(kp+6656);
}
__device__ __forceinline__ void kload2(bf16x8*kf,lds_cptr kp,int j){ kf[2*j]=*(const __attribute__((address_space(3))) bf16x8*)(kp+j*2048); kf[2*j+1]=*(const __attribute__((address_space(3))) bf16x8*)(kp+j*2048+512); }
__device__ __forceinline__ s16x4 vtr(lds_cptr p){ return __builtin_bit_cast(s16x4,__builtin_amdgcn_ds_read_tr16_b64_v4i16((__attribute__((address_space(3))) v4i16_t*)p)); }
typedef unsigned u32x2_t __attribute__((ext_vector_type(2)));
__device__ __forceinline__ u32x2_t ldkx_raw(lds_cptr p){ return *(const __attribute__((address_space(3))) u32x2_t*)p; }
__device__ __forceinline__ bf16x8 mkkx(u32x2_t w){ const u32x4 v={w.x,w.y,0x3F803F80u,0u}; return __builtin_bit_cast(bf16x8,v); }
__device__ __forceinline__ bf16x8 ldkx(lds_cptr p){ const u32x2_t w=*(const __attribute__((address_space(3))) u32x2_t*)p; const u32x4 v={w.x,w.y,0x3F803F80u,0u}; return __builtin_bit_cast(bf16x8,v); }
__device__ __forceinline__ bf16x8 make_qx(float a,int hi){
  const unsigned ah=cvtpk_s(a,0.f)&0xffffu; const float r1=a-__uint_as_float(ah<<16);
  const unsigned am=cvtpk_s(r1,0.f)&0xffffu; const float r2=r1-__uint_as_float(am<<16);
  u32x4 v={0x3F803F80u,0x3F80u|(ah<<16),cvtpk_s(r1,r2),0u};
  if(hi){v=(u32x4){0u,0u,0u,0u};}
  return __builtin_bit_cast(bf16x8,v);
}
__device__ __forceinline__ float rowmax(const f32x16&p0,const f32x16&p1){
  float a=max3f(p0[0],p0[1],p1[0]),b=max3f(p0[2],p0[3],p1[1]);a=max3f(a,p1[2],p1[3]);
  #pragma unroll
  for(int r=4;r<16;r+=4){a=max3f(a,p0[r],p0[r+1]);b=max3f(b,p0[r+2],p0[r+3]);a=max3f(a,p1[r],p1[r+1]);b=max3f(b,p1[r+2],p1[r+3]);}
  const float m=max2f(a,b);
  auto rr=__builtin_amdgcn_permlane32_swap(__float_as_uint(m),__float_as_uint(m),false,false);
  return max2f(__uint_as_float(rr[0]),__uint_as_float(rr[1]));
}
__device__ __forceinline__ void pv(f32x16*o,int vb,bf16x8 pa0,bf16x8 pa1,bf16x8 pa2,bf16x8 pa3){
  #pragma unroll
  for(int d0=0;d0<2;++d0){s16x4 lo[4],hi[4];
    #pragma unroll
    for(int ks=0;ks<4;++ks){
      asm volatile("ds_read_b64_tr_b16 %0,%1 offset:%c2":"=&v"(lo[ks]):"v"(vb),"i"(d0*4096+ks*1024):"memory");
      asm volatile("ds_read_b64_tr_b16 %0,%1 offset:%c2":"=&v"(hi[ks]):"v"(vb),"i"(d0*4096+ks*1024+512):"memory");}
    asm volatile("s_waitcnt lgkmcnt(0)":::"memory");SBAR();
    #define PK(k) (bf16x8){lo[k][0],lo[k][1],lo[k][2],lo[k][3],hi[k][0],hi[k][1],hi[k][2],hi[k][3]}
    o[d0]=__builtin_amdgcn_mfma_f32_32x32x16_bf16(pa0,PK(0),o[d0],0,0,0);
    o[d0]=__builtin_amdgcn_mfma_f32_32x32x16_bf16(pa1,PK(1),o[d0],0,0,0);
    o[d0]=__builtin_amdgcn_mfma_f32_32x32x16_bf16(pa2,PK(2),o[d0],0,0,0);
    o[d0]=__builtin_amdgcn_mfma_f32_32x32x16_bf16(pa3,PK(3),o[d0],0,0,0);
    #undef PK
  }
}

#ifndef ATTN_STORE16
#define ATTN_STORE16(p,v) (*(u32x4*)(p)=(v))
#endif
template<int THRL> __device__ __forceinline__ void attn_unit(int b,int h,int qb,const bf16*Q,const bf16*__restrict__ K,const bf16*__restrict__ V,bf16*O,const unsigned long long*KX8,const float*GF,const float*QKB,float*SSQ,char*shm,const int tid){
  const int lane=tid&63,r32=lane&31,hi=lane>>5; const int wid=__builtin_amdgcn_readfirstlane(tid>>6);
  const long rowbase=(long)b*SEQ; const int q0=qb*QB;
  const bf16*Qw=Q+(rowbase+q0+wid*QBLK)*DM+h*D;
  const bf16*Kh=K+rowbase*DM+h*D,*Vh=V+rowbase*DM+h*D;
  const unsigned lds0=(unsigned)(uintptr_t)shm;
  float*wsf=(float*)(shm+LDS_WS)+wid*64;
  const bf16*ksrc=Kh+wid*8;
  const bf16*vsrc=Vh+(long)(16*(wid&3))*DM+(wid>>2)*32;
  const unsigned kvoff=(unsigned)lane*(DM*2), vvoff=(unsigned)((lane>>2)*DM+(lane&3)*8)*2u;
  const unsigned kdst=lds0+LDS_K+wid*1024, vdst=lds0+LDS_V+wid*1024;
  #define DMA_K(t,slot) glds16s(ksrc+(long)(NT-1-(t))*KVBLK*DM,kvoff,(unsigned)__builtin_amdgcn_readfirstlane(kdst+(slot)))
  #define DMA_V(t,slot) glds16s(vsrc+(long)(NT-1-(t))*KVBLK*DM,vvoff,(unsigned)__builtin_amdgcn_readfirstlane(vdst+(slot)))
  const int vb0=(int)(lds0+LDS_V)+((lane>>4)&1)*32+(lane&3)*8+(4*hi+((lane&15)>>2))*64;
  const char*Kbase=shm+LDS_K; bf16x8 kf[8];
  const lds_cptr shm3=(lds_cptr)shm; const lds_cptr kp0=shm3+LDS_K+hi*1024+r32*16; const lds_cptr vp0=shm3+LDS_V+((lane>>4)&1)*32+(lane&3)*8+(4*hi+((lane&15)>>2))*64;
  const int NT=(q0+QB)/KVBLK;
  const lds_cptr tp0=shm3+LDS_TAB+r32*8;
  const float nGi=-GF[(long)(b*NHEAD+h)*SEQ+q0+wid*QBLK+r32];
  float gl0,gl1,gthr,bqk;
  { const float*gfh=GF+(long)(b*NHEAD+h)*SEQ; gl0=(lane<NT)?gfh[64*lane+63]:3.0e38f; gl1=(lane+64<NT)?gfh[64*(lane+64)+63]:3.0e38f;
    float kp=QKB[(b*NHEAD+h)*16+(lane&15)];
    #define DPPMAX_(v,c) fmaxf((v),__builtin_bit_cast(float,__builtin_amdgcn_update_dpp(0,__builtin_bit_cast(int,(v)),(c),0xf,0xf,false)))
    kp=DPPMAX_(kp,0xB1);kp=DPPMAX_(kp,0x4E);kp=DPPMAX_(kp,0x141);kp=DPPMAX_(kp,0x140);
    #undef DPPMAX_
    const float bq=2.04f*sqrtf(QKB[512+(b*NHEAD+h)*32+qb]*kp);
    gthr=gfh[q0]-(TCUT+2.f*bq); bqk=bq; }
  DMA_K(0,0);DMA_V(0,0);DMA_K(1,SLOTB);
  bf16x8 qr[4];
  #pragma unroll
  for(int d0=0;d0<4;++d0)qr[d0]=*reinterpret_cast<const bf16x8*>(&Qw[(long)r32*DM+d0*16+hi*8]);
  { float dd=0.f; const bf16*Kd=Kh+(long)(q0+wid*QBLK+r32)*DM+hi*8;
    #pragma unroll
    for(int d0=0;d0<4;++d0){ const bf16x8 kk=*reinterpret_cast<const bf16x8*>(Kd+d0*16);
      #pragma unroll
      for(int j=0;j<8;++j)dd+=__uint_as_float((unsigned)(unsigned short)qr[d0][j]<<16)*__uint_as_float((unsigned)(unsigned short)kk[j]<<16); }
    { const auto rr=__builtin_amdgcn_permlane32_swap(__float_as_uint(dd),__float_as_uint(dd),false,false); dd=__uint_as_float(rr[0])+__uint_as_float(rr[1]); }
    float vm=dd-nGi;
    #define DPPMIN_(v,c) fminf((v),__builtin_bit_cast(float,__builtin_amdgcn_update_dpp(0,__builtin_bit_cast(int,(v)),(c),0xf,0xf,false)))
    vm=DPPMIN_(vm,0xB1);vm=DPPMIN_(vm,0x4E);vm=DPPMIN_(vm,0x141);vm=DPPMIN_(vm,0x140);
    #undef DPPMIN_
    { const auto rr=__builtin_amdgcn_permlane16_swap(__float_as_uint(vm),__float_as_uint(vm),false,false); vm=fminf(__uint_as_float(rr[0]),__uint_as_float(rr[1])); }
    if(lane==0)wsf[0]=vm; }
  int NS=NT;
  { const int cnt=__builtin_popcountll(__ballot(gl0<gthr))+__builtin_popcountll(__ballot(gl1<gthr)); int tlo=cnt&~1; if(tlo>NT-4)tlo=NT-4; NS=__builtin_amdgcn_readfirstlane(NT-tlo); }
  { const char*tsrc=(const char*)(KX8+(long)(b*NHEAD+h)*SEQ); const int npc=2*(qb+1);
    for(int pc=((NT-NS)>>1)+wid;pc<npc;pc+=NW)glds16s(tsrc+(long)pc*1024,(unsigned)lane*16u,(unsigned)__builtin_amdgcn_readfirstlane(lds0+LDS_TAB+pc*1024)); }
  float mhat=0.f,l_reg=0.f;f32x16 o[2];o[0]=f32x16{};o[1]=f32x16{};bf16x8 qx=make_qx(nGi,hi);const f32x16 zc=f32x16{};
  if(hi==0)wsf[32+r32]=nGi;
  const int qrel=wid*QBLK+r32;
  #define CMASK(P0,P1,t) do{int jb_=3-(t); if(jb_>=0)cmask(P0,P1,jb_,qrel,hi);}while(0)
  bool resc=false;
  #define START(P0,P1) do{ const float rm=rowmax(P0,P1); resc=false; \
    { const float dl=(rm<-1e30f)?0.f:rm; mhat=fadd_s(mhat,dl); \
      _Pragma("unroll") for(int r=0;r<16;++r){P0[r]=fsub_s(P0[r],dl);P1[r]=fsub_s(P1[r],dl);} \
      qx=make_qx(nGi-mhat,hi); } \
    _Pragma("unroll") for(int r=0;r<16;++r)P0[r]=__builtin_amdgcn_exp2f(P0[r]); }while(0)
  #define RESC() do{ if(resc){ asm volatile("s_waitcnt lgkmcnt(0)":::"memory"); \
      _Pragma("unroll") for(int d_=0;d_<2;++d_) _Pragma("unroll") for(int r=0;r<16;++r)o[d_][r]*=wsf[crow(r,hi)]; } }while(0)
  f32x16 pA0,pA1,pB0,pB1;
  int sl_prev=0,sl_cur=0,sl_next=SLOTB;
  #define ROT() do{sl_prev=sl_cur;sl_cur=sl_next;sl_next=(sl_next==(NSLOT-1)*SLOTB)?0:sl_next+SLOTB;}while(0)
  DMA_K(2,2*SLOTB);
  WAIT_BAR(1);
  { float bm=((const float*)(shm+LDS_WS))[0];
    #pragma unroll
    for(int w_=1;w_<NW;++w_)bm=fminf(bm,((const float*)(shm+LDS_WS))[w_*64]);
    const float gthr2=bm-bqk-TCUT-0.05f;
    const int cnt=__builtin_popcountll(__ballot(gl0<gthr2))+__builtin_popcountll(__ballot(gl1<gthr2)); int tlo=cnt&~1; if(tlo>NT-4)tlo=NT-4; const int ns2=__builtin_amdgcn_readfirstlane(NT-tlo); if(ns2<NS)NS=ns2; }
  qkt(pA0,pA1,Kbase,qr,qx,ldkx(tp0+(NT-1)*512),ldkx(tp0+(NT-1)*512+256),r32,hi);asm volatile("s_nop 15\n\ts_nop 7":"+v"(pA0),"+v"(pA1));CMASK(pA0,pA1,0);
  START(pA0,pA1);
  _Pragma("unroll") for(int r=0;r<16;++r)pA1[r]=__builtin_amdgcn_exp2f(pA1[r]);
  WAIT_BAR(0);
  DMA_K(3,0);DMA_V(1,SLOTB);
  ROT();
  kload8(kf,kp0+sl_cur);
  WAIT_BAR(2);
  s16x4 vlo[8],vhi[8]; u32x4 pw0,pw1,pw2,pw3;
  #define PKW(P,B) cvtpk_s(P[B],P[B+1])
  #define PAF(k) __builtin_bit_cast(bf16x8,pw##k)
  #define VFR(i) (bf16x8){vlo[i][0],vlo[i][1],vlo[i][2],vlo[i][3],vhi[i][0],vhi[i][1],vhi[i][2],vhi[i][3]}
  #define PIN(x) asm volatile("":"+v"(x))
  #define MX3(a,b,c) __builtin_fmaxf(__builtin_fmaxf((a),(b)),(c))
  #define GAPA(MF,A0,A1,A2,A3,W0,W1,PW) do{ MF; sacc+=A0; sacc+=A1; sacc+=A2; sacc+=A3; PIN(sacc); W0; W1; PIN(PW); SBAR(); }while(0)
  #define EX(v) __builtin_amdgcn_exp2f(v)
  #define GAPB(MF,X,B) do{ MF; X[B]=EX(X[B]); X[B+1]=EX(X[B+1]); X[B+2]=EX(X[B+2]); X[B+3]=EX(X[B+3]); PIN(X); SBAR(); }while(0)
  #define VRD(i) do{ vlo[i]=vtr(vp_+(((i)>>2)*4096+((i)&3)*1024)); vhi[i]=vtr(vp_+(((i)>>2)*4096+((i)&3)*1024+512)); }while(0)
  #define KRD(G,j) do{ if(G){ kload2(kf,kp0+sl_next,j); SBAR(); } }while(0)
  #define STEP(C0,C1,P0,P1,t,GK,GV,GL) do{ SBAR(); \
    const lds_cptr vp_=vp0+sl_prev; \
    const u32x2_t kq0_=ldkx_raw(tp0+(NT-1-(t))*512), kq1_=ldkx_raw(tp0+(NT-1-(t))*512+256); \
    VRD(0); SBAR(); float sacc=(P0[0]+P0[1]); \
    GAPA(C0=__builtin_amdgcn_mfma_f32_32x32x16_bf16(kf[0],qr[0],zc,0,0,0), P0[2],P0[3],P0[4],P0[5],     pw0[0]=PKW(P0,0), pw0[1]=PKW(P0,2), pw0); \
    VRD(4); SBAR(); GAPA(C1=__builtin_amdgcn_mfma_f32_32x32x16_bf16(kf[1],qr[0],zc,0,0,0), P0[6],P0[7],P0[8],P0[9],     pw0[2]=PKW(P0,4), pw0[3]=PKW(P0,6), pw0); \
    C0=__builtin_amdgcn_mfma_f32_32x32x16_bf16(mkkx(kq0_),qx,C0,0,0,0); SBAR(); C1=__builtin_amdgcn_mfma_f32_32x32x16_bf16(mkkx(kq1_),qx,C1,0,0,0); SBAR(); \
    VRD(1); SBAR(); GAPA(C0=__builtin_amdgcn_mfma_f32_32x32x16_bf16(kf[2],qr[1],C0,0,0,0),   P0[10],P0[11],P0[12],P0[13], pw1[0]=PKW(P0,8), pw1[1]=PKW(P0,10), pw1); \
    VRD(5); SBAR(); GAPA(C1=__builtin_amdgcn_mfma_f32_32x32x16_bf16(kf[3],qr[1],C1,0,0,0),   P0[14],P0[15],P1[0],P1[1],   pw1[2]=PKW(P0,12),pw1[3]=PKW(P0,14), pw1); \
    VRD(2); SBAR(); GAPA(C0=__builtin_amdgcn_mfma_f32_32x32x16_bf16(kf[4],qr[2],C0,0,0,0),   P1[2],P1[3],P1[4],P1[5],     pw2[0]=PKW(P1,0), pw2[1]=PKW(P1,2), pw2); \
    VRD(6); SBAR(); GAPA(C1=__builtin_amdgcn_mfma_f32_32x32x16_bf16(kf[5],qr[2],C1,0,0,0),   P1[6],P1[7],P1[8],P1[9],     pw2[2]=PKW(P1,4), pw2[3]=PKW(P1,6), pw2); \
    VRD(3); SBAR(); GAPA(C0=__builtin_amdgcn_mfma_f32_32x32x16_bf16(kf[6],qr[3],C0,0,0,0),   P1[10],P1[11],P1[12],P1[13], pw3[0]=PKW(P1,8), pw3[1]=PKW(P1,10), pw3); \
    VRD(7); SBAR(); GAPA(C1=__builtin_amdgcn_mfma_f32_32x32x16_bf16(kf[7],qr[3],C1,0,0,0),   P1[14],P1[15],0.f,0.f,       pw3[2]=PKW(P1,12),pw3[3]=PKW(P1,14), pw3); \
    l_reg+=sacc; \
    if(GK){DMA_K((t)+3,sl_cur);} if(GV){DMA_V((t)+1,sl_next);} \
    CMASK(C0,C1,t); \
    { float a=MX3(C0[0],C0[1],C1[0]),b=MX3(C0[2],C0[3],C1[1]); a=MX3(a,C1[2],C1[3]); \
      _Pragma("unroll") for(int r=4;r<16;r+=4){a=MX3(a,C0[r],C0[r+1]);b=MX3(b,C0[r+2],C0[r+3]);a=MX3(a,C1[r],C1[r+1]);b=MX3(b,C1[r+2],C1[r+3]);} \
      float rm=__builtin_fmaxf(a,b); { auto rr=__builtin_amdgcn_permlane32_swap(__float_as_uint(rm),__float_as_uint(rm),false,false); rm=__builtin_fmaxf(__uint_as_float(rr[0]),__uint_as_float(rr[1])); } \
      resc=false; \
      if(__builtin_expect(__any(rm>(float)THRL),0)){ const float dl=__builtin_fmaxf(rm,0.f); mhat+=dl; \
        _Pragma("unroll") for(int r=0;r<16;++r){C0[r]-=dl;C1[r]-=dl;} \
        qx=make_qx(wsf[32+r32]-mhat,hi); \
        const float f=__builtin_amdgcn_exp2f(-dl); l_reg*=f; if(hi==0)wsf[r32]=f; resc=true; } } \
    SBAR(); \
    GAPB(o[0]=__builtin_amdgcn_mfma_f32_32x32x16_bf16(PAF(0),VFR(0),o[0],0,0,0), C0,0); \
    GAPB(o[1]=__builtin_amdgcn_mfma_f32_32x32x16_bf16(PAF(0),VFR(4),o[1],0,0,0), C0,4); \
    KRD(GL,0); GAPB(o[0]=__builtin_amdgcn_mfma_f32_32x32x16_bf16(PAF(1),VFR(1),o[0],0,0,0), C0,8); \
    KRD(GL,1); GAPB(o[1]=__builtin_amdgcn_mfma_f32_32x32x16_bf16(PAF(1),VFR(5),o[1],0,0,0), C0,12); \
    KRD(GL,2); GAPB(o[0]=__builtin_amdgcn_mfma_f32_32x32x16_bf16(PAF(2),VFR(2),o[0],0,0,0), C1,0); \
    KRD(GL,3); GAPB(o[1]=__builtin_amdgcn_mfma_f32_32x32x16_bf16(PAF(2),VFR(6),o[1],0,0,0), C1,4); \
    GAPB(o[0]=__builtin_amdgcn_mfma_f32_32x32x16_bf16(PAF(3),VFR(3),o[0],0,0,0), C1,8); \
    GAPB(o[1]=__builtin_amdgcn_mfma_f32_32x32x16_bf16(PAF(3),VFR(7),o[1],0,0,0), C1,12); \
    }while(0)
  int t=1;
  #define ENDW(tt) do{ if((tt)+3<NS){WAIT_BAR(2);} else if((tt)+2<NS){WAIT_BAR(1);} else {WAIT_BAR(0);} }while(0)
  for(;t<5&&t+1<NS;t+=2){
    STEP(pB0,pB1,pA0,pA1,t,(t+3<NS),(t+1<NS),(t+1<NS));       ENDW(t);   RESC(); ROT();
    STEP(pA0,pA1,pB0,pB1,t+1,(t+4<NS),(t+2<NS),(t+2<NS));     ENDW(t+1); RESC(); ROT();
  }
  #undef CMASK
  #define CMASK(P0,P1,t) do{}while(0)
  for(;t+5<NS;t+=2){
    STEP(pB0,pB1,pA0,pA1,t,true,true,true);     WAIT_BAR(2); RESC(); ROT();
    STEP(pA0,pA1,pB0,pB1,t+1,true,true,true);   WAIT_BAR(2); RESC(); ROT();
  }
  #undef CMASK
  #define CMASK(P0,P1,t) do{int jb_=3-(t); if(jb_>=0)cmask(P0,P1,jb_,qrel,hi);}while(0)
  for(;t+1<NS;t+=2){
    STEP(pB0,pB1,pA0,pA1,t,(t+3<NS),(t+1<NS),(t+1<NS));       ENDW(t);   RESC(); ROT();
    STEP(pA0,pA1,pB0,pB1,t+1,(t+4<NS),(t+2<NS),(t+2<NS));     ENDW(t+1); RESC(); ROT();
  }
  STEP(pB0,pB1,pA0,pA1,NS-1,false,false,false); RESC();
  { float sacc=pB0[0]+pB0[1]; _Pragma("unroll") for(int r=2;r<16;++r)sacc+=pB0[r]; _Pragma("unroll") for(int r=0;r<16;++r)sacc+=pB1[r]; l_reg+=sacc;
    pw0=(u32x4){PKW(pB0,0),PKW(pB0,2),PKW(pB0,4),PKW(pB0,6)};pw1=(u32x4){PKW(pB0,8),PKW(pB0,10),PKW(pB0,12),PKW(pB0,14)};pw2=(u32x4){PKW(pB1,0),PKW(pB1,2),PKW(pB1,4),PKW(pB1,6)};pw3=(u32x4){PKW(pB1,8),PKW(pB1,10),PKW(pB1,12),PKW(pB1,14)};
    SBAR(); pv(o,vb0+sl_cur,PAF(0),PAF(1),PAF(2),PAF(3)); }
  #undef PKW
  #undef PAF
  #undef VFR
  #undef PIN
  #undef MX3
  #undef GAPA
  #undef GAPB
  #undef EX
  #undef VRD
  #undef KRD
  #undef STEP
  #undef ENDW
  {auto rr=__builtin_amdgcn_permlane32_swap(__float_as_uint(l_reg),__float_as_uint(l_reg),false,false);l_reg=__uint_as_float(rr[0])+__uint_as_float(rr[1]);}
  if(hi==0)wsf[32+r32]=l_reg;asm volatile("s_waitcnt lgkmcnt(0)":::"memory");
  float rli[16];
  #pragma unroll
  for(int r=0;r<16;++r)rli[r]=__builtin_amdgcn_rcpf(wsf[32+crow(r,hi)]);
  bf16*Ow=O+(rowbase+q0+wid*QBLK)*OPITCH+h*D;
  { bf16*stg=(bf16*)(shm+LDS_OST)+wid*2048;
    #pragma unroll
    for(int r=0;r<16;++r){const int orow=crow(r,hi);
      #pragma unroll
      for(int d0=0;d0<2;++d0)stg[orow*64+d0*32+r32]=__float2bfloat16(o[d0][r]*rli[r]);}
    asm volatile("s_waitcnt lgkmcnt(0)":::"memory");
    #pragma unroll
    for(int i=0;i<4;++i){const int row=i*8+(lane>>3),ch=lane&7; const u32x4 v=*(const u32x4*)(stg+row*64+ch*8); ATTN_STORE16(Ow+(long)row*OPITCH+ch*8,v);
      float q=0.f;
      #pragma unroll
      for(int e=0;e<4;++e){const float lo=__uint_as_float(v[e]<<16),hh=__uint_as_float(v[e]&0xffff0000u);q+=lo*lo+hh*hh;}
      q+=__shfl_xor(q,1);q+=__shfl_xor(q,2);q+=__shfl_xor(q,4);
      if(ch==0)SSQ[(rowbase+q0+wid*QBLK+row)*16+8+h]=q;} }
  asm volatile("s_waitcnt lgkmcnt(0)\n\ts_barrier":::"memory");
  #undef DMA_K
  #undef DMA_V
  #undef CMASK
  #undef START
  #undef RESC
  #undef ROT
}
constexpr int ATTN_LDS_BYTES=LDS_BYTES;
struct AttnTensors { const bf16* Q; const bf16* K; const bf16* V; bf16* O; const unsigned long long* KX8; const float* GF; const float* QKB; float* SSQ; };
struct AttnUnit { int bh; int qb; };
struct StaticOrder {
  int vcu;
  __device__ __forceinline__ explicit StaticOrder(int grid,int block):vcu((block%8)*(grid/8)+block/8){}
  __device__ __forceinline__ bool next(int i,AttnUnit&u)const{ if(i>=4)return false; const int s=vcu&7; u.bh=((vcu>>3)+8*i)&31;     u.qb=(i==0)?s:(i==1)?15-s:(i==2)?16+s:31-s; return true; }
  __device__ __forceinline__ void a_ready(const AttnUnit&)const{}
  __device__ __forceinline__ void done(const AttnUnit&)const{}
};
template<class Sched,int THRL=8> __device__ __forceinline__ void attn_phase(char*lds,const AttnTensors&T,const Sched&S,const int tid){
  AttnUnit u;
  for(int i=0;S.next(i,u);++i){ S.a_ready(u); attn_unit<THRL>(u.bh/NHEAD,u.bh%NHEAD,u.qb,T.Q,T.K,T.V,T.O,T.KX8,T.GF,T.QKB,T.SSQ,lds,tid); S.done(u); }
}
#undef SBAR
#undef WAIT_BAR
}

constexpr int NWAVES = 8;
constexpr int N_PHASES = 11;
constexpr int N_LAUNCHES = MK_N_LAUNCHES;

constexpr size_t MiB = 1u << 20;
constexpr size_t WS_CTL = 0, CTL_ZERO_BYTES = 64 * 1024;
constexpr size_t WS_ADAP = 14 * MiB;
constexpr size_t WS_ADA = 2 * MiB;
constexpr size_t WS_WSM = WS_ADA + 128 * 1024;
constexpr size_t WS_LC = 3 * MiB;
constexpr size_t WS_CT = 4 * MiB;
constexpr size_t WS_TOKC = WS_CT + 64 * 1024;
constexpr size_t WS_TW = WS_TOKC + 256 * 1024;
constexpr size_t WS_SSQY = 5 * MiB;
constexpr size_t WS_SSQ1 = 7 * MiB;
constexpr size_t WS_SSQ2 = 9 * MiB;
constexpr size_t WS_INV = 11 * MiB;
constexpr size_t WS_TOK = 14 * MiB;
constexpr size_t WS_SW = WS_TOK + 256 * 1024;
constexpr size_t WS_WIN = 16 * MiB;
constexpr size_t WS_WOUT = 22 * MiB;
constexpr size_t WS_WGU = 24 * MiB;
constexpr size_t WS_WD = 56 * MiB;
constexpr size_t WS_XN = 104 * MiB;
constexpr size_t WS_U = 168 * MiB;
constexpr size_t WS_Y = 328 * MiB;
constexpr size_t WS_H2 = WS_XN;
constexpr size_t WS_H2S = 168 * MiB;
constexpr size_t WS_ACT = 244 * MiB;
constexpr size_t WS_KX8 = 392 * MiB;
constexpr size_t WS_GF = 394 * MiB;
constexpr size_t WS_MIX = 396 * MiB;
constexpr size_t WS_MOE = WS_XN;
constexpr size_t WS_X1 = WS_Y;
constexpr size_t WS_END = 460 * MiB;
static_assert(WS_ACT + (size_t)MAXTILES * 256 * 1024 * 2 <= WS_Y && WS_H2S + (size_t)MAXTILES * 256 * 1024 * 2 <= WS_ACT, "d_ws map");
constexpr int CW_TMO = 0, CW_CODE = 1;
constexpr int CW_CNT = 64, CNT_STRIDE = 64;
constexpr int CW_QKB = 2048;
constexpr int CW_BAR = 4096;
constexpr int RING_OFF = 0, RING_BYTES = 155648;
constexpr int LDSCTL_OFF = RING_BYTES, MISC_OFF = LDSCTL_OFF + 320;
constexpr int TCLS_OFF = LDSCTL_OFF + 512;
constexpr int TFIRST_OFF = LDSCTL_OFF + 704;
constexpr int LCNT_OFF = LDSCTL_OFF + 768;
constexpr int TOKU_OFF = LDSCTL_OFF + 1024;
constexpr int LDS_BYTES = 163840;

#define GAS __attribute__((address_space(1)))
#define LAS __attribute__((address_space(3)))
typedef unsigned short bf16;
typedef unsigned v4u __attribute__((ext_vector_type(4)));
typedef float f32x4 __attribute__((ext_vector_type(4)));
typedef short bf16x8 __attribute__((ext_vector_type(8)));
typedef GAS unsigned gu32;
typedef GAS unsigned long long gu64;
#define RLX_AGENT __ATOMIC_RELAXED, __HIP_MEMORY_SCOPE_AGENT
#define LDS_WAIT() asm volatile("s_waitcnt lgkmcnt(0)" ::: "memory")
#define VM_WAIT() asm volatile("s_waitcnt vmcnt(0)" ::: "memory")
__device__ __forceinline__ unsigned long long rt() { return __builtin_amdgcn_s_memrealtime(); }
__device__ __forceinline__ unsigned f2bf(float f) { unsigned u = __builtin_bit_cast(unsigned, f); return (u + 0x7fffu + ((u >> 16) & 1u)) >> 16; }
typedef float f32x2_hw __attribute__((ext_vector_type(2))); typedef __bf16 bf16x2_hw __attribute__((ext_vector_type(2)));
__device__ __forceinline__ unsigned pk2(float lo, float hi) { const f32x2_hw v = {lo, hi}; const bf16x2_hw b = __builtin_convertvector(v, bf16x2_hw); return __builtin_bit_cast(unsigned, b); }

#define XB_TMO      128
#define XB_XCNT(j)  (256  + 64 * (j))
#define XB_XSUB(j)  (1280 + 64 * (j))
#define XB_XGEN(j)  (2304 + 64 * (j))
#define XB_TOP      3328
#define XB_TOPGEN   3392
#define XCD_BAR_WORDS 3456
#define XB_SPIN_CAP (1u << 18)

__device__ __forceinline__ unsigned xb_ld(unsigned* p)              { return __hip_atomic_load(p, __ATOMIC_RELAXED, __HIP_MEMORY_SCOPE_AGENT); }
__device__ __forceinline__ unsigned xb_add(unsigned* p, unsigned v) { return __hip_atomic_fetch_add(p, v, __ATOMIC_RELAXED, __HIP_MEMORY_SCOPE_AGENT); }
__device__ __forceinline__ unsigned xb_xcc_id() { return (unsigned)__builtin_amdgcn_s_getreg((3 << 11) | 20) & 0xFu; }
#define XB_SPIN(cond, bar) do { unsigned _sp = 0; while (cond) { __builtin_amdgcn_s_sleep(1); \
    if ((++_sp & 255u) == 0u) { if (xb_ld(&(bar)[XB_TMO])) break; if (_sp > XB_SPIN_CAP) { atomicAdd(&(bar)[XB_TMO], 1u); break; } } } } while (0)

struct XcdBarrier {
    unsigned* bar; unsigned x;
    volatile LAS unsigned* st;
};

__device__ __forceinline__ XcdBarrier xcd_barrier_post(unsigned* bar, volatile LAS unsigned* st) {
    XcdBarrier b; b.bar = bar; b.x = xb_xcc_id(); b.st = st;
    if (threadIdx.x == 0) (void)xb_add(&bar[XB_XCNT(b.x)], 1u);
    return b;
}
__device__ __forceinline__ void xcd_barrier_complete(unsigned* bar, unsigned x, unsigned& nloc, unsigned& nx) {
    const unsigned G = gridDim.x * gridDim.y * gridDim.z;
    unsigned sum, cnt, mine, sp = 0u;
    for (;;) {
        sum = 0u; cnt = 0u; mine = 0u;
#pragma unroll
        for (unsigned j = 0; j < 16; ++j) { const unsigned c = xb_ld(&bar[XB_XCNT(j)]); sum += c; cnt += (c > 0u) ? 1u : 0u; mine = (j == x) ? c : mine; }
        if (sum == G) break;
        __builtin_amdgcn_s_sleep(1);
        if ((++sp & 255u) == 0u) { if (xb_ld(&bar[XB_TMO])) break; if (sp > XB_SPIN_CAP) { atomicAdd(&bar[XB_TMO], 1u); break; } }
    }
    nloc = mine > 0u ? mine : 1u; nx = cnt > 0u ? cnt : 1u;
}

__device__ __forceinline__ void xcd_barrier(const XcdBarrier& b) {
    asm volatile("s_waitcnt vmcnt(0)" ::: "memory");
    __syncthreads();
    if (threadIdx.x == 0) {
        unsigned* bar = b.bar;
        __builtin_amdgcn_s_waitcnt(0);
        unsigned nloc = b.st[0], nx = b.st[1];
        if (nloc == 0u) { xcd_barrier_complete(bar, b.x, nloc, nx); b.st[0] = nloc; b.st[1] = nx; }
        const unsigned old = xb_add(&bar[XB_XSUB(b.x)], 1u);
        const unsigned gen = old / nloc;
        if (old + 1u == (gen + 1u) * nloc) {
            __builtin_amdgcn_fence(__ATOMIC_RELEASE, "agent");
            asm volatile("s_waitcnt vmcnt(0)" ::: "memory");
            const unsigned og = xb_add(&bar[XB_TOP], 1u);
            const unsigned tg = og / nx;
            if (og + 1u == (tg + 1u) * nx) xb_add(&bar[XB_TOPGEN], 1u);
            else XB_SPIN(xb_ld(&bar[XB_TOPGEN]) == tg, bar);
            __builtin_amdgcn_fence(__ATOMIC_ACQUIRE, "agent");
            xb_add(&bar[XB_XGEN(b.x)], 1u);
            asm volatile("s_waitcnt vmcnt(0)" ::: "memory");
        } else {
            XB_SPIN(xb_ld(&bar[XB_XGEN(b.x)]) == gen, bar);
            __builtin_amdgcn_fence(__ATOMIC_ACQUIRE, "agent");
            asm volatile("s_waitcnt vmcnt(0)" ::: "memory");
        }
    }
    __syncthreads();
}

struct Frame {
    LAS unsigned char* lds;
    volatile LAS unsigned* MISC;
    gu32* ctl;
    int tid, lane, wave;
    int vcu, G;
    unsigned char* ws;
    const float *x, *c, *w_ada, *b_ada, *g_mix, *w_in, *g_sgu, *w_sp, *b_sp, *b_fg, *g_osgu, *g_ofox, *w_out, *g_ffn, *w_rg, *b_rg, *w_re, *b_re, *w_gate, *w_up, *w_down, *g_fin;
    float* out;
};
#define DPP_ADD(v, ctrl) ((v) + __builtin_bit_cast(float, __builtin_amdgcn_update_dpp(0, __builtin_bit_cast(int, (v)), (ctrl), 0xf, 0xf, false)))
__device__ __forceinline__ float wave_sum(float v) {
    v = DPP_ADD(v, 0xB1); v = DPP_ADD(v, 0x4E); v = DPP_ADD(v, 0x141); v = DPP_ADD(v, 0x140);
    const int iv = __builtin_bit_cast(int, v);
    const float a = __builtin_bit_cast(float, __builtin_amdgcn_readlane(iv, 0)), b = __builtin_bit_cast(float, __builtin_amdgcn_readlane(iv, 16)), c = __builtin_bit_cast(float, __builtin_amdgcn_readlane(iv, 32)), e = __builtin_bit_cast(float, __builtin_amdgcn_readlane(iv, 48));
    return (a + b) + (c + e);
}
#define DPP_MOV(v, ctrl) __builtin_bit_cast(float, __builtin_amdgcn_update_dpp(0, __builtin_bit_cast(int, (v)), (ctrl), 0xf, 0xf, false))
#define SWZ_ADD(v, pat) ((v) + __builtin_bit_cast(float, __builtin_amdgcn_ds_swizzle(__builtin_bit_cast(int, (v)), (pat))))
__device__ __forceinline__ float sum_b2_b5(float v) { v = SWZ_ADD(v, 0x101F); v = SWZ_ADD(v, 0x201F); v = SWZ_ADD(v, 0x401F);
    const auto rr = __builtin_amdgcn_permlane32_swap(__float_as_uint(v), __float_as_uint(v), false, false); return __uint_as_float(rr[0]) + __uint_as_float(rr[1]); }
__device__ __forceinline__ void wave_sum8_t(const float (&v)[8], int lane, float& r0, float& r1) {
    const bool b0 = (lane & 1) != 0, b1 = (lane & 2) != 0; float a[4], c[2];
#pragma unroll
    for (int i = 0; i < 4; ++i) { const float keep = b0 ? v[i + 4] : v[i], send = b0 ? v[i] : v[i + 4]; a[i] = keep + DPP_MOV(send, 0xB1); }
#pragma unroll
    for (int i = 0; i < 2; ++i) { const float keep = b1 ? a[i + 2] : a[i], send = b1 ? a[i] : a[i + 2]; c[i] = keep + DPP_MOV(send, 0x4E); }
    r0 = sum_b2_b5(c[0]); r1 = sum_b2_b5(c[1]);
}
__device__ __forceinline__ void wave_sum4_all(float (&v)[4], int lane) {
    const bool b0 = (lane & 1) != 0, b1 = (lane & 2) != 0; float a[2];
#pragma unroll
    for (int i = 0; i < 2; ++i) { const float keep = b0 ? v[i + 2] : v[i], send = b0 ? v[i] : v[i + 2]; a[i] = keep + DPP_MOV(send, 0xB1); }
    const float keep = b1 ? a[1] : a[0], send = b1 ? a[0] : a[1]; float c = keep + DPP_MOV(send, 0x4E);
    c = sum_b2_b5(c); const int ic = __builtin_bit_cast(int, c);
    v[0] = __builtin_bit_cast(float, __builtin_amdgcn_readlane(ic, 0)); v[1] = __builtin_bit_cast(float, __builtin_amdgcn_readlane(ic, 2)); v[2] = __builtin_bit_cast(float, __builtin_amdgcn_readlane(ic, 1)); v[3] = __builtin_bit_cast(float, __builtin_amdgcn_readlane(ic, 3));
}
__device__ __forceinline__ float wave_max(float v) {
#pragma unroll
    for (int o = 1; o < 64; o <<= 1) v = fmaxf(v, __shfl_xor(v, o));
    return v;
}
__device__ __forceinline__ int lane_id_fresh() { int t, l; asm volatile("v_mbcnt_lo_u32_b32 %0, -1, 0" : "=v"(t)); asm volatile("v_mbcnt_hi_u32_b32 %0, -1, %1" : "=v"(l) : "v"(t)); return l; }
__device__ __forceinline__ float bf2f(unsigned short h) { return __uint_as_float((unsigned)h << 16); }

__device__ __forceinline__ void p0_tr_item(const float* W, int ldw, int k0, int n0, bf16* dst, int ldt, const float* kscale, LAS float* scr, int lane) {
    typedef float f32x2_t __attribute__((ext_vector_type(2)));
    f32x2_t tv[32];
#pragma unroll
    for (int i = 0; i < 32; ++i) { const int kk = 2 * i + (lane >> 5); tv[i] = *(const f32x2_t*)(W + (size_t)(k0 + kk) * ldw + n0 + 2 * (lane & 31)); }
    if (kscale) {
#pragma unroll
        for (int i = 0; i < 32; ++i) tv[i] = tv[i] * kscale[k0 + 2 * i + (lane >> 5)]; }
#pragma unroll
    for (int i = 0; i < 32; ++i) { LAS float* p = scr + (2 * i + (lane >> 5)) * 65 + 2 * (lane & 31); p[0] = tv[i].x; p[1] = tv[i].y; }
    LDS_WAIT(); asm volatile("" ::: "memory");
    const int c = lane & 7;
#pragma unroll
    for (int j = 0; j < 8; ++j) { const int n = (lane >> 3) + 8 * j; const LAS float* s = scr + (8 * c) * 65 + n;
        v4u o; o.x = pk2(s[0 * 65], s[1 * 65]); o.y = pk2(s[2 * 65], s[3 * 65]); o.z = pk2(s[4 * 65], s[5 * 65]); o.w = pk2(s[6 * 65], s[7 * 65]);
        *(GAS v4u*)(dst + (size_t)n * ldt + 8 * c) = o; }
    LDS_WAIT(); asm volatile("" ::: "memory");
}
__device__ __forceinline__ void p0_tr_item8(const float* W, int ldw, int k0, int n0, unsigned char* dst, int ldt, float scale, LAS float* scr, int lane) {
    typedef float f32x2_t __attribute__((ext_vector_type(2))); typedef int v2i_t __attribute__((ext_vector_type(2)));
    f32x2_t tv[32];
#pragma unroll
    for (int i = 0; i < 32; ++i) { const int kk = 2 * i + (lane >> 5); tv[i] = *(const f32x2_t*)(W + (size_t)(k0 + kk) * ldw + n0 + 2 * (lane & 31)); }
#pragma unroll
    for (int i = 0; i < 32; ++i) { LAS float* p = scr + (2 * i + (lane >> 5)) * 65 + 2 * (lane & 31); p[0] = tv[i].x * scale; p[1] = tv[i].y * scale; }
    LDS_WAIT(); asm volatile("" ::: "memory");
    const int c = lane & 7;
#pragma unroll
    for (int j = 0; j < 8; ++j) { const int n = (lane >> 3) + 8 * j; const LAS float* s = scr + (8 * c) * 65 + n; int p0 = 0, p1 = 0;
        p0 = __builtin_amdgcn_cvt_pk_fp8_f32(s[0 * 65], s[1 * 65], p0, false); p0 = __builtin_amdgcn_cvt_pk_fp8_f32(s[2 * 65], s[3 * 65], p0, true);
        p1 = __builtin_amdgcn_cvt_pk_fp8_f32(s[4 * 65], s[5 * 65], p1, false); p1 = __builtin_amdgcn_cvt_pk_fp8_f32(s[6 * 65], s[7 * 65], p1, true);
        *(v2i_t*)(dst + (size_t)n * ldt + 8 * c) = (v2i_t){p0, p1}; }
    LDS_WAIT(); asm volatile("" ::: "memory");
}
__device__ __forceinline__ void p0_prologue(Frame& F) {
    LAS float* scr = (LAS float*)(F.lds + RING_OFF + F.wave * 16896);
    const int gw = F.vcu * NWAVES + F.wave, NGW = F.G * NWAVES;
    bf16* WIN = (bf16*)(F.ws + WS_WIN); bf16* WOUT = (bf16*)(F.ws + WS_WOUT); bf16* WGU = (bf16*)(F.ws + WS_WGU); bf16* WD = (bf16*)(F.ws + WS_WD);
    constexpr int I_ADA = 16 * 24;
    constexpr int I_IN = (D / 64) * (NPROJ / 64);
    constexpr int I_OUT = (D / 64) * (D / 64);
    constexpr int I_GU1 = (D / 64) * (DEXP / 64);
    constexpr int I_GU = NEXP * 2 * I_GU1;
    constexpr int I_DC1 = (DEXP / 64) * (D / 64);
    constexpr int I_DC = NEXP * I_DC1;
    constexpr int I_SM = 8 * 128 * 128 / 512;
    constexpr int NITEMS = I_ADA + I_IN + I_OUT + I_SM;
    for (int it = gw; it < NITEMS; it += NGW) {
        int r = it;
        if (r < I_ADA) {
            const int kp = r / 24, cg = r % 24; const int n = cg * 256 + F.lane * 4;
            f32x4 a0 = {0.f, 0.f, 0.f, 0.f}, a1 = a0, a2 = a0, a3 = a0;
#pragma unroll
            for (int q = 0; q < 4; ++q) { const int idx = q * 64 + F.lane; const float cv = F.c[(idx >> 6) * D + kp * 64 + (idx & 63)]; scr[idx] = cv / (1.f + __expf(-cv)); }
            LDS_WAIT(); asm volatile("" ::: "memory");
#pragma unroll 2
            for (int k0 = 0; k0 < 64; k0 += 32) { f32x4 w[32];
#pragma unroll
                for (int kk = 0; kk < 32; ++kk) w[kk] = *(const f32x4*)(F.w_ada + (size_t)(kp * 64 + k0 + kk) * NADA + n);
#pragma unroll
                for (int kk = 0; kk < 32; ++kk) { a0 += w[kk] * scr[k0 + kk]; a1 += w[kk] * scr[64 + k0 + kk]; a2 += w[kk] * scr[128 + k0 + kk]; a3 += w[kk] * scr[192 + k0 + kk]; } }
            LDS_WAIT(); asm volatile("" ::: "memory");
            float* P = (float*)(F.ws + WS_ADAP) + (size_t)kp * 4 * NADA + n;
            *(f32x4*)(P) = a0; *(f32x4*)(P + NADA) = a1; *(f32x4*)(P + 2 * NADA) = a2; *(f32x4*)(P + 3 * NADA) = a3;
            continue; }
        r -= I_ADA;
        if (r < I_IN) { const int kb = r / (NPROJ / 64), nb = r % (NPROJ / 64); p0_tr_item(F.w_in, LDW_IN, 64 * kb, 64 * nb, WIN + (size_t)(64 * nb) * D + 64 * kb, D, nullptr, scr, F.lane); continue; }
        r -= I_IN;
        if (r < I_OUT) { const int kb = r / (D / 64), nb = r % (D / 64); const int k0 = 64 * kb;
            p0_tr_item(F.w_out, D, k0, 64 * nb, WOUT + (size_t)(64 * nb) * D + (k0 < DH ? k0 + DH : k0 - DH), D, k0 < DH ? F.g_osgu : F.g_ofox - DH, scr, F.lane); continue; }
        r -= I_OUT;
        { bf16* WSM = (bf16*)(F.ws + WS_WSM);
#pragma unroll
          for (int j = 0; j < 8; ++j) { const int idx = r * 512 + j * 64 + F.lane; const int tt = (idx >> 7) & 127, ss = idx & 127; const float v = F.w_sp[idx]; WSM[idx] = (bf16)f2bf(ss <= tt ? v : 0.f); } }
    }
}

__device__ __forceinline__ void p3_convert(Frame& F) {
    int lane = lane_id_fresh();
    LAS float* scr = (LAS float*)(F.lds + RING_OFF + F.wave * 16896);
    bf16* WGU = (bf16*)(F.ws + WS_WGU); bf16* WD = (bf16*)(F.ws + WS_WD);
    constexpr int I_GU1 = (D / 64) * (DEXP / 64), I_GU = NEXP * 2 * I_GU1, I_DC1 = (DEXP / 64) * (D / 64), I_DC = NEXP * I_DC1, NIT = I_GU + I_DC;
    const int per = (NIT + F.G - 1) / F.G;
    __syncthreads();
    for (int it = F.vcu * per + F.wave; it < (F.vcu + 1) * per && it < NIT; it += NWAVES) {
        int r = it;
        if (r < I_GU) { const int e = r / (2 * I_GU1), r2 = r % (2 * I_GU1), isup = r2 / I_GU1, r3 = r2 % I_GU1; const int kb = r3 / (DEXP / 64), nb = r3 % (DEXP / 64); const int n0 = 64 * nb;
            const float* W = (isup ? F.w_up : F.w_gate) + (size_t)e * D * DEXP; const int drow = (n0 >> 7) * 256 + isup * 128 + (n0 & 127);
#if MOE_FP8
            p0_tr_item8(W, DEXP, 64 * kb, n0, (unsigned char*)WGU + ((size_t)e * 1024 + drow) * D + 64 * kb, D, 64.f, scr, lane); continue; }
#else
            p0_tr_item(W, DEXP, 64 * kb, n0, WGU + ((size_t)e * 1024 + drow) * D + 64 * kb, D, nullptr, scr, lane); continue; }
#endif
        r -= I_GU;
        if (r < I_DC) { const int e = r / I_DC1, r3 = r % I_DC1; const int kb = r3 / (D / 64), nb = r3 % (D / 64);
#if MOE_FP8
            p0_tr_item8(F.w_down + (size_t)e * DEXP * D, D, 64 * kb, 64 * nb, (unsigned char*)WD + ((size_t)e * D + 64 * nb) * DEXP + 64 * kb, DEXP, 64.f, scr, lane); continue; }
#else
            p0_tr_item(F.w_down + (size_t)e * DEXP * D, D, 64 * kb, 64 * nb, WD + ((size_t)e * D + 64 * nb) * DEXP + 64 * kb, DEXP, nullptr, scr, lane); continue; }
#endif
    }
    __syncthreads();
}
__device__ __forceinline__ void p1_load(Frame& F, f32x4 (&v)[2][4], int ch, int rl) {
#pragma unroll
    for (int rr = 0; rr < 2; ++rr) { const f32x4* xr = (const f32x4*)(F.x + (size_t)(ch * 128 + rl + 8 * rr) * D) + F.lane;
#pragma unroll
        for (int j = 0; j < 4; ++j) v[rr][j] = xr[64 * j]; }
}
__device__ __forceinline__ void p1_rows(Frame& F, f32x4 (&v)[2][4], int ch, int rl, const LAS float* modA, const LAS float* modB, const LAS float* wf, LAS float* gi, bf16* XN) {
            float s[2] = {0.f, 0.f};
#pragma unroll
            for (int rr = 0; rr < 2; ++rr)
#pragma unroll
                for (int j = 0; j < 4; ++j) s[rr] += (v[rr][j].x * v[rr][j].x + v[rr][j].y * v[rr][j].y) + (v[rr][j].z * v[rr][j].z + v[rr][j].w * v[rr][j].w);
#pragma unroll
            for (int rr = 0; rr < 2; ++rr) { const int m = ch * 128 + rl + 8 * rr;
                const float rstd = 1.f / sqrtf(wave_sum(s[rr]) * (1.f / D) + EPS);
                float fl[8];
#pragma unroll
                for (int q = 0; q < 8; ++q) fl[q] = 0.f;
                unsigned long long* o8 = (unsigned long long*)(XN + (size_t)m * D) + F.lane;
#pragma unroll
                for (int j = 0; j < 4; ++j) { const int k0 = 4 * F.lane + 256 * j; float h[4];
#pragma unroll
                    for (int e = 0; e < 4; ++e) { h[e] = v[rr][j][e] * rstd * modA[k0 + e] + modB[k0 + e];
#pragma unroll
                        for (int q = 0; q < 8; ++q) fl[q] += h[e] * wf[q * D + k0 + e]; }
                    o8[64 * j] = (unsigned long long)pk2(h[0], h[1]) | ((unsigned long long)pk2(h[2], h[3]) << 32); }
                float r0, r1; wave_sum8_t(fl, F.lane, r0, r1);
                if (F.lane < 4) { const int q0 = 4 * (F.lane & 1) + 2 * (F.lane >> 1);
#pragma unroll
                    for (int e = 0; e < 2; ++e) { const float z = (e ? r1 : r0) + F.b_fg[q0 + e];
                        const float sp = fmaxf(-z, 0.f) + log1pf(expf(-fabsf(z)));
                        gi[(rl + 8 * rr) * 8 + q0 + e] = sp * LOG2E; } } }
}
__device__ __forceinline__ void p1_prenorm(Frame& F) {
    const float* ADAP = (const float*)(F.ws + WS_ADAP); float* ADA = (float*)(F.ws + WS_ADA);
    for (int i = blockIdx.x * (NWAVES * 64) + F.tid; i < BATCH * NADA; i += F.G * NWAVES * 64) { float s = F.b_ada[i % NADA];
#pragma unroll
        for (int p = 0; p < 16; ++p) s += ADAP[(size_t)p * BATCH * NADA + i];
        ADA[i] = s; }
    LAS float* modA = (LAS float*)(F.lds);
    LAS float* modB = modA + 1024;
    LAS float* wf = modB + 1024;
    LAS float* gi = wf + 8192;
    bf16* XN = (bf16*)(F.ws + WS_XN); float* LC = (float*)(F.ws + WS_LC); float* CT = (float*)(F.ws + WS_CT);
    for (int ch = blockIdx.x; ch < M / 128; ch += F.G) {
        const int b = ch / (T / 128);
        __syncthreads();
        for (int k = F.tid; k < D; k += NWAVES * 64) { float sh = F.b_ada[k], sc = F.b_ada[D + k];
#pragma unroll
            for (int p = 0; p < 16; ++p) { sh += ADAP[((size_t)p * BATCH + b) * NADA + k]; sc += ADAP[((size_t)p * BATCH + b) * NADA + D + k]; }
            modA[k] = F.g_mix[k] * (1.f + sc); modB[k] = sh; }
        for (int i = F.tid; i < D * 8; i += NWAVES * 64) wf[(i & 7) * D + (i >> 3)] = F.w_in[(size_t)(i >> 3) * LDW_IN + NPROJ + (i & 7)];
        __syncthreads();
        { f32x4 va[2][4], vb[2][4];
            p1_load(F, va, ch, F.wave);
#pragma unroll 1
            for (int it = 0; it < 4; ++it) {
                p1_load(F, vb, ch, F.wave + 16 * (2 * it + 1));
                p1_rows(F, va, ch, F.wave + 16 * (2 * it), modA, modB, wf, gi, XN);
                if (it < 3) p1_load(F, va, ch, F.wave + 16 * (2 * it + 2));
                p1_rows(F, vb, ch, F.wave + 16 * (2 * it + 1), modA, modB, wf, gi, XN);
            } }
        __syncthreads();
        { const int h = F.wave; float* lc = LC + ((size_t)b * NH + h) * T + (ch % (T / 128)) * 128;
            const float a0 = gi[(2 * F.lane) * 8 + h], a1 = gi[(2 * F.lane + 1) * 8 + h]; float sc = a0 + a1;
#pragma unroll
            for (int o = 1; o < 64; o <<= 1) { const float t = __shfl_up(sc, o); if (F.lane >= o) sc += t; }
            lc[2 * F.lane] = sc - a1; lc[2 * F.lane + 1] = sc;
            if (F.lane == 63) CT[((size_t)b * NH + h) * (T / 128) + (ch % (T / 128))] = sc; }
    }
    __syncthreads();
}

__device__ __forceinline__ void p3_sgu_naive(Frame& F) {
    const bf16* U = (const bf16*)(F.ws + WS_U); const bf16* VS = U + (size_t)M * DH; const bf16* WSM = (const bf16*)(F.ws + WS_WSM);
    bf16* Y = (bf16*)(F.ws + WS_Y); float* SSQY = (float*)(F.ws + WS_SSQY);
    LAS bf16* vn = (LAS bf16*)(F.lds);
    const int h = F.wave, c = F.tid;
    for (int ch = blockIdx.x; ch < M / 128; ch += F.G) {
        __syncthreads();
        const float gs = F.g_sgu[h * 64 + F.lane];
        for (int s = 0; s < 128; ++s) { const size_t m = (size_t)ch * 128 + s; const float val = bf2f(VS[m * DH + c]); const float q = wave_sum(val * val);
            vn[s * DH + c] = (bf16)f2bf(val * (1.f / sqrtf(q * (1.f / 64.f) + EPS)) * gs); }
        __syncthreads();
        for (int t = 0; t < 128; ++t) { float z = F.b_sp[h * 128 + t]; const bf16* wrow = WSM + ((size_t)h * 128 + t) * 128;
            for (int s = 0; s <= t; ++s) z += bf2f(wrow[s]) * bf2f(vn[s * DH + c]);
            const size_t m = (size_t)ch * 128 + t; const float y = bf2f(U[m * DH + c]) * z;
            Y[m * D + DH + c] = (bf16)f2bf(y); const float q = wave_sum(y * y); if (F.lane == 0) SSQY[m * 16 + h] = q; }
    }
    __syncthreads();
}
__device__ __forceinline__ void p3_sgu(Frame& F) {
    typedef short s16x4_t __attribute__((ext_vector_type(4))); typedef float f32x16_t __attribute__((ext_vector_type(16)));
    const bf16* U = (const bf16*)(F.ws + WS_U); const bf16* VS = U + (size_t)M * DH; const bf16* WSM = (const bf16*)(F.ws + WS_WSM);
    bf16* Y = (bf16*)(F.ws + WS_Y); float* SSQY = (float*)(F.ws + WS_SSQY);
    constexpr int RS = 144;
    const int h = F.wave, lane = F.lane, c8 = lane & 7, kg = lane >> 5, t32 = lane & 31;
    LAS unsigned char* vreg = F.lds + h * (128 * RS);
    LAS float* bsl = (LAS float*)(F.lds + 8 * 128 * RS) + h * 128;
    float gsc[8];
#pragma unroll
    for (int e = 0; e < 8; ++e) gsc[e] = F.g_sgu[h * 64 + c8 * 8 + e];
    const int trb = (8 * (lane >> 5) + ((lane & 15) >> 2)) * RS + (16 * ((lane >> 4) & 1) + 4 * (lane & 3)) * 2;
    for (int ch = blockIdx.x; ch < M / 128; ch += F.G) {
        const size_t row0 = (size_t)ch * 128;
        asm volatile("s_waitcnt lgkmcnt(0)" ::: "memory");
        uint4 pre[16];
#pragma unroll
        for (int it = 0; it < 16; ++it) pre[it] = *(const uint4*)(VS + (row0 + it * 8 + (lane >> 3)) * DH + h * 64 + c8 * 8);
#pragma unroll
        for (int it = 0; it < 16; ++it) { const int r = it * 8 + (lane >> 3); const uint4 w = pre[it]; const unsigned ww[4] = {w.x, w.y, w.z, w.w};
            float v[8]; float q = 0.f;
#pragma unroll
            for (int e = 0; e < 4; ++e) { v[2 * e] = __uint_as_float(ww[e] << 16); v[2 * e + 1] = __uint_as_float(ww[e] & 0xffff0000u); q += v[2 * e] * v[2 * e] + v[2 * e + 1] * v[2 * e + 1]; }
            q = DPP_ADD(q, 0xB1); q = DPP_ADD(q, 0x4E); q = DPP_ADD(q, 0x141);
            const float rstd = 1.f / sqrtf(q * (1.f / 64.f) + EPS);
            v4u o; o.x = pk2(v[0] * rstd * gsc[0], v[1] * rstd * gsc[1]); o.y = pk2(v[2] * rstd * gsc[2], v[3] * rstd * gsc[3]); o.z = pk2(v[4] * rstd * gsc[4], v[5] * rstd * gsc[5]); o.w = pk2(v[6] * rstd * gsc[6], v[7] * rstd * gsc[7]);
            *(LAS v4u*)(vreg + r * RS + c8 * 16) = o; }
        bsl[lane] = F.b_sp[h * 128 + lane]; bsl[lane + 64] = F.b_sp[h * 128 + 64 + lane];
        asm volatile("s_waitcnt lgkmcnt(0)" ::: "memory");
        f32x16_t acc[4][2];
#pragma unroll
        for (int tb = 0; tb < 4; ++tb) { acc[tb][0] = f32x16_t{}; acc[tb][1] = f32x16_t{}; }
#pragma unroll
        for (int tb = 0; tb < 4; ++tb)
#pragma unroll
            for (int ks = 0; ks < 2 * tb + 2; ++ks) {
                const bf16x8 a = *(const bf16x8*)(WSM + ((size_t)(h * 128 + 32 * tb + t32)) * 128 + 16 * ks + 8 * kg);
#pragma unroll
                for (int db = 0; db < 2; ++db) {
                    const s16x4_t lo = __builtin_bit_cast(s16x4_t, __builtin_amdgcn_ds_read_tr16_b64_v4i16((LAS s16x4_t*)(vreg + trb + (16 * ks) * RS + db * 64)));
                    const s16x4_t hi = __builtin_bit_cast(s16x4_t, __builtin_amdgcn_ds_read_tr16_b64_v4i16((LAS s16x4_t*)(vreg + trb + (16 * ks + 4) * RS + db * 64)));
                    const bf16x8 bfr = {lo[0], lo[1], lo[2], lo[3], hi[0], hi[1], hi[2], hi[3]};
                    acc[tb][db] = __builtin_amdgcn_mfma_f32_32x32x16_bf16(a, bfr, acc[tb][db], 0, 0, 0); } }
        asm volatile("s_waitcnt lgkmcnt(0)" ::: "memory");
#pragma unroll
        for (int tb = 0; tb < 4; ++tb)
#pragma unroll
            for (int db = 0; db < 2; ++db)
#pragma unroll
                for (int r = 0; r < 16; ++r) { const int t = 32 * tb + (r & 3) + 8 * (r >> 2) + 4 * kg;
                    *(LAS unsigned short*)(vreg + t * RS + (32 * db + t32) * 2) = (unsigned short)f2bf(acc[tb][db][r] + bsl[t]); }
        asm volatile("s_waitcnt lgkmcnt(0)" ::: "memory");
#pragma unroll
        for (int it = 0; it < 16; ++it) pre[it] = *(const uint4*)(U + (row0 + it * 8 + (lane >> 3)) * DH + h * 64 + c8 * 8);
#pragma unroll
        for (int it = 0; it < 16; ++it) { const int r = it * 8 + (lane >> 3); const v4u zz = *(const LAS v4u*)(vreg + r * RS + c8 * 16); const uint4 uu = pre[it];
            const unsigned zw[4] = {zz.x, zz.y, zz.z, zz.w}, uw[4] = {uu.x, uu.y, uu.z, uu.w}; unsigned ow[4]; float q = 0.f;
#pragma unroll
            for (int e = 0; e < 4; ++e) { const float y0 = __uint_as_float(zw[e] << 16) * __uint_as_float(uw[e] << 16), y1 = __uint_as_float(zw[e] & 0xffff0000u) * __uint_as_float(uw[e] & 0xffff0000u);
                q += y0 * y0 + y1 * y1; ow[e] = pk2(y0, y1); }
            q = DPP_ADD(q, 0xB1); q = DPP_ADD(q, 0x4E); q = DPP_ADD(q, 0x141);
            v4u o; o.x = ow[0]; o.y = ow[1]; o.z = ow[2]; o.w = ow[3];
            *(v4u*)(Y + (row0 + r) * D + DH + h * 64 + c8 * 8) = o;
            if (c8 == 0) SSQY[(row0 + r) * 16 + h] = q; }
    }
    asm volatile("s_waitcnt lgkmcnt(0)" ::: "memory");
    __syncthreads();
}
__device__ __forceinline__ void p3_attn_naive(Frame& F) {
    const bf16* Q = (const bf16*)(F.ws + WS_U) + (size_t)2 * M * DH; const bf16* K = Q + (size_t)M * DH; const bf16* V = K + (size_t)M * DH;
    const float* LC = (const float*)(F.ws + WS_LC); const float* CT = (const float*)(F.ws + WS_CT);
    bf16* Y = (bf16*)(F.ws + WS_Y); float* SSQY = (float*)(F.ws + WS_SSQY);
    LAS float* Gabs = (LAS float*)(F.lds);
    LAS float* pre = Gabs + T;
    for (int item = blockIdx.x; item < BATCH * NH * 8; item += F.G) {
        const int bh = item >> 3, r = item & 7, b = bh / NH, h = bh % NH;
        __syncthreads();
        if (F.tid < 64) { float a = 0.f; for (int c2 = 0; c2 < F.tid; ++c2) a += CT[bh * 64 + c2]; pre[F.tid] = a; }
        __syncthreads();
        for (int t = F.tid; t < T; t += NWAVES * 64) Gabs[t] = pre[t >> 7] + LC[(size_t)bh * T + t];
        __syncthreads();
        for (int n = F.wave; n < T / 8; n += NWAVES) {
            const int i = 8 * n + r; const size_t rowi = (size_t)b * T + i;
            float qf[64];
            { const uint4* q4 = (const uint4*)(Q + rowi * DH + h * HD);
#pragma unroll
              for (int c4 = 0; c4 < 8; ++c4) { const uint4 w = q4[c4]; const unsigned ww[4] = {w.x, w.y, w.z, w.w};
#pragma unroll
                  for (int e = 0; e < 4; ++e) { qf[c4 * 8 + 2 * e] = __uint_as_float(ww[e] << 16); qf[c4 * 8 + 2 * e + 1] = __uint_as_float(ww[e] & 0xffff0000u); } } }
            const float Gi = Gabs[i];
            float mx = -1e30f, l = 0.f; float o[64];
#pragma unroll
            for (int d = 0; d < 64; ++d) o[d] = 0.f;
            for (int j = F.lane; j <= i; j += 64) {
                const size_t rowj = (size_t)b * T + j; const uint4* k4 = (const uint4*)(K + rowj * DH + h * HD); const uint4* v4 = (const uint4*)(V + rowj * DH + h * HD);
                float s = 0.f;
#pragma unroll
                for (int c4 = 0; c4 < 8; ++c4) { const uint4 w = k4[c4]; const unsigned ww[4] = {w.x, w.y, w.z, w.w};
#pragma unroll
                    for (int e = 0; e < 4; ++e) { s += qf[c4 * 8 + 2 * e] * __uint_as_float(ww[e] << 16); s += qf[c4 * 8 + 2 * e + 1] * __uint_as_float(ww[e] & 0xffff0000u); } }
                s += Gabs[j] - Gi;
                if (s > mx) { const float f = __builtin_amdgcn_exp2f(mx - s); l *= f;
#pragma unroll
                    for (int d = 0; d < 64; ++d) o[d] *= f;
                    mx = s; }
                const float p = __builtin_amdgcn_exp2f(s - mx); l += p;
#pragma unroll
                for (int c4 = 0; c4 < 8; ++c4) { const uint4 w = v4[c4]; const unsigned ww[4] = {w.x, w.y, w.z, w.w};
#pragma unroll
                    for (int e = 0; e < 4; ++e) { o[c4 * 8 + 2 * e] += p * __uint_as_float(ww[e] << 16); o[c4 * 8 + 2 * e + 1] += p * __uint_as_float(ww[e] & 0xffff0000u); } }
            }
            const float Mx = wave_max(mx); const float f = __builtin_amdgcn_exp2f(mx - Mx); l *= f; const float L = wave_sum(l);
            float y = 0.f;
#pragma unroll
            for (int d = 0; d < 64; ++d) { const float od = wave_sum(o[d] * f); y = (F.lane == d) ? od : y; }
            y = y / L;
            Y[rowi * D + h * HD + F.lane] = (bf16)f2bf(y);
            const float q = wave_sum(y * y); if (F.lane == 0) SSQY[rowi * 16 + 8 + h] = q;
        }
    }
    __syncthreads();
}
__device__ __forceinline__ void p2_kx(Frame& F) {
    const float* LC = (const float*)(F.ws + WS_LC); const float* CT = (const float*)(F.ws + WS_CT);
    unsigned long long* KX8 = (unsigned long long*)(F.ws + WS_KX8); float* GF = (float*)(F.ws + WS_GF);
    const int gw = F.vcu * NWAVES + F.wave, NGW = F.G * NWAVES;
    for (int pr = gw; pr < BATCH * NH * (T / 128); pr += NGW) { const int bh = pr >> 6, ch = pr & 63;
        const float base = wave_sum(F.lane < ch ? CT[bh * 64 + F.lane] : 0.f);
#pragma unroll
        for (int e = 0; e < 2; ++e) { const size_t t = (size_t)bh * T + ch * 128 + e * 64 + F.lane; const float G = base + LC[t];
            const unsigned gh = f2bf(G); const float r1 = G - __uint_as_float(gh << 16); const unsigned gm = f2bf(r1); const float r2 = r1 - __uint_as_float(gm << 16); const unsigned gl = f2bf(r2);
            KX8[t] = (unsigned long long)(gh | (gm << 16)) | ((unsigned long long)(gl | (0x3F80u << 16)) << 32); GF[t] = G; } }
}
__device__ __forceinline__ void p6_load(Frame& F, f32x4 (&xv)[2][4], uint2 (&mv)[2][4], const bf16* MIX, int mrow) {
#pragma unroll
    for (int rr = 0; rr < 2; ++rr) { const size_t m = (size_t)mrow + rr; const f32x4* xr = (const f32x4*)(F.x + m * D) + F.lane; const uint2* mr = (const uint2*)(MIX + m * D) + F.lane;
#pragma unroll
        for (int j = 0; j < 4; ++j) { xv[rr][j] = xr[64 * j]; mv[rr][j] = mr[64 * j]; } }
}
__device__ __forceinline__ void p6_rows(Frame& F, f32x4 (&xv)[2][4], uint2 (&mv)[2][4], int m0, int r0, int RPW, const f32x4 (&cg1)[4], const f32x4 (&cA)[4], const f32x4 (&cB)[4],
                                        const LAS float* wrg, const LAS float* wre, LAS unsigned* lcnt, LAS unsigned* rinfo, bf16* H2, bf16* X1, float* TW) {
#pragma unroll
        for (int rr = 0; rr < 2; ++rr) { const int m = m0 + r0 + rr; float s = 0.f;
#pragma unroll
            for (int j = 0; j < 4; ++j) { f32x4 mx; mx[0] = __uint_as_float(mv[rr][j].x << 16); mx[1] = __uint_as_float(mv[rr][j].x & 0xffff0000u); mx[2] = __uint_as_float(mv[rr][j].y << 16); mx[3] = __uint_as_float(mv[rr][j].y & 0xffff0000u);
                xv[rr][j] = xv[rr][j] + cg1[j] * mx;
                ((unsigned long long*)(X1 + (size_t)m * D) + F.lane)[64 * j] = (unsigned long long)pk2(xv[rr][j].x, xv[rr][j].y) | ((unsigned long long)pk2(xv[rr][j].z, xv[rr][j].w) << 32);
                s += (xv[rr][j].x * xv[rr][j].x + xv[rr][j].y * xv[rr][j].y) + (xv[rr][j].z * xv[rr][j].z + xv[rr][j].w * xv[rr][j].w); }
            const float rstd = 1.f / sqrtf(wave_sum(s) * (1.f / D) + EPS);
            float lg[4] = {0.f, 0.f, 0.f, 0.f};
#if MOE_FP8
            int* o4 = (int*)((unsigned char*)H2 + (size_t)m * D) + F.lane;
#else
            unsigned long long* o8 = (unsigned long long*)(H2 + (size_t)m * D) + F.lane;
#endif
#pragma unroll
            for (int j = 0; j < 4; ++j) { const int k0 = 4 * F.lane + 256 * j; xv[rr][j] = xv[rr][j] * rstd * cA[j] + cB[j];
#if MOE_FP8
                { int p = 0; p = __builtin_amdgcn_cvt_pk_fp8_f32(xv[rr][j].x, xv[rr][j].y, p, false); p = __builtin_amdgcn_cvt_pk_fp8_f32(xv[rr][j].z, xv[rr][j].w, p, true); o4[64 * j] = p; }
#else
                o8[64 * j] = (unsigned long long)pk2(xv[rr][j].x, xv[rr][j].y) | ((unsigned long long)pk2(xv[rr][j].z, xv[rr][j].w) << 32);
#endif
#pragma unroll
                for (int q = 0; q < 4; ++q) { const f32x4 w = *(const LAS f32x4*)(wrg + q * D + k0); lg[q] += (xv[rr][j].x * w.x + xv[rr][j].y * w.y) + (xv[rr][j].z * w.z + xv[rr][j].w * w.w); } }
            wave_sum4_all(lg, F.lane);
#pragma unroll
            for (int q = 0; q < 4; ++q) lg[q] += F.b_rg[q];
            int gs = 0; float best = lg[0];
#pragma unroll
            for (int q = 1; q < 4; ++q) if (lg[q] > best) { best = lg[q]; gs = q; }
            float den = 0.f;
#pragma unroll
            for (int q = 0; q < 4; ++q) den += expf(lg[q] - best);
            const float psel = 1.f / den;
            gs = __builtin_amdgcn_readfirstlane(gs);
            float le[4] = {0.f, 0.f, 0.f, 0.f}; const LAS float* wg = wre + gs * 4 * D;
#pragma unroll
            for (int j = 0; j < 4; ++j) { const int k0 = 4 * F.lane + 256 * j;
#pragma unroll
                for (int q = 0; q < 4; ++q) { const f32x4 w = *(const LAS f32x4*)(wg + q * D + k0); le[q] += (xv[rr][j].x * w.x + xv[rr][j].y * w.y) + (xv[rr][j].z * w.z + xv[rr][j].w * w.w); } }
            wave_sum4_all(le, F.lane);
#pragma unroll
            for (int q = 0; q < 4; ++q) le[q] += F.b_re[gs * 4 + q];
            int i0 = 0; float v0 = le[0];
#pragma unroll
            for (int q = 1; q < 4; ++q) if (le[q] > v0) { v0 = le[q]; i0 = q; }
            int i1 = -1; float v1 = -INFINITY;
#pragma unroll
            for (int q = 0; q < 4; ++q) if (q != i0 && le[q] > v1) { v1 = le[q]; i1 = q; }
            const float e1 = expf(v1 - v0); const float w0 = psel / (1.f + e1), w1 = psel * e1 / (1.f + e1);
            const int ea = i0 < i1 ? i0 : i1, eb = i0 < i1 ? i1 : i0; const float wa = i0 < i1 ? w0 : w1, wb = i0 < i1 ? w1 : w0;
            const int pair = ea == 0 ? eb - 1 : (ea == 1 ? eb + 1 : 5); const int cls = gs * 6 + pair;
            if (F.lane == 0) { TW[(size_t)m * 2] = wa; TW[(size_t)m * 2 + 1] = wb;
                const unsigned lr = __hip_atomic_fetch_add(lcnt + cls, 1u, __ATOMIC_RELAXED, __HIP_MEMORY_SCOPE_WORKGROUP);
                rinfo[F.wave * RPW + r0 + rr] = (unsigned)cls | (lr << 8); }
        }
}
__device__ __forceinline__ void p6_route(Frame& F) {
    const float* ADA = (const float*)(F.ws + WS_ADA); const bf16* MIX = (const bf16*)(F.ws + WS_MIX);
    bf16* H2 = (bf16*)(F.ws + WS_H2); bf16* X1 = (bf16*)(F.ws + WS_X1); int* INV = (int*)(F.ws + WS_INV); float* TW = (float*)(F.ws + WS_TW);
    LAS float* wrg = (LAS float*)(F.lds);
    LAS float* wre = wrg + 4 * D;
    LAS unsigned* lcnt = (LAS unsigned*)(wre + 16 * D);
    LAS unsigned* rinfo = lcnt + 32;
    __syncthreads();
    if (F.tid < 32) lcnt[F.tid] = 0u;
    for (int i = F.tid; i < 4 * D; i += NWAVES * 64) wrg[(i & 3) * D + (i >> 2)] = F.w_rg[i];
    for (int i = F.tid; i < 16 * D; i += NWAVES * 64) { const int g = i / (4 * D), r = i % (4 * D); wre[g * 4 * D + (r & 3) * D + (r >> 2)] = F.w_re[i]; }
    __syncthreads();
    const int gw = F.vcu * NWAVES + F.wave, NGW = F.G * NWAVES; const int RPW = M / NGW;
    const int m0 = gw * RPW; const int b = m0 / T;
    f32x4 cg1[4], cA[4], cB[4];
#pragma unroll
    for (int j = 0; j < 4; ++j) { const int k0 = 4 * F.lane + 256 * j; cg1[j] = *(const f32x4*)(ADA + (size_t)b * NADA + 2 * D + k0);
        const f32x4 g = *(const f32x4*)(F.g_ffn + k0), sc = *(const f32x4*)(ADA + (size_t)b * NADA + 4 * D + k0); cA[j] = g * (1.f + sc); cB[j] = *(const f32x4*)(ADA + (size_t)b * NADA + 3 * D + k0); }
    { f32x4 xa[2][4], xb[2][4]; uint2 ma[2][4], mb[2][4];
        p6_load(F, xa, ma, MIX, m0);
#pragma unroll 1
        for (int r0 = 0; r0 < RPW; r0 += 4) {
            p6_load(F, xb, mb, MIX, m0 + r0 + 2);
            p6_rows(F, xa, ma, m0, r0, RPW, cg1, cA, cB, wrg, wre, lcnt, rinfo, H2, X1, TW);
            if (r0 + 4 < RPW) p6_load(F, xa, ma, MIX, m0 + r0 + 4);
            p6_rows(F, xb, mb, m0, r0 + 2, RPW, cg1, cA, cB, wrg, wre, lcnt, rinfo, H2, X1, TW);
        } }
    __syncthreads();
    if (F.tid < NCLS) { const unsigned n = lcnt[F.tid]; lcnt[F.tid] = n ? __hip_atomic_fetch_add((unsigned*)(F.ctl + CW_CNT + F.tid * CNT_STRIDE), n, __ATOMIC_RELAXED, __HIP_MEMORY_SCOPE_AGENT) : 0u; }
    __syncthreads();
    for (int i = F.tid; i < NWAVES * RPW; i += NWAVES * 64) { const unsigned ri = rinfo[i]; const int cls = (int)(ri & 255u);
        INV[(size_t)cls * M + lcnt[cls] + (ri >> 8)] = (F.vcu * NWAVES + i / RPW) * RPW + i % RPW; }
    __syncthreads();
}
__device__ __forceinline__ void moe_tables(Frame& F) {
    LAS unsigned* lcnt = (LAS unsigned*)(F.lds + LCNT_OFF);
    __syncthreads();
    if (F.tid < NCLS) lcnt[F.tid] = __hip_atomic_load(F.ctl + CW_CNT + F.tid * CNT_STRIDE, RLX_AGENT);
    __syncthreads();
    if (F.tid == 0) { LAS unsigned char* tcls = F.lds + TCLS_OFF; LAS unsigned char* tfirst = F.lds + TFIRST_OFF; int nt = 0;
        for (int c = 0; c < NCLS; ++c) { const int n = ((int)lcnt[c] + 255) >> 8; tfirst[c] = (unsigned char)nt; for (int k = 0; k < n && nt < MAXTILES; ++k) tcls[nt++] = (unsigned char)c; }
        F.MISC[16] = (unsigned)nt; }
    __syncthreads();
}
template <class Order> __device__ __forceinline__ void moe_fill_toku(Frame& F, const Order& S) {
    const int* INV = (const int*)(F.ws + WS_INV); LAS unsigned* toku = (LAS unsigned*)(F.lds + TOKU_OFF);
    for (int i = 0; i < 5; ++i) { pg8::Unit u; if (!S.next(i, u)) break;
        if (F.tid < 256) { const int rank = u.rank0 + F.tid; const int tok = rank < u.cnt ? INV[(size_t)u.cls * M + rank] : 0; toku[i * 256 + F.tid] = (unsigned)tok * (unsigned)(D * MOE_ESZ); } }
    __syncthreads();
}
__device__ __forceinline__ void p10_final(Frame& F) {
    const float* ADA = (const float*)(F.ws + WS_ADA); const bf16* X1 = (const bf16*)(F.ws + WS_X1); const bf16* MOE = (const bf16*)(F.ws + WS_MOE);
    const int gw = F.vcu * NWAVES + F.wave, NGW = F.G * NWAVES; const int RPW = M / NGW; const int m0 = gw * RPW; const int b = m0 / T;
    f32x4 cg2[4], cgf[4];
#pragma unroll
    for (int j = 0; j < 4; ++j) { const int k0 = 4 * F.lane + 256 * j; cg2[j] = *(const f32x4*)(ADA + (size_t)b * NADA + 5 * D + k0); cgf[j] = *(const f32x4*)(F.g_fin + k0); }
    for (int r0 = 0; r0 < RPW; r0 += 4) {
        uint2 mv[4][4], ev[4][4];
#pragma unroll
        for (int rr = 0; rr < 4; ++rr) { const size_t m = (size_t)m0 + r0 + rr; const uint2* mr = (const uint2*)(X1 + m * D) + F.lane; const uint2* er = (const uint2*)(MOE + m * D) + F.lane;
#pragma unroll
            for (int j = 0; j < 4; ++j) { mv[rr][j] = mr[64 * j]; ev[rr][j] = er[64 * j]; } }
#pragma unroll
        for (int rr = 0; rr < 4; ++rr) { const size_t m = (size_t)m0 + r0 + rr; float s = 0.f; f32x4 xv[4];
#pragma unroll
            for (int j = 0; j < 4; ++j) { f32x4 mx, ex; mx[0] = __uint_as_float(mv[rr][j].x << 16); mx[1] = __uint_as_float(mv[rr][j].x & 0xffff0000u); mx[2] = __uint_as_float(mv[rr][j].y << 16); mx[3] = __uint_as_float(mv[rr][j].y & 0xffff0000u);
                ex[0] = __uint_as_float(ev[rr][j].x << 16); ex[1] = __uint_as_float(ev[rr][j].x & 0xffff0000u); ex[2] = __uint_as_float(ev[rr][j].y << 16); ex[3] = __uint_as_float(ev[rr][j].y & 0xffff0000u);
                xv[j] = mx + cg2[j] * ex; s += (xv[j].x * xv[j].x + xv[j].y * xv[j].y) + (xv[j].z * xv[j].z + xv[j].w * xv[j].w); }
            const float rstd = 1.f / sqrtf(wave_sum(s) * (1.f / D) + EPS);
            f32x4* orow = (f32x4*)(F.out + m * D) + F.lane;
#pragma unroll
            for (int j = 0; j < 4; ++j) orow[64 * j] = xv[j] * rstd * cgf[j]; }
    }
}

#define REFRESH() do { F.lane = lane_id_fresh(); F.tid = F.wave * 64 + F.lane; } while (0)
struct Args { const float* in[22]; float* out; unsigned char* ws; int ph_lo, ph_hi; };
__global__ void __launch_bounds__(NWAVES * 64, 2) mk_fwd(Args args) {
    extern __shared__ __attribute__((aligned(16))) unsigned char lds[];
    Frame F;
    F.lds = (LAS unsigned char*)lds;
    F.MISC = (volatile LAS unsigned*)(F.lds + MISC_OFF);
    F.tid = threadIdx.x; F.lane = F.tid & 63; F.wave = __builtin_amdgcn_readfirstlane(F.tid >> 6);
    F.G = gridDim.x; { const int bx = blockIdx.x; F.vcu = (F.G % 8 == 0) ? (bx % 8) * (F.G / 8) + bx / 8 : bx; }
    F.ws = args.ws; F.ctl = (gu32*)(args.ws + WS_CTL); F.out = args.out;
    F.x = args.in[0]; F.c = args.in[1]; F.w_ada = args.in[2]; F.b_ada = args.in[3]; F.g_mix = args.in[4]; F.w_in = args.in[5]; F.g_sgu = args.in[6]; F.w_sp = args.in[7]; F.b_sp = args.in[8]; F.b_fg = args.in[9];
    F.g_osgu = args.in[10]; F.g_ofox = args.in[11]; F.w_out = args.in[12]; F.g_ffn = args.in[13]; F.w_rg = args.in[14]; F.b_rg = args.in[15]; F.w_re = args.in[16]; F.b_re = args.in[17];
    F.w_gate = args.in[18]; F.w_up = args.in[19]; F.w_down = args.in[20]; F.g_fin = args.in[21];
    for (int u = F.tid; u < (LDS_BYTES - LDSCTL_OFF) / 4; u += NWAVES * 64) ((LAS unsigned*)(F.lds + LDSCTL_OFF))[u] = 0u;
    __syncthreads();
    XcdBarrier bar; bar.bar = (unsigned*)(F.ctl + CW_BAR); bar.x = 0; bar.st = nullptr;
    if (N_LAUNCHES == 1) bar = xcd_barrier_post((unsigned*)(F.ctl + CW_BAR), F.MISC + 8);
#define GRID_BAR() do { if (N_LAUNCHES == 1) xcd_barrier(bar); } while (0)
#if PROBE_MASK
#define PROBE_BEGIN(k) do { if (((PROBE_MASK) >> (k)) & 1) { if (blockIdx.x == 0 && F.tid == 0) F.MISC[22] = (unsigned)rt(); } } while (0)
#define PROBE_END(k) do { if (((PROBE_MASK) >> (k)) & 1) { if (blockIdx.x == 0 && F.tid == 0) F.MISC[20] = F.MISC[20] + ((unsigned)rt() - F.MISC[22]); } } while (0)
#else
#define PROBE_BEGIN(k) do {} while (0)
#define PROBE_END(k) do {} while (0)
#endif
    const int lo = args.ph_lo, hi = args.ph_hi;
#define IN(k) (lo <= (k) && (k) < hi)
#define BOTH(k) (IN(k) && IN((k) + 1))
    bf16* const XN = (bf16*)(F.ws + WS_XN); bf16* const U = (bf16*)(F.ws + WS_U); bf16* const Y = (bf16*)(F.ws + WS_Y);
    float* const ADA = (float*)(F.ws + WS_ADA);

    if (IN(0)) { PROBE_BEGIN(0); p0_prologue(F); if (BOTH(0)) GRID_BAR(); PROBE_END(0); }
    if (IN(1)) { REFRESH(); PROBE_BEGIN(1); p1_prenorm(F); if (BOTH(1)) GRID_BAR(); PROBE_END(1); }
    if (IN(2)) { REFRESH(); PROBE_BEGIN(2);
        p2_kx(F);
        pg8::Gemm g{XN, (const bf16*)(F.ws + WS_WIN), D, D, D, 127, 127}; pg8::StaticOrder S; S.init(M, NPROJ, D, D, F.G, (int)blockIdx.x);
        pg8::EpiProj E{U, (unsigned*)(F.ctl + CW_QKB)};
        pg8::gemm_phase<pg8::EpiProj, pg8::StaticOrder, true, true>(F.lds + RING_OFF, g, S, E, F.tid);
        if (BOTH(2)) GRID_BAR(); PROBE_END(2);
    }
    if (IN(3)) { REFRESH(); PROBE_BEGIN(3);
        PROBE_BEGIN(4);
#if NAIVE_SGU
        p3_sgu_naive(F);
#else
        p3_sgu(F);
#endif
        PROBE_END(4);
#if NAIVE_ATTN
        p3_attn_naive(F);
#else
        static_assert(attn_body::LDS_BYTES <= RING_BYTES, "attention LDS map");
        { const attn_body::bf16* Qp = (const attn_body::bf16*)(F.ws + WS_U) + (size_t)2 * M * DH;
          const attn_body::AttnTensors AT{Qp, Qp + (size_t)M * DH, Qp + (size_t)2 * M * DH, (attn_body::bf16*)(F.ws + WS_Y), (const unsigned long long*)(F.ws + WS_KX8), (const float*)(F.ws + WS_GF), (const float*)(F.ctl + CW_QKB), (float*)(F.ws + WS_SSQY)};
          const attn_body::StaticOrder S((int)F.G, (int)blockIdx.x);
          attn_body::AttnUnit u;
          for (int i = 0; S.next(i, u); ++i) {
              if (i == ((F.vcu >> 1) & 3)) p3_convert(F);
              attn_body::attn_unit<8>(u.bh / attn_body::NHEAD, u.bh % attn_body::NHEAD, u.qb, AT.Q, AT.K, AT.V, AT.O, AT.KX8, AT.GF, AT.QKB, AT.SSQ, (char*)lds + RING_OFF, F.tid); } }
#endif
        if (IN(3) && IN(5)) GRID_BAR(); PROBE_END(3); }
    if (IN(5)) { REFRESH(); PROBE_BEGIN(5);
        pg8::Gemm g{Y, (const bf16*)(F.ws + WS_WOUT), D, D, D, 127, 127}; pg8::StaticOrder S; S.init(M, D, D, D, F.G, (int)blockIdx.x);
        pg8::EpiMix E{(bf16*)(F.ws + WS_MIX), (const float*)(F.ws + WS_SSQY)};
        pg8::gemm_phase<pg8::EpiMix, pg8::StaticOrder, true, true>(F.lds + RING_OFF, g, S, E, F.tid);
        if (BOTH(5)) GRID_BAR(); PROBE_END(5);
    }
    if (IN(6)) { REFRESH(); PROBE_BEGIN(6); p6_route(F); if (IN(6) && IN(8)) GRID_BAR(); PROBE_END(6); }
    if (IN(8)) { REFRESH(); PROBE_BEGIN(8);
        moe_tables(F);
        pg8::Gemm g{(const bf16*)(F.ws + WS_H2), (const bf16*)(F.ws + WS_WGU), D * MOE_ESZ / 2, D * MOE_ESZ / 2, D * MOE_ESZ / 2, 127, 121};
        pg8::MoeUpOrder S{F.G, (int)blockIdx.x, (int)F.MISC[16], F.lds + TCLS_OFF, F.lds + TFIRST_OFF, (const LAS unsigned*)(F.lds + LCNT_OFF), (const LAS unsigned*)(F.lds + TOKU_OFF)};
        moe_fill_toku(F, S);
        pg8::EpiUp E{(bf16*)(F.ws + WS_ACT), (const float*)(F.ws + WS_TW), (const int*)(F.ws + WS_INV)};
        pg8::gemm_phase<pg8::EpiUp, pg8::MoeUpOrder, true, true, MOE_FP8 != 0>(F.lds + RING_OFF, g, S, E, F.tid);
        if (BOTH(8)) GRID_BAR(); PROBE_END(8);
    }
    if (IN(9)) { REFRESH(); PROBE_BEGIN(9);
        if (!IN(8)) moe_tables(F);
        pg8::Gemm g{(const bf16*)(F.ws + WS_ACT), (const bf16*)(F.ws + WS_WD), D * MOE_ESZ / 2, DEXP * MOE_ESZ / 2, D * MOE_ESZ / 2, 123, 121};
        pg8::MoeDownOrder S{F.G, (int)blockIdx.x, (int)F.MISC[16], F.lds + TCLS_OFF, F.lds + TFIRST_OFF, (const LAS unsigned*)(F.lds + LCNT_OFF)};
        pg8::EpiDown E{(bf16*)(F.ws + WS_MOE), (const int*)(F.ws + WS_INV)};
        pg8::gemm_phase<pg8::EpiDown, pg8::MoeDownOrder, true, true, MOE_FP8 != 0>(F.lds + RING_OFF, g, S, E, F.tid);
        if (BOTH(9)) GRID_BAR(); PROBE_END(9);
    }
    if (IN(10)) { REFRESH(); PROBE_BEGIN(10); p10_final(F); PROBE_END(10); }
#if PROBE_MASK
    if (blockIdx.x == 0 && F.tid == 0) { const unsigned long long t0 = rt(); const unsigned long long w = (unsigned long long)F.MISC[20] * (PROBE_MULT); while (rt() - t0 < w) __builtin_amdgcn_s_sleep(32); }
#endif
#undef IN
#undef BOTH
}

extern "C" void kernel_launch(void* const* d_in, const int* in_sizes, int n_in, void* d_out, int out_size, void* d_ws, size_t ws_size, hipStream_t stream) {
    static int grid = 0;
    if (grid == 0) {
        if (n_in != 22 || in_sizes[0] != M * D || out_size != M * D || ws_size < WS_END) { fprintf(stderr, "kernel_launch: unexpected shapes (n_in %d, in0 %d, out %d, ws %zu); nothing launched\n", n_in, n_in > 0 ? in_sizes[0] : -1, out_size, ws_size); grid = -1; return; }
        int dev = 0, cus = 0, per_cu = 0;
        if (hipGetDevice(&dev) != hipSuccess || hipDeviceGetAttribute(&cus, hipDeviceAttributeMultiprocessorCount, dev) != hipSuccess) { fprintf(stderr, "kernel_launch: device query failed\n"); grid = -1; return; }
        if (hipFuncSetAttribute((const void*)mk_fwd, hipFuncAttributeMaxDynamicSharedMemorySize, LDS_BYTES) != hipSuccess) { fprintf(stderr, "kernel_launch: hipFuncSetAttribute failed\n"); grid = -1; return; }
        if (hipOccupancyMaxActiveBlocksPerMultiprocessor(&per_cu, (const void*)mk_fwd, NWAVES * 64, LDS_BYTES) != hipSuccess || per_cu < 1) { fprintf(stderr, "kernel_launch: occupancy query reports %d workgroups per CU\n", per_cu); (void)hipGetLastError(); grid = -1; return; }
        grid = cus;
        if (grid != 256) { fprintf(stderr, "kernel_launch: built for a 256-CU device (static unit orders), found %d CUs; nothing launched\n", cus); grid = -1; return; }
    }
    if (grid < 0) return;
    if (hipMemsetAsync((char*)d_ws + WS_CTL, 0, CTL_ZERO_BYTES, stream) != hipSuccess) { fprintf(stderr, "kernel_launch: hipMemsetAsync failed\n"); return; }
    Args a{};
    for (int i = 0; i < 22; ++i) a.in[i] = (const float*)d_in[i];
    a.out = (float*)d_out; a.ws = (unsigned char*)d_ws;
    if (N_LAUNCHES == 1) {
        a.ph_lo = 0; a.ph_hi = N_PHASES;
        void* kargs[] = {&a};
        const hipError_t le = hipLaunchCooperativeKernel((const void*)mk_fwd, dim3(grid), dim3(NWAVES * 64), kargs, LDS_BYTES, stream);
        if (le != hipSuccess) fprintf(stderr, "kernel_launch: cooperative launch failed: %s (grid %d)\n", hipGetErrorName(le), grid);
    } else {
        for (int li = 0; li < N_PHASES; ++li) { a.ph_lo = li; a.ph_hi = li + 1;
            hipLaunchKernelGGL(mk_fwd, dim3(grid), dim3(NWAVES * 64), LDS_BYTES, stream, a);
            const hipError_t le = hipPeekAtLastError();
            if (le != hipSuccess) { fprintf(stderr, "kernel_launch: launch %d failed: %s\n", li, hipGetErrorName(le)); break; } }
    }
}
```

```cpp
#include <hip/hip_runtime.h>
#include <hip/hip_bf16.h>
#include <cstdio>
#include <cstdint>
#include <cmath>

#ifndef MK_N_LAUNCHES
#define MK_N_LAUNCHES 1
#endif
#ifndef PROBE_MASK
#define PROBE_MASK 0
#endif
#ifndef PROBE_MULT
#define PROBE_MULT 4
#endif
#ifndef MOE_FP8
#define MOE_FP8 1
#endif
#define MOE_ESZ (MOE_FP8 ? 1 : 2)
#ifndef NAIVE_SGU
#define NAIVE_SGU 0
#endif
#ifndef NAIVE_ATTN
#define NAIVE_ATTN 0
#endif

constexpr int BATCH = 4, T = 8192, D = 1024, NH = 8, HD = 64, DH = 512;
constexpr int M = BATCH * T;
constexpr int NPROJ = 2560;
constexpr int LDW_IN = 2568;
constexpr int NADA = 6 * D;
constexpr int NEXP = 16, DEXP = 512, NCLS = 24;
constexpr int MAXTILES = 152;
constexpr float EPS = 1e-6f;
constexpr float C2 = 0.125f * 1.4426950408889634f;
constexpr float LOG2E = 1.4426950408889634f;

namespace pg8 {
#define PG8_LAS __attribute__((address_space(3)))
typedef unsigned short bf16_t;
typedef short bf16x8 __attribute__((ext_vector_type(8)));
typedef float f32x4 __attribute__((ext_vector_type(4)));
typedef unsigned u32x4 __attribute__((ext_vector_type(4)));
constexpr int BM = 256, BK = 64, HALF = 128, HTB = HALF * BK * 2  , STAGE_BYTES = 8 * HTB, NXCD = 8, WGM = 8;

__host__ __device__ __forceinline__ int lds_byte(int r, int c) { const int st = (r >> 4) * 2 + (c >> 5), rr = r & 15, cc = c & 31, ob = rr * 64 + cc * 2; return st * 1024 + (ob ^ (((ob >> 9) & 1) << 5)); }
__host__ __device__ __forceinline__ void stage_rc(int b, int& R, int& C) { const int st = b / 1024, sb = b % 1024, swz = sb ^ (((sb >> 9) & 1) << 5); R = (st >> 1) * 16 + swz / 64; C = (st & 1) * 32 + (swz % 64) / 2; }
__host__ __device__ __forceinline__ int perm32(int rho) { const int n = rho >> 4, i = rho & 15; return 8 * (i >> 2) + 4 * n + (i & 3); }

struct Unit { int pm, pn, aux; long aoff, boff, dboff; int cls, rank0, cnt, ord; };
struct Gemm { const bf16_t* A; const bf16_t* Bt; int lda, ldb, K; int scA, scB; };

struct StaticOrder {
    static constexpr bool GATHER = false;
    int nM, nN, nwg, G, c; long ta, tb;
    __host__ __device__ void init(int M, int N, int lda, int ldb, int G_, int c_) { nM = M / BM; nN = N / BM; nwg = nM * nN; G = G_; c = c_; ta = (long)BM * lda * 2; tb = (long)BM * ldb * 2; }
    __host__ __device__ bool next(int i, Unit& u) const {
        const long L = (long)i * G + c; if (L >= nwg) return false;
        int wgid = (int)L; { const int q = nwg / NXCD, r = nwg % NXCD, xcd = wgid % NXCD, off = wgid / NXCD; wgid = (xcd < r ? xcd * (q + 1) : r * (q + 1) + (xcd - r) * q) + off; }
        const int nig = WGM * nN, gid = wgid / nig, fm = gid * WGM, gsz = (nM - fm) < WGM ? (nM - fm) : WGM;
        u.pm = fm + ((wgid % nig) % gsz); u.pn = (wgid % nig) / gsz; u.aux = 0; u.aoff = u.pm * ta; u.boff = u.pn * tb; u.dboff = 0; u.cls = 0; u.rank0 = 0; u.cnt = 0; u.ord = i; return true;
    }
    __device__ __forceinline__ void a_ready(const Unit&) const {}
    __device__ __forceinline__ void done(const Unit&) const {}
};


__device__ __forceinline__ unsigned cvt_pk_bf16(float lo, float hi) { unsigned r; asm volatile("v_cvt_pk_bf16_f32 %0, %1, %2" : "=v"(r) : "v"(lo), "v"(hi)); return r; }
__device__ __forceinline__ float gelu_tanh(float v) {
    const float u = v * (1.5957691216057308f + 0.0713548162726f * v * v);
    return v * __builtin_amdgcn_rcpf(1.0f + __builtin_amdgcn_exp2f(-1.4426950408889634f * u));
}
__device__ __forceinline__ float silu_f(float v) { return v * __builtin_amdgcn_rcpf(1.0f + __builtin_amdgcn_exp2f(-1.4426950408889634f * v)); }

struct NoState {};
#define PG8_DPP_MAX(v, ctrl) fmaxf((v), __builtin_bit_cast(float, __builtin_amdgcn_update_dpp(0, __builtin_bit_cast(int, (v)), (ctrl), 0xf, 0xf, false)))
__device__ __forceinline__ float wave_max_nonneg(float v) {
    v = PG8_DPP_MAX(v, 0xB1); v = PG8_DPP_MAX(v, 0x4E); v = PG8_DPP_MAX(v, 0x141); v = PG8_DPP_MAX(v, 0x140);
    const int iv = __builtin_bit_cast(int, v);
    return fmaxf(fmaxf(__builtin_bit_cast(float, __builtin_amdgcn_readlane(iv, 0)), __builtin_bit_cast(float, __builtin_amdgcn_readlane(iv, 16))), fmaxf(__builtin_bit_cast(float, __builtin_amdgcn_readlane(iv, 32)), __builtin_bit_cast(float, __builtin_amdgcn_readlane(iv, 48))));
}
struct EpiProj {
    static constexpr bool PERM = true, AFTER_DRAIN = false, MID = false; typedef NoState State;
    bf16_t* O; unsigned* qkb;
    __device__ __forceinline__ void operator()(const f32x4 (&acc)[2][2][4][2], const State&, const Unit& u, int wr, int wc, int fr, int fq) const {
        const int row0 = u.pm * BM + wr * 64 + fr; const int seg = u.pn >> 1; float nmx[2] = {0.f, 0.f};
        bf16_t* base = O + (size_t)seg * ((size_t)M * 512);
        const int col0 = (u.pn & 1) * 256 + wc * 32 + 8 * fq;
#pragma unroll
        for (int ai = 0; ai < 2; ++ai)
#pragma unroll
            for (int m = 0; m < 4; ++m) { bf16_t* rowp = base + (size_t)(row0 + ai * HALF + m * 16) * 512 + col0;
#pragma unroll
                for (int bj = 0; bj < 2; ++bj) { f32x4 v0 = acc[ai][bj][m][0], v1 = acc[ai][bj][m][1];
                    if (seg < 2) {
#pragma unroll
                        for (int j = 0; j < 4; ++j) { v0[j] = gelu_tanh(v0[j]); v1[j] = gelu_tanh(v1[j]); }
                    } else if (seg == 2) { v0 = v0 * C2; v1 = v1 * C2; }
                    if (seg == 2 || seg == 3) { float s8 = ((v0[0] * v0[0] + v0[1] * v0[1]) + (v0[2] * v0[2] + v0[3] * v0[3])) + ((v1[0] * v1[0] + v1[1] * v1[1]) + (v1[2] * v1[2] + v1[3] * v1[3]));
                        { const auto r16 = __builtin_amdgcn_permlane16_swap(__float_as_uint(s8), __float_as_uint(s8), false, false); s8 = __uint_as_float(r16[0]) + __uint_as_float(r16[1]);
                          const auto r32 = __builtin_amdgcn_permlane32_swap(__float_as_uint(s8), __float_as_uint(s8), false, false); s8 = __uint_as_float(r32[0]) + __uint_as_float(r32[1]); }
                        nmx[bj] = fmaxf(nmx[bj], s8); }
                    u32x4 w; w.x = cvt_pk_bf16(v0[0], v0[1]); w.y = cvt_pk_bf16(v0[2], v0[3]); w.z = cvt_pk_bf16(v1[0], v1[1]); w.w = cvt_pk_bf16(v1[2], v1[3]);
                    *(u32x4*)(rowp + bj * HALF) = w; } }
        if (seg == 2 || seg == 3) {
#pragma unroll
            for (int bj = 0; bj < 2; ++bj) { const float wm = wave_max_nonneg(nmx[bj]); const int bh = (u.pm >> 5) * 8 + 4 * (u.pn & 1) + 2 * bj + (wc >> 1);
                if (fr == 0 && fq == 0) __hip_atomic_fetch_max(qkb + (seg == 3 ? bh * 16 + (u.pm & 15) : 512 + bh * 32 + (u.pm & 31)), __float_as_uint(wm), __ATOMIC_RELAXED, __HIP_MEMORY_SCOPE_AGENT); } }
    }
};
struct EpiMix {
    static constexpr bool PERM = true, AFTER_DRAIN = false, MID = true; struct State { float rs[2][4]; };
    bf16_t* O; const float* ssq;
    __device__ __forceinline__ void mid(f32x4 (&acc)[2][2][4][2], State& st, const Unit& u, int wr, int fr) const {
        int rb = u.pm * BM + wr * 64 + fr; asm volatile("" : "+v"(rb));
#pragma unroll
        for (int ai = 0; ai < 2; ++ai)
#pragma unroll
            for (int m = 0; m < 4; ++m) { const int r = rb + ai * HALF + m * 16; const f32x4* p = (const f32x4*)(ssq + (size_t)r * 16);
                const f32x4 s0 = p[0], s1 = p[1], f0 = p[2], f1 = p[3];
                const float a = ((s0[0] + s0[1]) + (s0[2] + s0[3])) + ((s1[0] + s1[1]) + (s1[2] + s1[3])), c = ((f0[0] + f0[1]) + (f0[2] + f0[3])) + ((f1[0] + f1[1]) + (f1[2] + f1[3]));
                const float rs = 1.f / sqrtf(a * (1.f / 512.f) + EPS), rf = 1.f / sqrtf(c * (1.f / 512.f) + EPS); st.rs[ai][m] = rs; const float ratio = rf / rs;
#pragma unroll
                for (int bj = 0; bj < 2; ++bj)
#pragma unroll
                    for (int n = 0; n < 2; ++n) acc[ai][bj][m][n] = acc[ai][bj][m][n] * ratio; }
    }
    __device__ __forceinline__ void operator()(const f32x4 (&acc)[2][2][4][2], const State& st, const Unit& u, int wr, int wc, int fr, int fq) const {
        const int row0 = u.pm * BM + wr * 64 + fr; const int col0 = u.pn * BM + wc * 32 + 8 * fq;
#pragma unroll
        for (int ai = 0; ai < 2; ++ai)
#pragma unroll
            for (int m = 0; m < 4; ++m) { bf16_t* rowp = O + (size_t)(row0 + ai * HALF + m * 16) * D + col0; const float rs = st.rs[ai][m];
#pragma unroll
                for (int bj = 0; bj < 2; ++bj) { const f32x4 v0 = acc[ai][bj][m][0] * rs, v1 = acc[ai][bj][m][1] * rs;
                    u32x4 w; w.x = cvt_pk_bf16(v0[0], v0[1]); w.y = cvt_pk_bf16(v0[2], v0[3]); w.z = cvt_pk_bf16(v1[0], v1[1]); w.w = cvt_pk_bf16(v1[2], v1[3]);
                    *(u32x4*)(rowp + bj * HALF) = w; } }
    }
};
struct EpiUp {
    static constexpr bool PERM = true, AFTER_DRAIN = false, MID = false; typedef NoState State;
    bf16_t* ACT; const float* TW; const int* INV;
    __device__ __forceinline__ void operator()(const f32x4 (&acc)[2][2][4][2], const State&, const Unit& u, int wr, int wc, int fr, int fq) const {
        const int s = u.aux >> 2, t = u.aux & 3; const int col0 = s * 512 + t * 128 + wc * 32 + 8 * fq; const int* inv = INV + (size_t)u.cls * M + u.rank0;
#pragma unroll
        for (int ai = 0; ai < 2; ++ai)
#pragma unroll
            for (int m = 0; m < 4; ++m) { const int rl = ai * HALF + wr * 64 + m * 16 + fr; const int r = u.pm * BM + rl; float w = 0.f;
                if (u.rank0 + rl < u.cnt) w = TW[(size_t)inv[rl] * 2 + s];
                float a[8];
#pragma unroll
                for (int n = 0; n < 2; ++n)
#pragma unroll
                    for (int j = 0; j < 4; ++j) a[n * 4 + j] = silu_f(acc[ai][0][m][n][j]) * acc[ai][1][m][n][j] * w;
#if MOE_FP8
                int p0 = 0, p1 = 0;
#pragma unroll
                for (int j = 0; j < 8; ++j) a[j] = __builtin_amdgcn_fmed3f(a[j] * 4.f, -448.f, 448.f);
                p0 = __builtin_amdgcn_cvt_pk_fp8_f32(a[0], a[1], p0, false); p0 = __builtin_amdgcn_cvt_pk_fp8_f32(a[2], a[3], p0, true);
                p1 = __builtin_amdgcn_cvt_pk_fp8_f32(a[4], a[5], p1, false); p1 = __builtin_amdgcn_cvt_pk_fp8_f32(a[6], a[7], p1, true);
                typedef int v2i_t __attribute__((ext_vector_type(2)));
                *(v2i_t*)((unsigned char*)ACT + (size_t)r * D + col0) = (v2i_t){p0, p1}; }
#else
                u32x4 o; o.x = cvt_pk_bf16(a[0], a[1]); o.y = cvt_pk_bf16(a[2], a[3]); o.z = cvt_pk_bf16(a[4], a[5]); o.w = cvt_pk_bf16(a[6], a[7]);
                *(u32x4*)(ACT + (size_t)r * D + col0) = o; }
#endif
    }
};
struct EpiDown {
    static constexpr bool PERM = true, AFTER_DRAIN = false, MID = false; typedef NoState State;
    bf16_t* O; const int* INV;
    __device__ __forceinline__ void operator()(const f32x4 (&acc)[2][2][4][2], const State&, const Unit& u, int wr, int wc, int fr, int fq) const {
        const int col0 = u.aux * BM + wc * 32 + 8 * fq; const int* inv = INV + (size_t)u.cls * M + u.rank0;
#pragma unroll
        for (int ai = 0; ai < 2; ++ai)
#pragma unroll
            for (int m = 0; m < 4; ++m) { const int rl = ai * HALF + wr * 64 + m * 16 + fr;
                if (u.rank0 + rl < u.cnt) { const int tok = inv[rl]; bf16_t* rowp = O + (size_t)tok * D + col0;
#pragma unroll
                    for (int bj = 0; bj < 2; ++bj) { const f32x4 v0 = acc[ai][bj][m][0], v1 = acc[ai][bj][m][1];
                        u32x4 w; w.x = cvt_pk_bf16(v0[0], v0[1]); w.y = cvt_pk_bf16(v0[2], v0[3]); w.z = cvt_pk_bf16(v1[0], v1[1]); w.w = cvt_pk_bf16(v1[2], v1[3]);
                        *(u32x4*)(rowp + bj * HALF) = w; } } }
    }
};
__device__ __forceinline__ int cls_expert(int cls, int s) { const int g = cls / 6, p = cls % 6; const int a = p < 3 ? 0 : (p < 5 ? 1 : 2); const int b = p < 3 ? p + 1 : (p < 5 ? p - 1 : 3); return g * 4 + (s ? b : a); }
struct MoeUpOrder {
    static constexpr bool GATHER = true;
    int G, c, NT; const PG8_LAS unsigned char* tcls; const PG8_LAS unsigned char* tfirst; const PG8_LAS unsigned* lcnt; const PG8_LAS unsigned* toku;
    __device__ __forceinline__ bool next(int i, Unit& u) const {
        const int x = c & 7, j = (c >> 3) + (G >> 3) * i; const int pm = 8 * (j >> 3) + x; if (pm >= NT) return false;
        const int st = j & 7; const int cls = (int)tcls[pm]; u.pm = pm; u.aux = st; u.pn = cls_expert(cls, st >> 2) * 4 + (st & 3);
        u.aoff = 0; u.boff = (long)u.pn * (BM * D * MOE_ESZ); u.dboff = 0; u.cls = cls; u.rank0 = (pm - (int)tfirst[cls]) * BM; u.cnt = (int)lcnt[cls]; u.ord = i; return true;
    }
    __device__ __forceinline__ unsigned row_off(const Unit& u, int r) const { return toku[u.ord * BM + r]; }
    __device__ __forceinline__ void a_ready(const Unit&) const {}
    __device__ __forceinline__ void done(const Unit&) const {}
};
struct MoeDownOrder {
    static constexpr bool GATHER = false;
    int G, c, NT; const PG8_LAS unsigned char* tcls; const PG8_LAS unsigned char* tfirst; const PG8_LAS unsigned* lcnt;
    __device__ __forceinline__ bool next(int i, Unit& u) const {
        const int x = c & 7, j = (c >> 3) + (G >> 3) * i; const int pm = 8 * (j >> 2) + x; if (pm >= NT) return false;
        const int nt = j & 3; const int cls = (int)tcls[pm]; const int ea = cls_expert(cls, 0), eb = cls_expert(cls, 1); u.pm = pm; u.aux = nt; u.pn = 0;
        u.aoff = (long)pm * (BM * D * MOE_ESZ); u.boff = ((long)ea * D + nt * BM) * (DEXP * MOE_ESZ); u.dboff = (long)(eb - ea) * D * (DEXP * MOE_ESZ) - DEXP * MOE_ESZ;
        u.cls = cls; u.rank0 = (pm - (int)tfirst[cls]) * BM; u.cnt = (int)lcnt[cls]; u.ord = i; return true;
    }
    __device__ __forceinline__ void a_ready(const Unit&) const {}
    __device__ __forceinline__ void done(const Unit&) const {}
};

template <class Epi, class Sched, bool ALIGN_EPI = false, bool SP2 = false, bool FP8 = false>
__device__ __forceinline__ void gemm_phase(PG8_LAS unsigned char* lds, const Gemm g, const Sched& S, const Epi& E, const int tid) {
    typedef int v4i_t __attribute__((ext_vector_type(4))); typedef int v8i_t __attribute__((ext_vector_type(8)));
    const int wid = __builtin_amdgcn_readfirstlane(tid >> 6), lane = tid & 63, wr = wid >> 2, wc = wid & 3, fr = lane & 15, fq = lane >> 4;
    const int K = g.K, nt = K / BK;
    static_assert(SP2, "only the two-super-phase loop is kept");
    const int nth = nt / 2;
    unsigned voffB[2]; int RR[2], CC2[2];
    unsigned cvo[2][2];
#pragma unroll
    for (int i = 0; i < 2; ++i) { int R, C; stage_rc(tid * 16 + i * 8192, R, C); const int Rb = Epi::PERM ? ((R & ~31) + perm32(R & 31)) : R;
        RR[i] = R; CC2[i] = C * 2; voffB[i] = (unsigned)(Rb * g.ldb + C) * 2u; }
#define PG8_AOFFS(dst, u) do { _Pragma("unroll") for (int _h = 0; _h < 2; ++_h) _Pragma("unroll") for (int _i = 0; _i < 2; ++_i) { \
        if constexpr (Sched::GATHER) dst[_h][_i] = S.row_off(u, _h * HALF + RR[_i]) + (unsigned)CC2[_i]; else dst[_h][_i] = (unsigned)((_h * HALF + RR[_i]) * g.lda) * 2u + (unsigned)CC2[_i]; } } while (0)
    const size_t kstep = (size_t)(BK * 2);
    const size_t hstep = (size_t)HALF * g.ldb * 2;
    const unsigned ldsw = (unsigned)wid * 1024u;
    int aofs[2], bofs[2];
    if constexpr (FP8) { aofs[0] = lds_byte(wr * 64 + fr, 16 * (fq & 1)) + (fq >> 1) * 1024; aofs[1] = lds_byte(wr * 64 + fr, 16 * (fq & 1) + 8) + (fq >> 1) * 1024;
                         bofs[0] = lds_byte(wc * 32 + fr, 16 * (fq & 1)) + (fq >> 1) * 1024; bofs[1] = lds_byte(wc * 32 + fr, 16 * (fq & 1) + 8) + (fq >> 1) * 1024; }
    else { aofs[0] = lds_byte(wr * 64 + fr, fq * 8); aofs[1] = aofs[0] + 1024; bofs[0] = lds_byte(wc * 32 + fr, fq * 8); bofs[1] = bofs[0] + 1024; }
#define PG8_SA(b, h) (((b) * 2 + (h)) * HTB)
#define PG8_SB(b, h) ((4 + (b) * 2 + (h)) * HTB)
#define PG8_STAGE(bufoff, gbase, voff) do { _Pragma("unroll") for (int _i = 0; _i < 2; ++_i) \
        __builtin_amdgcn_global_load_lds((const unsigned*)((const char*)(gbase) + (voff)[_i]), (PG8_LAS unsigned*)(lds + (bufoff) + ldsw + _i * 8192), 16, 0, 0); } while (0)
#define PG8_LD16(off) (*(const PG8_LAS v4i_t*)(lds + (off)))
#define PG8_LDA(dst, b, h) do { if constexpr (FP8) { _Pragma("unroll") for (int m = 0; m < 4; ++m) dst##8[m] = *(const PG8_LAS v8i_t*)(lds + PG8_SA(b, h) + aofs[0] + m * 2048); }     \
        else { _Pragma("unroll") for (int m = 0; m < 4; ++m) _Pragma("unroll") for (int k = 0; k < 2; ++k) dst[m][k] = *(const PG8_LAS bf16x8*)(lds + PG8_SA(b, h) + aofs[k] + m * 2048); } } while (0)
#define PG8_LDB(dst, b, h) do { if constexpr (FP8) { _Pragma("unroll") for (int n = 0; n < 2; ++n) dst##8[n] = *(const PG8_LAS v8i_t*)(lds + PG8_SB(b, h) + bofs[0] + n * 2048); } \
        else { _Pragma("unroll") for (int n = 0; n < 2; ++n) _Pragma("unroll") for (int k = 0; k < 2; ++k) dst[n][k] = *(const PG8_LAS bf16x8*)(lds + PG8_SB(b, h) + bofs[k] + n * 2048); } } while (0)
#define PG8_PINACC(ai, bj) do { if constexpr (FP8) { _Pragma("unroll") for (int m = 0; m < 4; ++m) _Pragma("unroll") for (int n = 0; n < 2; ++n) asm volatile("" : "+v"(acc[ai][bj][m][n])); } } while (0)
#define PG8_MMA(ai, bj, At, Bt) do { PG8_PINACC(ai, bj); __builtin_amdgcn_s_setprio(1); _Pragma("unroll") for (int m = 0; m < 4; ++m) _Pragma("unroll") for (int n = 0; n < 2; ++n) { \
        if constexpr (FP8) acc[ai][bj][m][n] = __builtin_amdgcn_mfma_scale_f32_16x16x128_f8f6f4(Bt##8[n], At##8[m], acc[ai][bj][m][n], 0, 0, 0, g.scB, 0, g.scA); \
        else { _Pragma("unroll") for (int k = 0; k < 2; ++k) acc[ai][bj][m][n] = __builtin_amdgcn_mfma_f32_16x16x32_bf16(Bt[n][k], At[m][k], acc[ai][bj][m][n], 0, 0, 0); } } \
        PG8_PINACC(ai, bj); __builtin_amdgcn_s_setprio(0); } while (0)
#define PG8_WAIT_V(n) asm volatile("s_waitcnt vmcnt(" #n ")" ::: "memory")
#define PG8_WAIT_L(n) asm volatile("s_waitcnt lgkmcnt(" #n ")" ::: "memory")
#define PG8_BAR __builtin_amdgcn_s_barrier()
#define PG8_SCHED __builtin_amdgcn_sched_barrier(0)
    Unit cur, nxt; int ui = 0;
    if (!S.next(0, cur)) return;
    f32x4 acc[2][2][4][2]; typename Epi::State est;
#pragma unroll
    for (int a = 0; a < 2; ++a)
#pragma unroll
        for (int b = 0; b < 2; ++b)
#pragma unroll
            for (int m = 0; m < 4; ++m)
#pragma unroll
                for (int n = 0; n < 2; ++n) acc[a][b][m][n] = (f32x4){0.f, 0.f, 0.f, 0.f};
    bf16x8 At[4][2], B0[2][2], B1[2][2]; v8i_t At8[4], B08[2], B18[2];
    const char* cA = (const char*)g.A + cur.aoff; const char* cB = (const char*)g.Bt + cur.boff;
    S.a_ready(cur);
    PG8_AOFFS(cvo, cur);
    if constexpr (SP2) {
        PG8_STAGE(PG8_SB(0, 0), cB, voffB); PG8_STAGE(PG8_SB(0, 1), cB + hstep, voffB); PG8_STAGE(PG8_SA(0, 0), cA, cvo[0]); PG8_STAGE(PG8_SA(0, 1), cA, cvo[1]);
        if (wr == 1) PG8_BAR;
        PG8_WAIT_V(2); PG8_BAR;
        PG8_STAGE(PG8_SB(1, 0), cB + kstep, voffB); PG8_STAGE(PG8_SA(1, 0), cA + kstep, cvo[0]); PG8_STAGE(PG8_SB(1, 1), cB + hstep + kstep, voffB);
        PG8_WAIT_V(6); PG8_BAR;
    }
    for (;;) {
        const bool has_next = S.next(ui + 1, nxt);
        const char* nA = has_next ? (const char*)g.A + nxt.aoff : cA; const char* nB = has_next ? (const char*)g.Bt + nxt.boff : cB;
#pragma unroll 1
        for (int t = 0; t < nt; t += 2) {
            if constexpr (Epi::MID) { if (t == nt / 2) E.mid(acc, est, cur, wr, fr); }
            const bool last = (t == nt - 2);
            const char* a1 = cA + (size_t)(t + 1) * kstep;
            const char* a2 = last ? nA : cA + (size_t)(t + 2) * kstep; const char* b2 = last ? nB : cB + (size_t)(t + 2) * kstep + ((t + 2 >= nth) ? cur.dboff : 0);
            unsigned xo[2][2];
            if constexpr (Sched::GATHER) { if (last && has_next) { PG8_AOFFS(xo, nxt); } else { xo[0][0] = cvo[0][0]; xo[0][1] = cvo[0][1]; xo[1][0] = cvo[1][0]; xo[1][1] = cvo[1][1]; } }
            else { xo[0][0] = cvo[0][0]; xo[0][1] = cvo[0][1]; xo[1][0] = cvo[1][0]; xo[1][1] = cvo[1][1]; }
            const char* a3 = a2 + kstep; const char* b3 = b2 + kstep;
            if (last && has_next) S.a_ready(nxt);
            if constexpr (SP2) {
            PG8_LDB(B0, 0, 0); PG8_LDB(B1, 0, 1); PG8_SCHED; PG8_LDA(At, 0, 0); PG8_STAGE(PG8_SA(1, 1), a1, cvo[1]);
            PG8_WAIT_V(8); PG8_WAIT_L(0); PG8_BAR; PG8_MMA(0, 0, At, B0); PG8_MMA(0, 1, At, B1); PG8_BAR; PG8_SCHED;
            PG8_LDA(At, 0, 1); PG8_STAGE(PG8_SB(0, 0), b2, voffB); PG8_STAGE(PG8_SB(0, 1), b2 + hstep, voffB); PG8_STAGE(PG8_SA(0, 0), a2, xo[0]);
            PG8_WAIT_V(8); PG8_WAIT_L(0); PG8_BAR; PG8_MMA(1, 0, At, B0); PG8_MMA(1, 1, At, B1); PG8_BAR; PG8_SCHED;
            PG8_LDB(B0, 1, 0); PG8_LDB(B1, 1, 1); PG8_SCHED; PG8_LDA(At, 1, 0); PG8_STAGE(PG8_SA(0, 1), a2, xo[1]);
            PG8_WAIT_V(8); PG8_WAIT_L(0); PG8_BAR; PG8_MMA(0, 0, At, B0); PG8_MMA(0, 1, At, B1); PG8_BAR; PG8_SCHED;
            PG8_LDA(At, 1, 1); PG8_STAGE(PG8_SB(1, 0), b3, voffB); PG8_STAGE(PG8_SB(1, 1), b3 + hstep, voffB); PG8_STAGE(PG8_SA(1, 0), a3, xo[0]);
            if constexpr (Sched::GATHER) { if (last) { cvo[0][0] = xo[0][0]; cvo[0][1] = xo[0][1]; cvo[1][0] = xo[1][0]; cvo[1][1] = xo[1][1]; } }
            PG8_WAIT_V(8); PG8_WAIT_L(0); PG8_BAR; PG8_MMA(1, 0, At, B0); PG8_MMA(1, 1, At, B1); PG8_BAR; PG8_SCHED;
            }
        }
        if constexpr (ALIGN_EPI) { if (wr == 0) PG8_BAR; }
        if constexpr (!Epi::AFTER_DRAIN) { E(acc, est, cur, wr, wc, fr, fq); S.done(cur); }
        if (!has_next) break;
#pragma unroll
        for (int a = 0; a < 2; ++a)
#pragma unroll
            for (int b = 0; b < 2; ++b)
#pragma unroll
                for (int m = 0; m < 4; ++m)
#pragma unroll
                    for (int n = 0; n < 2; ++n) acc[a][b][m][n] = (f32x4){0.f, 0.f, 0.f, 0.f};
        cur = nxt; cA = nA; cB = nB; ++ui;
        if constexpr (ALIGN_EPI) { if (wr == 1) PG8_BAR; }
    }
    PG8_WAIT_V(0);
    if constexpr (!ALIGN_EPI) { if (wr == 0) PG8_BAR; }
    PG8_BAR;
#undef PG8_SA
#undef PG8_SB
#undef PG8_STAGE
#undef PG8_AOFFS
#undef PG8_LDA
#undef PG8_LD16
#undef PG8_LDB
#undef PG8_MMA
#undef PG8_PINACC
#undef PG8_WAIT_V
#undef PG8_WAIT_L
#undef PG8_BAR
#undef PG8_SCHED
}
}
namespace attn_body {
using bf16=__hip_bfloat16;
using bf16x8=__attribute__((ext_vector_type(8)))short;
using s16x4=__attribute__((ext_vector_type(4)))short;
using f32x16=__attribute__((ext_vector_type(16)))float;
using u32x4=__attribute__((ext_vector_type(4)))unsigned;
constexpr int BATCH=4,NHEAD=8,SEQ=8192,D=64,DM=NHEAD*D,OPITCH=1024;
constexpr int NW=8,QBLK=32,QB=QBLK*NW,KVBLK=64,NQB=SEQ/QB;
constexpr int ATTN_PITCH=DM, ATTN_UNIT_ROWS=QB;
__device__ __forceinline__ int crow(int r,int hi){return (r&3)+8*(r>>2)+4*hi;}
#define SBAR() __builtin_amdgcn_sched_barrier(0)
__device__ __forceinline__ void cmask(f32x16&p0,f32x16&p1,int jb,int qrel,int hi){
  const float NEG=-INFINITY; int kb=64*jb+4*hi-qrel; asm volatile("":"+v"(kb));
  #pragma unroll
  for(int r=0;r<16;++r){const int c=(r&3)+8*(r>>2); if(kb>-c)p0[r]=NEG; if(kb>-c-32)p1[r]=NEG;}
}

constexpr int NSLOT=3, SLOTB=8192;
constexpr float TCUT=45.f;
constexpr int LDS_K=0, LDS_V=NSLOT*SLOTB, LDS_WS=2*NSLOT*SLOTB, LDS_OST=LDS_WS+NW*64*4, LDS_TAB=LDS_OST+NW*4096, LDS_BYTES=LDS_TAB+SEQ*8;
__device__ __forceinline__ void glds16(const void*gsrc,unsigned lds_dst){unsigned keep;
  asm volatile("s_mov_b32 %0, m0\n\ts_mov_b32 m0, %2\n\ts_nop 0\n\tglobal_load_lds_dwordx4 %1, off\n\ts_mov_b32 m0, %0":"=&s"(keep):"v"(gsrc),"s"(lds_dst):"memory");}
__device__ __forceinline__ void glds16s(const void*sbase,unsigned voff,unsigned lds_dst){unsigned keep;
  asm volatile("s_nop 4\n\ts_mov_b32 %0, m0\n\ts_mov_b32 m0, %3\n\ts_nop 0\n\tglobal_load_lds_dwordx4 %1, %2\n\ts_mov_b32 m0, %0":"=&s"(keep):"v"(voff),"s"(sbase),"s"(lds_dst):"memory");}
__device__ __forceinline__ float max3f(float a,float b,float c){float r;asm("v_max3_f32 %0, %1, %2, %3":"=v"(r):"v"(a),"v"(b),"v"(c));return r;}
__device__ __forceinline__ float max2f(float a,float b){float r;asm("v_max_f32_e32 %0, %1, %2":"=v"(r):"v"(a),"v"(b));return r;}
__device__ __forceinline__ float fadd_s(float a,float b){float r;asm("v_add_f32_e32 %0, %1, %2":"=v"(r):"v"(a),"v"(b));return r;}
__device__ __forceinline__ float fsub_s(float a,float b){float r;asm("v_sub_f32_e32 %0, %1, %2":"=v"(r):"v"(a),"v"(b));return r;}
typedef float f32x2_t __attribute__((ext_vector_type(2))); typedef __bf16 bf16x2_t __attribute__((ext_vector_type(2)));
__device__ __forceinline__ unsigned cvtpk_s(float lo,float hi){f32x2_t v={lo,hi};bf16x2_t b=__builtin_convertvector(v,bf16x2_t);return __builtin_bit_cast(unsigned,b);}
#define WAIT_BAR(N) asm volatile("s_waitcnt vmcnt(" #N ") lgkmcnt(0)\n\ts_barrier":::"memory")

__device__ __forceinline__ void qkt(f32x16&p0,f32x16&p1,const char*Kslot,const bf16x8*qr,const bf16x8 qx,const bf16x8 kx0,const bf16x8 kx1,int r32,int hi){
  const f32x16 negm=f32x16{};
  const char*kb=Kslot+hi*1024+r32*16;
  #pragma unroll
  for(int d0=0;d0<4;++d0){
    const bf16x8 b0=*reinterpret_cast<const bf16x8*>(kb+d0*2048);
    const bf16x8 b1=*reinterpret_cast<const bf16x8*>(kb+d0*2048+512);
    if(d0==0){p0=__builtin_amdgcn_mfma_f32_32x32x16_bf16(b0,qr[0],negm,0,0,0);p1=__builtin_amdgcn_mfma_f32_32x32x16_bf16(b1,qr[0],negm,0,0,0);}
    else{p0=__builtin_amdgcn_mfma_f32_32x32x16_bf16(b0,qr[d0],p0,0,0,0);p1=__builtin_amdgcn_mfma_f32_32x32x16_bf16(b1,qr[d0],p1,0,0,0);}}
  p0=__builtin_amdgcn_mfma_f32_32x32x16_bf16(kx0,qx,p0,0,0,0);p1=__builtin_amdgcn_mfma_f32_32x32x16_bf16(kx1,qx,p1,0,0,0);
}
typedef __attribute__((address_space(3))) const char* lds_cptr;
typedef short v4i16_t __attribute__((ext_vector_type(4)));
__device__ __forceinline__ void kload8(bf16x8*kf,lds_cptr kp){
  kf[0]=*(const __attribute__((address_space(3))) bf16x8*)(kp);      kf[1]=*(const __attribute__((address_space(3))) bf16x8*)(kp+512);
  kf[2]=*(const __attribute__((address_space(3))) bf16x8*)(kp+2048); kf[3]=*(const __attribute__((address_space(3))) bf16x8*)(kp+2560);
  kf[4]=*(const __attribute__((address_space(3))) bf16x8*)(kp+4096); kf[5]=*(const __attribute__((address_space(3))) bf16x8*)(kp+4608);
  kf[6]=*(const __attribute__((address_space(3))) bf16x8*)(kp+6144); kf[7]=*(const __attribute__((address_space(3))) bf16x8*)(kp+6656);
}
__device__ __forceinline__ void kload2(bf16x8*kf,lds_cptr kp,int j){ kf[2*j]=*(const __attribute__((address_space(3))) bf16x8*)(kp+j*2048); kf[2*j+1]=*(const __attribute__((address_space(3))) bf16x8*)(kp+j*2048+512); }
__device__ __forceinline__ s16x4 vtr(lds_cptr p){ return __builtin_bit_cast(s16x4,__builtin_amdgcn_ds_read_tr16_b64_v4i16((__attribute__((address_space(3))) v4i16_t*)p)); }
typedef unsigned u32x2_t __attribute__((ext_vector_type(2)));
__device__ __forceinline__ u32x2_t ldkx_raw(lds_cptr p){ return *(const __attribute__((address_space(3))) u32x2_t*)p; }
__device__ __forceinline__ bf16x8 mkkx(u32x2_t w){ const u32x4 v={w.x,w.y,0x3F803F80u,0u}; return __builtin_bit_cast(bf16x8,v); }
__device__ __forceinline__ bf16x8 ldkx(lds_cptr p){ const u32x2_t w=*(const __attribute__((address_space(3))) u32x2_t*)p; const u32x4 v={w.x,w.y,0x3F803F80u,0u}; return __builtin_bit_cast(bf16x8,v); }
__device__ __forceinline__ bf16x8 make_qx(float a,int hi){
  const unsigned ah=cvtpk_s(a,0.f)&0xffffu; const float r1=a-__uint_as_float(ah<<16);
  const unsigned am=cvtpk_s(r1,0.f)&0xffffu; const float r2=r1-__uint_as_float(am<<16);
  u32x4 v={0x3F803F80u,0x3F80u|(ah<<16),cvtpk_s(r1,r2),0u};
  if(hi){v=(u32x4){0u,0u,0u,0u};}
  return __builtin_bit_cast(bf16x8,v);
}
__device__ __forceinline__ float rowmax(const f32x16&p0,const f32x16&p1){
  float a=max3f(p0[0],p0[1],p1[0]),b=max3f(p0[2],p0[3],p1[1]);a=max3f(a,p1[2],p1[3]);
  #pragma unroll
  for(int r=4;r<16;r+=4){a=max3f(a,p0[r],p0[r+1]);b=max3f(b,p0[r+2],p0[r+3]);a=max3f(a,p1[r],p1[r+1]);b=max3f(b,p1[r+2],p1[r+3]);}
  const float m=max2f(a,b);
  auto rr=__builtin_amdgcn_permlane32_swap(__float_as_uint(m),__float_as_uint(m),false,false);
  return max2f(__uint_as_float(rr[0]),__uint_as_float(rr[1]));
}
__device__ __forceinline__ void pv(f32x16*o,int vb,bf16x8 pa0,bf16x8 pa1,bf16x8 pa2,bf16x8 pa3){
  #pragma unroll
  for(int d0=0;d0<2;++d0){s16x4 lo[4],hi[4];
    #pragma unroll
    for(int ks=0;ks<4;++ks){
      asm volatile("ds_read_b64_tr_b16 %0,%1 offset:%c2":"=&v"(lo[ks]):"v"(vb),"i"(d0*4096+ks*1024):"memory");
      asm volatile("ds_read_b64_tr_b16 %0,%1 offset:%c2":"=&v"(hi[ks]):"v"(vb),"i"(d0*4096+ks*1024+512):"memory");}
    asm volatile("s_waitcnt lgkmcnt(0)":::"memory");SBAR();
    #define PK(k) (bf16x8){lo[k][0],lo[k][1],lo[k][2],lo[k][3],hi[k][0],hi[k][1],hi[k][2],hi[k][3]}
    o[d0]=__builtin_amdgcn_mfma_f32_32x32x16_bf16(pa0,PK(0),o[d0],0,0,0);
    o[d0]=__builtin_amdgcn_mfma_f32_32x32x16_bf16(pa1,PK(1),o[d0],0,0,0);
    o[d0]=__builtin_amdgcn_mfma_f32_32x32x16_bf16(pa2,PK(2),o[d0],0,0,0);
    o[d0]=__builtin_amdgcn_mfma_f32_32x32x16_bf16(pa3,PK(3),o[d0],0,0,0);
    #undef PK
  }
}

#ifndef ATTN_STORE16
#define ATTN_STORE16(p,v) (*(u32x4*)(p)=(v))
#endif
template<int THRL> __device__ __forceinline__ void attn_unit(int b,int h,int qb,const bf16*Q,const bf16*__restrict__ K,const bf16*__restrict__ V,bf16*O,const unsigned long long*KX8,const float*GF,const float*QKB,float*SSQ,char*shm,const int tid){
  const int lane=tid&63,r32=lane&31,hi=lane>>5; const int wid=__builtin_amdgcn_readfirstlane(tid>>6);
  const long rowbase=(long)b*SEQ; const int q0=qb*QB;
  const bf16*Qw=Q+(rowbase+q0+wid*QBLK)*DM+h*D;
  const bf16*Kh=K+rowbase*DM+h*D,*Vh=V+rowbase*DM+h*D;
  const unsigned lds0=(unsigned)(uintptr_t)shm;
  float*wsf=(float*)(shm+LDS_WS)+wid*64;
  const bf16*ksrc=Kh+wid*8;
  const bf16*vsrc=Vh+(long)(16*(wid&3))*DM+(wid>>2)*32;
  const unsigned kvoff=(unsigned)lane*(DM*2), vvoff=(unsigned)((lane>>2)*DM+(lane&3)*8)*2u;
  const unsigned kdst=lds0+LDS_K+wid*1024, vdst=lds0+LDS_V+wid*1024;
  #define DMA_K(t,slot) glds16s(ksrc+(long)(NT-1-(t))*KVBLK*DM,kvoff,(unsigned)__builtin_amdgcn_readfirstlane(kdst+(slot)))
  #define DMA_V(t,slot) glds16s(vsrc+(long)(NT-1-(t))*KVBLK*DM,vvoff,(unsigned)__builtin_amdgcn_readfirstlane(vdst+(slot)))
  const int vb0=(int)(lds0+LDS_V)+((lane>>4)&1)*32+(lane&3)*8+(4*hi+((lane&15)>>2))*64;
  const char*Kbase=shm+LDS_K; bf16x8 kf[8];
  const lds_cptr shm3=(lds_cptr)shm; const lds_cptr kp0=shm3+LDS_K+hi*1024+r32*16; const lds_cptr vp0=shm3+LDS_V+((lane>>4)&1)*32+(lane&3)*8+(4*hi+((lane&15)>>2))*64;
  const int NT=(q0+QB)/KVBLK;
  const lds_cptr tp0=shm3+LDS_TAB+r32*8;
  const float nGi=-GF[(long)(b*NHEAD+h)*SEQ+q0+wid*QBLK+r32];
  float gl0,gl1,gthr,bqk;
  { const float*gfh=GF+(long)(b*NHEAD+h)*SEQ; gl0=(lane<NT)?gfh[64*lane+63]:3.0e38f; gl1=(lane+64<NT)?gfh[64*(lane+64)+63]:3.0e38f;
    float kp=QKB[(b*NHEAD+h)*16+(lane&15)];
    #define DPPMAX_(v,c) fmaxf((v),__builtin_bit_cast(float,__builtin_amdgcn_update_dpp(0,__builtin_bit_cast(int,(v)),(c),0xf,0xf,false)))
    kp=DPPMAX_(kp,0xB1);kp=DPPMAX_(kp,0x4E);kp=DPPMAX_(kp,0x141);kp=DPPMAX_(kp,0x140);
    #undef DPPMAX_
    const float bq=2.04f*sqrtf(QKB[512+(b*NHEAD+h)*32+qb]*kp);
    gthr=gfh[q0]-(TCUT+2.f*bq); bqk=bq; }
  DMA_K(0,0);DMA_V(0,0);DMA_K(1,SLOTB);
  bf16x8 qr[4];
  #pragma unroll
  for(int d0=0;d0<4;++d0)qr[d0]=*reinterpret_cast<const bf16x8*>(&Qw[(long)r32*DM+d0*16+hi*8]);
  { float dd=0.f; const bf16*Kd=Kh+(long)(q0+wid*QBLK+r32)*DM+hi*8;
    #pragma unroll
    for(int d0=0;d0<4;++d0){ const bf16x8 kk=*reinterpret_cast<const bf16x8*>(Kd+d0*16);
      #pragma unroll
      for(int j=0;j<8;++j)dd+=__uint_as_float((unsigned)(unsigned short)qr[d0][j]<<16)*__uint_as_float((unsigned)(unsigned short)kk[j]<<16); }
    { const auto rr=__builtin_amdgcn_permlane32_swap(__float_as_uint(dd),__float_as_uint(dd),false,false); dd=__uint_as_float(rr[0])+__uint_as_float(rr[1]); }
    float vm=dd-nGi;
    #define DPPMIN_(v,c) fminf((v),__builtin_bit_cast(float,__builtin_amdgcn_update_dpp(0,__builtin_bit_cast(int,(v)),(c),0xf,0xf,false)))
    vm=DPPMIN_(vm,0xB1);vm=DPPMIN_(vm,0x4E);vm=DPPMIN_(vm,0x141);vm=DPPMIN_(vm,0x140);
    #undef DPPMIN_
    { const auto rr=__builtin_amdgcn_permlane16_swap(__float_as_uint(vm),__float_as_uint(vm),false,false); vm=fminf(__uint_as_float(rr[0]),__uint_as_float(rr[1])); }
    if(lane==0)wsf[0]=vm; }
  int NS=NT;
  { const int cnt=__builtin_popcountll(__ballot(gl0<gthr))+__builtin_popcountll(__ballot(gl1<gthr)); int tlo=cnt&~1; if(tlo>NT-4)tlo=NT-4; NS=__builtin_amdgcn_readfirstlane(NT-tlo); }
  { const char*tsrc=(const char*)(KX8+(long)(b*NHEAD+h)*SEQ); const int npc=2*(qb+1);
    for(int pc=((NT-NS)>>1)+wid;pc<npc;pc+=NW)glds16s(tsrc+(long)pc*1024,(unsigned)lane*16u,(unsigned)__builtin_amdgcn_readfirstlane(lds0+LDS_TAB+pc*1024)); }
  float mhat=0.f,l_reg=0.f;f32x16 o[2];o[0]=f32x16{};o[1]=f32x16{};bf16x8 qx=make_qx(nGi,hi);const f32x16 zc=f32x16{};
  if(hi==0)wsf[32+r32]=nGi;
  const int qrel=wid*QBLK+r32;
  #define CMASK(P0,P1,t) do{int jb_=3-(t); if(jb_>=0)cmask(P0,P1,jb_,qrel,hi);}while(0)
  bool resc=false;
  #define START(P0,P1) do{ const float rm=rowmax(P0,P1); resc=false; \
    { const float dl=(rm<-1e30f)?0.f:rm; mhat=fadd_s(mhat,dl); \
      _Pragma("unroll") for(int r=0;r<16;++r){P0[r]=fsub_s(P0[r],dl);P1[r]=fsub_s(P1[r],dl);} \
      qx=make_qx(nGi-mhat,hi); } \
    _Pragma("unroll") for(int r=0;r<16;++r)P0[r]=__builtin_amdgcn_exp2f(P0[r]); }while(0)
  #define RESC() do{ if(resc){ asm volatile("s_waitcnt lgkmcnt(0)":::"memory"); \
      _Pragma("unroll") for(int d_=0;d_<2;++d_) _Pragma("unroll") for(int r=0;r<16;++r)o[d_][r]*=wsf[crow(r,hi)]; } }while(0)
  f32x16 pA0,pA1,pB0,pB1;
  int sl_prev=0,sl_cur=0,sl_next=SLOTB;
  #define ROT() do{sl_prev=sl_cur;sl_cur=sl_next;sl_next=(sl_next==(NSLOT-1)*SLOTB)?0:sl_next+SLOTB;}while(0)
  DMA_K(2,2*SLOTB);
  WAIT_BAR(1);
  { float bm=((const float*)(shm+LDS_WS))[0];
    #pragma unroll
    for(int w_=1;w_<NW;++w_)bm=fminf(bm,((const float*)(shm+LDS_WS))[w_*64]);
    const float gthr2=bm-bqk-TCUT-0.05f;
    const int cnt=__builtin_popcountll(__ballot(gl0<gthr2))+__builtin_popcountll(__ballot(gl1<gthr2)); int tlo=cnt&~1; if(tlo>NT-4)tlo=NT-4; const int ns2=__builtin_amdgcn_readfirstlane(NT-tlo); if(ns2<NS)NS=ns2; }
  qkt(pA0,pA1,Kbase,qr,qx,ldkx(tp0+(NT-1)*512),ldkx(tp0+(NT-1)*512+256),r32,hi);asm volatile("s_nop 15\n\ts_nop 7":"+v"(pA0),"+v"(pA1));CMASK(pA0,pA1,0);
  START(pA0,pA1);
  _Pragma("unroll") for(int r=0;r<16;++r)pA1[r]=__builtin_amdgcn_exp2f(pA1[r]);
  WAIT_BAR(0);
  DMA_K(3,0);DMA_V(1,SLOTB);
  ROT();
  kload8(kf,kp0+sl_cur);
  WAIT_BAR(2);
  s16x4 vlo[8],vhi[8]; u32x4 pw0,pw1,pw2,pw3;
  #define PKW(P,B) cvtpk_s(P[B],P[B+1])
  #define PAF(k) __builtin_bit_cast(bf16x8,pw##k)
  #define VFR(i) (bf16x8){vlo[i][0],vlo[i][1],vlo[i][2],vlo[i][3],vhi[i][0],vhi[i][1],vhi[i][2],vhi[i][3]}
  #define PIN(x) asm volatile("":"+v"(x))
  #define MX3(a,b,c) __builtin_fmaxf(__builtin_fmaxf((a),(b)),(c))
  #define GAPA(MF,A0,A1,A2,A3,W0,W1,PW) do{ MF; sacc+=A0; sacc+=A1; sacc+=A2; sacc+=A3; PIN(sacc); W0; W1; PIN(PW); SBAR(); }while(0)
  #define EX(v) __builtin_amdgcn_exp2f(v)
  #define GAPB(MF,X,B) do{ MF; X[B]=EX(X[B]); X[B+1]=EX(X[B+1]); X[B+2]=EX(X[B+2]); X[B+3]=EX(X[B+3]); PIN(X); SBAR(); }while(0)
  #define VRD(i) do{ vlo[i]=vtr(vp_+(((i)>>2)*4096+((i)&3)*1024)); vhi[i]=vtr(vp_+(((i)>>2)*4096+((i)&3)*1024+512)); }while(0)
  #define KRD(G,j) do{ if(G){ kload2(kf,kp0+sl_next,j); SBAR(); } }while(0)
  #define STEP(C0,C1,P0,P1,t,GK,GV,GL) do{ SBAR(); \
    const lds_cptr vp_=vp0+sl_prev; \
    const u32x2_t kq0_=ldkx_raw(tp0+(NT-1-(t))*512), kq1_=ldkx_raw(tp0+(NT-1-(t))*512+256); \
    VRD(0); SBAR(); float sacc=(P0[0]+P0[1]); \
    GAPA(C0=__builtin_amdgcn_mfma_f32_32x32x16_bf16(kf[0],qr[0],zc,0,0,0), P0[2],P0[3],P0[4],P0[5],     pw0[0]=PKW(P0,0), pw0[1]=PKW(P0,2), pw0); \
    VRD(4); SBAR(); GAPA(C1=__builtin_amdgcn_mfma_f32_32x32x16_bf16(kf[1],qr[0],zc,0,0,0), P0[6],P0[7],P0[8],P0[9],     pw0[2]=PKW(P0,4), pw0[3]=PKW(P0,6), pw0); \
    C0=__builtin_amdgcn_mfma_f32_32x32x16_bf16(mkkx(kq0_),qx,C0,0,0,0); SBAR(); C1=__builtin_amdgcn_mfma_f32_32x32x16_bf16(mkkx(kq1_),qx,C1,0,0,0); SBAR(); \
    VRD(1); SBAR(); GAPA(C0=__builtin_amdgcn_mfma_f32_32x32x16_bf16(kf[2],qr[1],C0,0,0,0),   P0[10],P0[11],P0[12],P0[13], pw1[0]=PKW(P0,8), pw1[1]=PKW(P0,10), pw1); \
    VRD(5); SBAR(); GAPA(C1=__builtin_amdgcn_mfma_f32_32x32x16_bf16(kf[3],qr[1],C1,0,0,0),   P0[14],P0[15],P1[0],P1[1],   pw1[2]=PKW(P0,12),pw1[3]=PKW(P0,14), pw1); \
    VRD(2); SBAR(); GAPA(C0=__builtin_amdgcn_mfma_f32_32x32x16_bf16(kf[4],qr[2],C0,0,0,0),   P1[2],P1[3],P1[4],P1[5],     pw2[0]=PKW(P1,0), pw2[1]=PKW(P1,2), pw2); \
    VRD(6); SBAR(); GAPA(C1=__builtin_amdgcn_mfma_f32_32x32x16_bf16(kf[5],qr[2],C1,0,0,0),   P1[6],P1[7],P1[8],P1[9],     pw2[2]=PKW(P1,4), pw2[3]=PKW(P1,6), pw2); \
    VRD(3); SBAR(); GAPA(C0=__builtin_amdgcn_mfma_f32_32x32x16_bf16(kf[6],qr[3],C0,0,0,0),   P1[10],P1[11],P1[12],P1[13], pw3[0]=PKW(P1,8), pw3[1]=PKW(P1,10), pw3); \
    VRD(7); SBAR(); GAPA(C1=__builtin_amdgcn_mfma_f32_32x32x16_bf16(kf[7],qr[3],C1,0,0,0),   P1[14],P1[15],0.f,0.f,       pw3[2]=PKW(P1,12),pw3[3]=PKW(P1,14), pw3); \
    l_reg+=sacc; \
    if(GK){DMA_K((t)+3,sl_cur);} if(GV){DMA_V((t)+1,sl_next);} \
    CMASK(C0,C1,t); \
    { float a=MX3(C0[0],C0[1],C1[0]),b=MX3(C0[2],C0[3],C1[1]); a=MX3(a,C1[2],C1[3]); \
      _Pragma("unroll") for(int r=4;r<16;r+=4){a=MX3(a,C0[r],C0[r+1]);b=MX3(b,C0[r+2],C0[r+3]);a=MX3(a,C1[r],C1[r+1]);b=MX3(b,C1[r+2],C1[r+3]);} \
      float rm=__builtin_fmaxf(a,b); { auto rr=__builtin_amdgcn_permlane32_swap(__float_as_uint(rm),__float_as_uint(rm),false,false); rm=__builtin_fmaxf(__uint_as_float(rr[0]),__uint_as_float(rr[1])); } \
      resc=false; \
      if(__builtin_expect(__any(rm>(float)THRL),0)){ const float dl=__builtin_fmaxf(rm,0.f); mhat+=dl; \
        _Pragma("unroll") for(int r=0;r<16;++r){C0[r]-=dl;C1[r]-=dl;} \
        qx=make_qx(wsf[32+r32]-mhat,hi); \
        const float f=__builtin_amdgcn_exp2f(-dl); l_reg*=f; if(hi==0)wsf[r32]=f; resc=true; } } \
    SBAR(); \
    GAPB(o[0]=__builtin_amdgcn_mfma_f32_32x32x16_bf16(PAF(0),VFR(0),o[0],0,0,0), C0,0); \
    GAPB(o[1]=__builtin_amdgcn_mfma_f32_32x32x16_bf16(PAF(0),VFR(4),o[1],0,0,0), C0,4); \
    KRD(GL,0); GAPB(o[0]=__builtin_amdgcn_mfma_f32_32x32x16_bf16(PAF(1),VFR(1),o[0],0,0,0), C0,8); \
    KRD(GL,1); GAPB(o[1]=__builtin_amdgcn_mfma_f32_32x32x16_bf16(PAF(1),VFR(5),o[1],0,0,0), C0,12); \
    KRD(GL,2); GAPB(o[0]=__builtin_amdgcn_mfma_f32_32x32x16_bf16(PAF(2),VFR(2),o[0],0,0,0), C1,0); \
    KRD(GL,3); GAPB(o[1]=__builtin_amdgcn_mfma_f32_32x32x16_bf16(PAF(2),VFR(6),o[1],0,0,0), C1,4); \
    GAPB(o[0]=__builtin_amdgcn_mfma_f32_32x32x16_bf16(PAF(3),VFR(3),o[0],0,0,0), C1,8); \
    GAPB(o[1]=__builtin_amdgcn_mfma_f32_32x32x16_bf16(PAF(3),VFR(7),o[1],0,0,0), C1,12); \
    }while(0)
  int t=1;
  #define ENDW(tt) do{ if((tt)+3<NS){WAIT_BAR(2);} else if((tt)+2<NS){WAIT_BAR(1);} else {WAIT_BAR(0);} }while(0)
  for(;t<5&&t+1<NS;t+=2){
    STEP(pB0,pB1,pA0,pA1,t,(t+3<NS),(t+1<NS),(t+1<NS));       ENDW(t);   RESC(); ROT();
    STEP(pA0,pA1,pB0,pB1,t+1,(t+4<NS),(t+2<NS),(t+2<NS));     ENDW(t+1); RESC(); ROT();
  }
  #undef CMASK
  #define CMASK(P0,P1,t) do{}while(0)
  for(;t+5<NS;t+=2){
    STEP(pB0,pB1,pA0,pA1,t,true,true,true);     WAIT_BAR(2); RESC(); ROT();
    STEP(pA0,pA1,pB0,pB1,t+1,true,true,true);   WAIT_BAR(2); RESC(); ROT();
  }
  #undef CMASK
  #define CMASK(P0,P1,t) do{int jb_=3-(t); if(jb_>=0)cmask(P0,P1,jb_,qrel,hi);}while(0)
  for(;t+1<NS;t+=2){
    STEP(pB0,pB1,pA0,pA1,t,(t+3<NS),(t+1<NS),(t+1<NS));       ENDW(t);   RESC(); ROT();
    STEP(pA0,pA1,pB0,pB1,t+1,(t+4<NS),(t+2<NS),(t+2<NS));     ENDW(t+1); RESC(); ROT();
  }
  STEP(pB0,pB1,pA0,pA1,NS-1,false,false,false); RESC();
  { float sacc=pB0[0]+pB0[1]; _Pragma("unroll") for(int r=2;r<16;++r)sacc+=pB0[r]; _Pragma("unroll") for(int r=0;r<16;++r)sacc+=pB1[r]; l_reg+=sacc;
    pw0=(u32x4){PKW(pB0,0),PKW(pB0,2),PKW(pB0,4),PKW(pB0,6)};pw1=(u32x4){PKW(pB0,8),PKW(pB0,10),PKW(pB0,12),PKW(pB0,14)};pw2=(u32x4){PKW(pB1,0),PKW(pB1,2),PKW(pB1,4),PKW(pB1,6)};pw3=(u32x4){PKW(pB1,8),PKW(pB1,10),PKW(pB1,12),PKW(pB1,14)};
    SBAR(); pv(o,vb0+sl_cur,PAF(0),PAF(1),PAF(2),PAF(3)); }
  #undef PKW
  #undef PAF
  #undef VFR
  #undef PIN
  #undef MX3
  #undef GAPA
  #undef GAPB
  #undef EX
  #undef VRD
  #undef KRD
  #undef STEP
  #undef ENDW
  {auto rr=__builtin_amdgcn_permlane32_swap(__float_as_uint(l_reg),__float_as_uint(l_reg),false,false);l_reg=__uint_as_float(rr[0])+__uint_as_float(rr[1]);}
  if(hi==0)wsf[32+r32]=l_reg;asm volatile("s_waitcnt lgkmcnt(0)":::"memory");
  float rli[16];
  #pragma unroll
  for(int r=0;r<16;++r)rli[r]=__builtin_amdgcn_rcpf(wsf[32+crow(r,hi)]);
  bf16*Ow=O+(rowbase+q0+wid*QBLK)*OPITCH+h*D;
  { bf16*stg=(bf16*)(shm+LDS_OST)+wid*2048;
    #pragma unroll
    for(int r=0;r<16;++r){const int orow=crow(r,hi);
      #pragma unroll
      for(int d0=0;d0<2;++d0)stg[orow*64+d0*32+r32]=__float2bfloat16(o[d0][r]*rli[r]);}
    asm volatile("s_waitcnt lgkmcnt(0)":::"memory");
    #pragma unroll
    for(int i=0;i<4;++i){const int row=i*8+(lane>>3),ch=lane&7; const u32x4 v=*(const u32x4*)(stg+row*64+ch*8); ATTN_STORE16(Ow+(long)row*OPITCH+ch*8,v);
      float q=0.f;
      #pragma unroll
      for(int e=0;e<4;++e){const float lo=__uint_as_float(v[e]<<16),hh=__uint_as_float(v[e]&0xffff0000u);q+=lo*lo+hh*hh;}
      q+=__shfl_xor(q,1);q+=__shfl_xor(q,2);q+=__shfl_xor(q,4);
      if(ch==0)SSQ[(rowbase+q0+wid*QBLK+row)*16+8+h]=q;} }
  asm volatile("s_waitcnt lgkmcnt(0)\n\ts_barrier":::"memory");
  #undef DMA_K
  #undef DMA_V
  #undef CMASK
  #undef START
  #undef RESC
  #undef ROT
}
constexpr int ATTN_LDS_BYTES=LDS_BYTES;
struct AttnTensors { const bf16* Q; const bf16* K; const bf16* V; bf16* O; const unsigned long long* KX8; const float* GF; const float* QKB; float* SSQ; };
struct AttnUnit { int bh; int qb; };
struct StaticOrder {
  int vcu;
  __device__ __forceinline__ explicit StaticOrder(int grid,int block):vcu((block%8)*(grid/8)+block/8){}
  __device__ __forceinline__ bool next(int i,AttnUnit&u)const{ if(i>=4)return false; const int s=vcu&7; u.bh=((vcu>>3)+8*i)&31;     u.qb=(i==0)?s:(i==1)?15-s:(i==2)?16+s:31-s; return true; }
  __device__ __forceinline__ void a_ready(const AttnUnit&)const{}
  __device__ __forceinline__ void done(const AttnUnit&)const{}
};
template<class Sched,int THRL=8> __device__ __forceinline__ void attn_phase(char*lds,const AttnTensors&T,const Sched&S,const int tid){
  AttnUnit u;
  for(int i=0;S.next(i,u);++i){ S.a_ready(u); attn_unit<THRL>(u.bh/NHEAD,u.bh%NHEAD,u.qb,T.Q,T.K,T.V,T.O,T.KX8,T.GF,T.QKB,T.SSQ,lds,tid); S.done(u); }
}
#undef SBAR
#undef WAIT_BAR
}

constexpr int NWAVES = 8;
constexpr int N_PHASES = 11;
constexpr int N_LAUNCHES = MK_N_LAUNCHES;

constexpr size_t MiB = 1u << 20;
constexpr size_t WS_CTL = 0, CTL_ZERO_BYTES = 64 * 1024;
constexpr size_t WS_ADAP = 14 * MiB;
constexpr size_t WS_ADA = 2 * MiB;
constexpr size_t WS_WSM = WS_ADA + 128 * 1024;
constexpr size_t WS_LC = 3 * MiB;
constexpr size_t WS_CT = 4 * MiB;
constexpr size_t WS_TOKC = WS_CT + 64 * 1024;
constexpr size_t WS_TW = WS_TOKC + 256 * 1024;
constexpr size_t WS_SSQY = 5 * MiB;
constexpr size_t WS_SSQ1 = 7 * MiB;
constexpr size_t WS_SSQ2 = 9 * MiB;
constexpr size_t WS_INV = 11 * MiB;
constexpr size_t WS_TOK = 14 * MiB;
constexpr size_t WS_SW = WS_TOK + 256 * 1024;
constexpr size_t WS_WIN = 16 * MiB;
constexpr size_t WS_WOUT = 22 * MiB;
constexpr size_t WS_WGU = 24 * MiB;
constexpr size_t WS_WD = 56 * MiB;
constexpr size_t WS_XN = 104 * MiB;
constexpr size_t WS_U = 168 * MiB;
constexpr size_t WS_Y = 328 * MiB;
constexpr size_t WS_H2 = WS_XN;
constexpr size_t WS_H2S = 168 * MiB;
constexpr size_t WS_ACT = 244 * MiB;
constexpr size_t WS_KX8 = 392 * MiB;
constexpr size_t WS_GF = 394 * MiB;
constexpr size_t WS_MIX = 396 * MiB;
constexpr size_t WS_MOE = WS_XN;
constexpr size_t WS_X1 = WS_Y;
constexpr size_t WS_END = 460 * MiB;
static_assert(WS_ACT + (size_t)MAXTILES * 256 * 1024 * 2 <= WS_Y && WS_H2S + (size_t)MAXTILES * 256 * 1024 * 2 <= WS_ACT, "d_ws map");
constexpr int CW_TMO = 0, CW_CODE = 1;
constexpr int CW_CNT = 64, CNT_STRIDE = 64;
constexpr int CW_QKB = 2048;
constexpr int CW_BAR = 4096;
constexpr int RING_OFF = 0, RING_BYTES = 155648;
constexpr int LDSCTL_OFF = RING_BYTES, MISC_OFF = LDSCTL_OFF + 320;
constexpr int TCLS_OFF = LDSCTL_OFF + 512;
constexpr int TFIRST_OFF = LDSCTL_OFF + 704;
constexpr int LCNT_OFF = LDSCTL_OFF + 768;
constexpr int TOKU_OFF = LDSCTL_OFF + 1024;
constexpr int LDS_BYTES = 163840;

#define GAS __attribute__((address_space(1)))
#define LAS __attribute__((address_space(3)))
typedef unsigned short bf16;
typedef unsigned v4u __attribute__((ext_vector_type(4)));
typedef float f32x4 __attribute__((ext_vector_type(4)));
typedef short bf16x8 __attribute__((ext_vector_type(8)));
typedef GAS unsigned gu32;
typedef GAS unsigned long long gu64;
#define RLX_AGENT __ATOMIC_RELAXED, __HIP_MEMORY_SCOPE_AGENT
#define LDS_WAIT() asm volatile("s_waitcnt lgkmcnt(0)" ::: "memory")
#define VM_WAIT() asm volatile("s_waitcnt vmcnt(0)" ::: "memory")
__device__ __forceinline__ unsigned long long rt() { return __builtin_amdgcn_s_memrealtime(); }
__device__ __forceinline__ unsigned f2bf(float f) { unsigned u = __builtin_bit_cast(unsigned, f); return (u + 0x7fffu + ((u >> 16) & 1u)) >> 16; }
typedef float f32x2_hw __attribute__((ext_vector_type(2))); typedef __bf16 bf16x2_hw __attribute__((ext_vector_type(2)));
__device__ __forceinline__ unsigned pk2(float lo, float hi) { const f32x2_hw v = {lo, hi}; const bf16x2_hw b = __builtin_convertvector(v, bf16x2_hw); return __builtin_bit_cast(unsigned, b); }

#define XB_TMO      128
#define XB_XCNT(j)  (256  + 64 * (j))
#define XB_XSUB(j)  (1280 + 64 * (j))
#define XB_XGEN(j)  (2304 + 64 * (j))
#define XB_TOP      3328
#define XB_TOPGEN   3392
#define XCD_BAR_WORDS 3456
#define XB_SPIN_CAP (1u << 18)

__device__ __forceinline__ unsigned xb_ld(unsigned* p)              { return __hip_atomic_load(p, __ATOMIC_RELAXED, __HIP_MEMORY_SCOPE_AGENT); }
__device__ __forceinline__ unsigned xb_add(unsigned* p, unsigned v) { return __hip_atomic_fetch_add(p, v, __ATOMIC_RELAXED, __HIP_MEMORY_SCOPE_AGENT); }
__device__ __forceinline__ unsigned xb_xcc_id() { return (unsigned)__builtin_amdgcn_s_getreg((3 << 11) | 20) & 0xFu; }
#define XB_SPIN(cond, bar) do { unsigned _sp = 0; while (cond) { __builtin_amdgcn_s_sleep(1); \
    if ((++_sp & 255u) == 0u) { if (xb_ld(&(bar)[XB_TMO])) break; if (_sp > XB_SPIN_CAP) { atomicAdd(&(bar)[XB_TMO], 1u); break; } } } } while (0)

struct XcdBarrier {
    unsigned* bar; unsigned x;
    volatile LAS unsigned* st;
};

__device__ __forceinline__ XcdBarrier xcd_barrier_post(unsigned* bar, volatile LAS unsigned* st) {
    XcdBarrier b; b.bar = bar; b.x = xb_xcc_id(); b.st = st;
    if (threadIdx.x == 0) (void)xb_add(&bar[XB_XCNT(b.x)], 1u);
    return b;
}
__device__ __forceinline__ void xcd_barrier_complete(unsigned* bar, unsigned x, unsigned& nloc, unsigned& nx) {
    const unsigned G = gridDim.x * gridDim.y * gridDim.z;
    unsigned sum, cnt, mine, sp = 0u;
    for (;;) {
        sum = 0u; cnt = 0u; mine = 0u;
#pragma unroll
        for (unsigned j = 0; j < 16; ++j) { const unsigned c = xb_ld(&bar[XB_XCNT(j)]); sum += c; cnt += (c > 0u) ? 1u : 0u; mine = (j == x) ? c : mine; }
        if (sum == G) break;
        __builtin_amdgcn_s_sleep(1);
        if ((++sp & 255u) == 0u) { if (xb_ld(&bar[XB_TMO])) break; if (sp > XB_SPIN_CAP) { atomicAdd(&bar[XB_TMO], 1u); break; } }
    }
    nloc = mine > 0u ? mine : 1u; nx = cnt > 0u ? cnt : 1u;
}

__device__ __forceinline__ void xcd_barrier(const XcdBarrier& b) {
    asm volatile("s_waitcnt vmcnt(0)" ::: "memory");
    __syncthreads();
    if (threadIdx.x == 0) {
        unsigned* bar = b.bar;
        __builtin_amdgcn_s_waitcnt(0);
        unsigned nloc = b.st[0], nx = b.st[1];
        if (nloc == 0u) { xcd_barrier_complete(bar, b.x, nloc, nx); b.st[0] = nloc; b.st[1] = nx; }
        const unsigned old = xb_add(&bar[XB_XSUB(b.x)], 1u);
        const unsigned gen = old / nloc;
        if (old + 1u == (gen + 1u) * nloc) {
            __builtin_amdgcn_fence(__ATOMIC_RELEASE, "agent");
            asm volatile("s_waitcnt vmcnt(0)" ::: "memory");
            const unsigned og = xb_add(&bar[XB_TOP], 1u);
            const unsigned tg = og / nx;
            if (og + 1u == (tg + 1u) * nx) xb_add(&bar[XB_TOPGEN], 1u);
            else XB_SPIN(xb_ld(&bar[XB_TOPGEN]) == tg, bar);
            __builtin_amdgcn_fence(__ATOMIC_ACQUIRE, "agent");
            xb_add(&bar[XB_XGEN(b.x)], 1u);
            asm volatile("s_waitcnt vmcnt(0)" ::: "memory");
        } else {
            XB_SPIN(xb_ld(&bar[XB_XGEN(b.x)]) == gen, bar);
            __builtin_amdgcn_fence(__ATOMIC_ACQUIRE, "agent");
            asm volatile("s_waitcnt vmcnt(0)" ::: "memory");
        }
    }
    __syncthreads();
}

struct Frame {
    LAS unsigned char* lds;
    volatile LAS unsigned* MISC;
    gu32* ctl;
    int tid, lane, wave;
    int vcu, G;
    unsigned char* ws;
    const float *x, *c, *w_ada, *b_ada, *g_mix, *w_in, *g_sgu, *w_sp, *b_sp, *b_fg, *g_osgu, *g_ofox, *w_out, *g_ffn, *w_rg, *b_rg, *w_re, *b_re, *w_gate, *w_up, *w_down, *g_fin;
    float* out;
};
#define DPP_ADD(v, ctrl) ((v) + __builtin_bit_cast(float, __builtin_amdgcn_update_dpp(0, __builtin_bit_cast(int, (v)), (ctrl), 0xf, 0xf, false)))
__device__ __forceinline__ float wave_sum(float v) {
    v = DPP_ADD(v, 0xB1); v = DPP_ADD(v, 0x4E); v = DPP_ADD(v, 0x141); v = DPP_ADD(v, 0x140);
    const int iv = __builtin_bit_cast(int, v);
    const float a = __builtin_bit_cast(float, __builtin_amdgcn_readlane(iv, 0)), b = __builtin_bit_cast(float, __builtin_amdgcn_readlane(iv, 16)), c = __builtin_bit_cast(float, __builtin_amdgcn_readlane(iv, 32)), e = __builtin_bit_cast(float, __builtin_amdgcn_readlane(iv, 48));
    return (a + b) + (c + e);
}
#define DPP_MOV(v, ctrl) __builtin_bit_cast(float, __builtin_amdgcn_update_dpp(0, __builtin_bit_cast(int, (v)), (ctrl), 0xf, 0xf, false))
#define SWZ_ADD(v, pat) ((v) + __builtin_bit_cast(float, __builtin_amdgcn_ds_swizzle(__builtin_bit_cast(int, (v)), (pat))))
__device__ __forceinline__ float sum_b2_b5(float v) { v = SWZ_ADD(v, 0x101F); v = SWZ_ADD(v, 0x201F); v = SWZ_ADD(v, 0x401F);
    const auto rr = __builtin_amdgcn_permlane32_swap(__float_as_uint(v), __float_as_uint(v), false, false); return __uint_as_float(rr[0]) + __uint_as_float(rr[1]); }
__device__ __forceinline__ void wave_sum8_t(const float (&v)[8], int lane, float& r0, float& r1) {
    const bool b0 = (lane & 1) != 0, b1 = (lane & 2) != 0; float a[4], c[2];
#pragma unroll
    for (int i = 0; i < 4; ++i) { const float keep = b0 ? v[i + 4] : v[i], send = b0 ? v[i] : v[i + 4]; a[i] = keep + DPP_MOV(send, 0xB1); }
#pragma unroll
    for (int i = 0; i < 2; ++i) { const float keep = b1 ? a[i + 2] : a[i], send = b1 ? a[i] : a[i + 2]; c[i] = keep + DPP_MOV(send, 0x4E); }
    r0 = sum_b2_b5(c[0]); r1 = sum_b2_b5(c[1]);
}
__device__ __forceinline__ void wave_sum4_all(float (&v)[4], int lane) {
    const bool b0 = (lane & 1) != 0, b1 = (lane & 2) != 0; float a[2];
#pragma unroll
    for (int i = 0; i < 2; ++i) { const float keep = b0 ? v[i + 2] : v[i], send = b0 ? v[i] : v[i + 2]; a[i] = keep + DPP_MOV(send, 0xB1); }
    const float keep = b1 ? a[1] : a[0], send = b1 ? a[0] : a[1]; float c = keep + DPP_MOV(send, 0x4E);
    c = sum_b2_b5(c); const int ic = __builtin_bit_cast(int, c);
    v[0] = __builtin_bit_cast(float, __builtin_amdgcn_readlane(ic, 0)); v[1] = __builtin_bit_cast(float, __builtin_amdgcn_readlane(ic, 2)); v[2] = __builtin_bit_cast(float, __builtin_amdgcn_readlane(ic, 1)); v[3] = __builtin_bit_cast(float, __builtin_amdgcn_readlane(ic, 3));
}
__device__ __forceinline__ float wave_max(float v) {
#pragma unroll
    for (int o = 1; o < 64; o <<= 1) v = fmaxf(v, __shfl_xor(v, o));
    return v;
}
__device__ __forceinline__ int lane_id_fresh() { int t, l; asm volatile("v_mbcnt_lo_u32_b32 %0, -1, 0" : "=v"(t)); asm volatile("v_mbcnt_hi_u32_b32 %0, -1, %1" : "=v"(l) : "v"(t)); return l; }
__device__ __forceinline__ float bf2f(unsigned short h) { return __uint_as_float((unsigned)h << 16); }

__device__ __forceinline__ void p0_tr_item(const float* W, int ldw, int k0, int n0, bf16* dst, int ldt, const float* kscale, LAS float* scr, int lane) {
    typedef float f32x2_t __attribute__((ext_vector_type(2)));
    f32x2_t tv[32];
#pragma unroll
    for (int i = 0; i < 32; ++i) { const int kk = 2 * i + (lane >> 5); tv[i] = *(const f32x2_t*)(W + (size_t)(k0 + kk) * ldw + n0 + 2 * (lane & 31)); }
    if (kscale) {
#pragma unroll
        for (int i = 0; i < 32; ++i) tv[i] = tv[i] * kscale[k0 + 2 * i + (lane >> 5)]; }
#pragma unroll
    for (int i = 0; i < 32; ++i) { LAS float* p = scr + (2 * i + (lane >> 5)) * 65 + 2 * (lane & 31); p[0] = tv[i].x; p[1] = tv[i].y; }
    LDS_WAIT(); asm volatile("" ::: "memory");
    const int c = lane & 7;
#pragma unroll
    for (int j = 0; j < 8; ++j) { const int n = (lane >> 3) + 8 * j; const LAS float* s = scr + (8 * c) * 65 + n;
        v4u o; o.x = pk2(s[0 * 65], s[1 * 65]); o.y = pk2(s[2 * 65], s[3 * 65]); o.z = pk2(s[4 * 65], s[5 * 65]); o.w = pk2(s[6 * 65], s[7 * 65]);
        *(GAS v4u*)(dst + (size_t)n * ldt + 8 * c) = o; }
    LDS_WAIT(); asm volatile("" ::: "memory");
}
__device__ __forceinline__ void p0_tr_item8(const float* W, int ldw, int k0, int n0, unsigned char* dst, int ldt, float scale, LAS float* scr, int lane) {
    typedef float f32x2_t __attribute__((ext_vector_type(2))); typedef int v2i_t __attribute__((ext_vector_type(2)));
    f32x2_t tv[32];
#pragma unroll
    for (int i = 0; i < 32; ++i) { const int kk = 2 * i + (lane >> 5); tv[i] = *(const f32x2_t*)(W + (size_t)(k0 + kk) * ldw + n0 + 2 * (lane & 31)); }
#pragma unroll
    for (int i = 0; i < 32; ++i) { LAS float* p = scr + (2 * i + (lane >> 5)) * 65 + 2 * (lane & 31); p[0] = __builtin_amdgcn_fmed3f(tv[i].x * scale, -448.f, 448.f); p[1] = __builtin_amdgcn_fmed3f(tv[i].y * scale, -448.f, 448.f); }
    LDS_WAIT(); asm volatile("" ::: "memory");
    const int c = lane & 7;
#pragma unroll
    for (int j = 0; j < 8; ++j) { const int n = (lane >> 3) + 8 * j; const LAS float* s = scr + (8 * c) * 65 + n; int p0 = 0, p1 = 0;
        p0 = __builtin_amdgcn_cvt_pk_fp8_f32(s[0 * 65], s[1 * 65], p0, false); p0 = __builtin_amdgcn_cvt_pk_fp8_f32(s[2 * 65], s[3 * 65], p0, true);
        p1 = __builtin_amdgcn_cvt_pk_fp8_f32(s[4 * 65], s[5 * 65], p1, false); p1 = __builtin_amdgcn_cvt_pk_fp8_f32(s[6 * 65], s[7 * 65], p1, true);
        *(v2i_t*)(dst + (size_t)n * ldt + 8 * c) = (v2i_t){p0, p1}; }
    LDS_WAIT(); asm volatile("" ::: "memory");
}
__device__ __forceinline__ void p0_prologue(Frame& F) {
    LAS float* scr = (LAS float*)(F.lds + RING_OFF + F.wave * 16896);
    const int gw = F.vcu * NWAVES + F.wave, NGW = F.G * NWAVES;
    bf16* WIN = (bf16*)(F.ws + WS_WIN); bf16* WOUT = (bf16*)(F.ws + WS_WOUT); bf16* WGU = (bf16*)(F.ws + WS_WGU); bf16* WD = (bf16*)(F.ws + WS_WD);
    constexpr int I_ADA = 16 * 24;
    constexpr int I_IN = (D / 64) * (NPROJ / 64);
    constexpr int I_OUT = (D / 64) * (D / 64);
    constexpr int I_GU1 = (D / 64) * (DEXP / 64);
    constexpr int I_GU = NEXP * 2 * I_GU1;
    constexpr int I_DC1 = (DEXP / 64) * (D / 64);
    constexpr int I_DC = NEXP * I_DC1;
    constexpr int I_SM = 8 * 128 * 128 / 512;
    constexpr int NITEMS = I_ADA + I_IN + I_OUT + I_SM;
    for (int it = gw; it < NITEMS; it += NGW) {
        int r = it;
        if (r < I_ADA) {
            const int kp = r / 24, cg = r % 24; const int n = cg * 256 + F.lane * 4;
            f32x4 a0 = {0.f, 0.f, 0.f, 0.f}, a1 = a0, a2 = a0, a3 = a0;
#pragma unroll
            for (int q = 0; q < 4; ++q) { const int idx = q * 64 + F.lane; const float cv = F.c[(idx >> 6) * D + kp * 64 + (idx & 63)]; scr[idx] = cv / (1.f + __expf(-cv)); }
            LDS_WAIT(); asm volatile("" ::: "memory");
#pragma unroll 2
            for (int k0 = 0; k0 < 64; k0 += 32) { f32x4 w[32];
#pragma unroll
                for (int kk = 0; kk < 32; ++kk) w[kk] = *(const f32x4*)(F.w_ada + (size_t)(kp * 64 + k0 + kk) * NADA + n);
#pragma unroll
                for (int kk = 0; kk < 32; ++kk) { a0 += w[kk] * scr[k0 + kk]; a1 += w[kk] * scr[64 + k0 + kk]; a2 += w[kk] * scr[128 + k0 + kk]; a3 += w[kk] * scr[192 + k0 + kk]; } }
            LDS_WAIT(); asm volatile("" ::: "memory");
            float* P = (float*)(F.ws + WS_ADAP) + (size_t)kp * 4 * NADA + n;
            *(f32x4*)(P) = a0; *(f32x4*)(P + NADA) = a1; *(f32x4*)(P + 2 * NADA) = a2; *(f32x4*)(P + 3 * NADA) = a3;
            continue; }
        r -= I_ADA;
        if (r < I_IN) { const int kb = r / (NPROJ / 64), nb = r % (NPROJ / 64); p0_tr_item(F.w_in, LDW_IN, 64 * kb, 64 * nb, WIN + (size_t)(64 * nb) * D + 64 * kb, D, nullptr, scr, F.lane); continue; }
        r -= I_IN;
        if (r < I_OUT) { const int kb = r / (D / 64), nb = r % (D / 64); const int k0 = 64 * kb;
            p0_tr_item(F.w_out, D, k0, 64 * nb, WOUT + (size_t)(64 * nb) * D + (k0 < DH ? k0 + DH : k0 - DH), D, k0 < DH ? F.g_osgu : F.g_ofox - DH, scr, F.lane); continue; }
        r -= I_OUT;
        { bf16* WSM = (bf16*)(F.ws + WS_WSM);
#pragma unroll
          for (int j = 0; j < 8; ++j) { const int idx = r * 512 + j * 64 + F.lane; const int tt = (idx >> 7) & 127, ss = idx & 127; const float v = F.w_sp[idx]; WSM[idx] = (bf16)f2bf(ss <= tt ? v : 0.f); } }
    }
}

__device__ __forceinline__ void p3_convert(Frame& F) {
    int lane = lane_id_fresh();
    LAS float* scr = (LAS float*)(F.lds + RING_OFF + F.wave * 16896);
    bf16* WGU = (bf16*)(F.ws + WS_WGU); bf16* WD = (bf16*)(F.ws + WS_WD);
    constexpr int I_GU1 = (D / 64) * (DEXP / 64), I_GU = NEXP * 2 * I_GU1, I_DC1 = (DEXP / 64) * (D / 64), I_DC = NEXP * I_DC1, NIT = I_GU + I_DC;
    const int per = (NIT + F.G - 1) / F.G;
    __syncthreads();
    for (int it = F.vcu * per + F.wave; it < (F.vcu + 1) * per && it < NIT; it += NWAVES) {
        int r = it;
        if (r < I_GU) { const int e = r / (2 * I_GU1), r2 = r % (2 * I_GU1), isup = r2 / I_GU1, r3 = r2 % I_GU1; const int kb = r3 / (DEXP / 64), nb = r3 % (DEXP / 64); const int n0 = 64 * nb;
            const float* W = (isup ? F.w_up : F.w_gate) + (size_t)e * D * DEXP; const int drow = (n0 >> 7) * 256 + isup * 128 + (n0 & 127);
#if MOE_FP8
            p0_tr_item8(W, DEXP, 64 * kb, n0, (unsigned char*)WGU + ((size_t)e * 1024 + drow) * D + 64 * kb, D, 64.f, scr, lane); continue; }
#else
            p0_tr_item(W, DEXP, 64 * kb, n0, WGU + ((size_t)e * 1024 + drow) * D + 64 * kb, D, nullptr, scr, lane); continue; }
#endif
        r -= I_GU;
        if (r < I_DC) { const int e = r / I_DC1, r3 = r % I_DC1; const int kb = r3 / (D / 64), nb = r3 % (D / 64);
#if MOE_FP8
            p0_tr_item8(F.w_down + (size_t)e * DEXP * D, D, 64 * kb, 64 * nb, (unsigned char*)WD + ((size_t)e * D + 64 * nb) * DEXP + 64 * kb, DEXP, 64.f, scr, lane); continue; }
#else
            p0_tr_item(F.w_down + (size_t)e * DEXP * D, D, 64 * kb, 64 * nb, WD + ((size_t)e * D + 64 * nb) * DEXP + 64 * kb, DEXP, nullptr, scr, lane); continue; }
#endif
    }
    __syncthreads();
}
__device__ __forceinline__ void p1_load(Frame& F, f32x4 (&v)[2][4], int ch, int rl) {
#pragma unroll
    for (int rr = 0; rr < 2; ++rr) { const f32x4* xr = (const f32x4*)(F.x + (size_t)(ch * 128 + rl + 8 * rr) * D) + F.lane;
#pragma unroll
        for (int j = 0; j < 4; ++j) v[rr][j] = xr[64 * j]; }
}
__device__ __forceinline__ void p1_rows(Frame& F, f32x4 (&v)[2][4], int ch, int rl, const LAS float* modA, const LAS float* modB, const LAS float* wf, LAS float* gi, bf16* XN) {
            float s[2] = {0.f, 0.f};
#pragma unroll
            for (int rr = 0; rr < 2; ++rr)
#pragma unroll
                for (int j = 0; j < 4; ++j) s[rr] += (v[rr][j].x * v[rr][j].x + v[rr][j].y * v[rr][j].y) + (v[rr][j].z * v[rr][j].z + v[rr][j].w * v[rr][j].w);
#pragma unroll
            for (int rr = 0; rr < 2; ++rr) { const int m = ch * 128 + rl + 8 * rr;
                const float rstd = 1.f / sqrtf(wave_sum(s[rr]) * (1.f / D) + EPS);
                float fl[8];
#pragma unroll
                for (int q = 0; q < 8; ++q) fl[q] = 0.f;
                unsigned long long* o8 = (unsigned long long*)(XN + (size_t)m * D) + F.lane;
#pragma unroll
                for (int j = 0; j < 4; ++j) { const int k0 = 4 * F.lane + 256 * j; float h[4];
#pragma unroll
                    for (int e = 0; e < 4; ++e) { h[e] = v[rr][j][e] * rstd * modA[k0 + e] + modB[k0 + e];
#pragma unroll
                        for (int q = 0; q < 8; ++q) fl[q] += h[e] * wf[q * D + k0 + e]; }
                    o8[64 * j] = (unsigned long long)pk2(h[0], h[1]) | ((unsigned long long)pk2(h[2], h[3]) << 32); }
                float r0, r1; wave_sum8_t(fl, F.lane, r0, r1);
                if (F.lane < 4) { const int q0 = 4 * (F.lane & 1) + 2 * (F.lane >> 1);
#pragma unroll
                    for (int e = 0; e < 2; ++e) { const float z = (e ? r1 : r0) + F.b_fg[q0 + e];
                        const float sp = fmaxf(-z, 0.f) + log1pf(expf(-fabsf(z)));
                        gi[(rl + 8 * rr) * 8 + q0 + e] = sp * LOG2E; } } }
}
__device__ __forceinline__ void p1_prenorm(Frame& F) {
    const float* ADAP = (const float*)(F.ws + WS_ADAP); float* ADA = (float*)(F.ws + WS_ADA);
    for (int i = blockIdx.x * (NWAVES * 64) + F.tid; i < BATCH * NADA; i += F.G * NWAVES * 64) { float s = F.b_ada[i % NADA];
#pragma unroll
        for (int p = 0; p < 16; ++p) s += ADAP[(size_t)p * BATCH * NADA + i];
        ADA[i] = s; }
    LAS float* modA = (LAS float*)(F.lds);
    LAS float* modB = modA + 1024;
    LAS float* wf = modB + 1024;
    LAS float* gi = wf + 8192;
    bf16* XN = (bf16*)(F.ws + WS_XN); float* LC = (float*)(F.ws + WS_LC); float* CT = (float*)(F.ws + WS_CT);
    for (int ch = blockIdx.x; ch < M / 128; ch += F.G) {
        const int b = ch / (T / 128);
        __syncthreads();
        for (int k = F.tid; k < D; k += NWAVES * 64) { float sh = F.b_ada[k], sc = F.b_ada[D + k];
#pragma unroll
            for (int p = 0; p < 16; ++p) { sh += ADAP[((size_t)p * BATCH + b) * NADA + k]; sc += ADAP[((size_t)p * BATCH + b) * NADA + D + k]; }
            modA[k] = F.g_mix[k] * (1.f + sc); modB[k] = sh; }
        for (int i = F.tid; i < D * 8; i += NWAVES * 64) wf[(i & 7) * D + (i >> 3)] = F.w_in[(size_t)(i >> 3) * LDW_IN + NPROJ + (i & 7)];
        __syncthreads();
        { f32x4 va[2][4], vb[2][4];
            p1_load(F, va, ch, F.wave);
#pragma unroll 1
            for (int it = 0; it < 4; ++it) {
                p1_load(F, vb, ch, F.wave + 16 * (2 * it + 1));
                p1_rows(F, va, ch, F.wave + 16 * (2 * it), modA, modB, wf, gi, XN);
                if (it < 3) p1_load(F, va, ch, F.wave + 16 * (2 * it + 2));
                p1_rows(F, vb, ch, F.wave + 16 * (2 * it + 1), modA, modB, wf, gi, XN);
            } }
        __syncthreads();
        { const int h = F.wave; float* lc = LC + ((size_t)b * NH + h) * T + (ch % (T / 128)) * 128;
            const float a0 = gi[(2 * F.lane) * 8 + h], a1 = gi[(2 * F.lane + 1) * 8 + h]; float sc = a0 + a1;
#pragma unroll
            for (int o = 1; o < 64; o <<= 1) { const float t = __shfl_up(sc, o); if (F.lane >= o) sc += t; }
            lc[2 * F.lane] = sc - a1; lc[2 * F.lane + 1] = sc;
            if (F.lane == 63) CT[((size_t)b * NH + h) * (T / 128) + (ch % (T / 128))] = sc; }
    }
    __syncthreads();
}

__device__ __forceinline__ void p3_sgu_naive(Frame& F) {
    const bf16* U = (const bf16*)(F.ws + WS_U); const bf16* VS = U + (size_t)M * DH; const bf16* WSM = (const bf16*)(F.ws + WS_WSM);
    bf16* Y = (bf16*)(F.ws + WS_Y); float* SSQY = (float*)(F.ws + WS_SSQY);
    LAS bf16* vn = (LAS bf16*)(F.lds);
    const int h = F.wave, c = F.tid;
    for (int ch = blockIdx.x; ch < M / 128; ch += F.G) {
        __syncthreads();
        const float gs = F.g_sgu[h * 64 + F.lane];
        for (int s = 0; s < 128; ++s) { const size_t m = (size_t)ch * 128 + s; const float val = bf2f(VS[m * DH + c]); const float q = wave_sum(val * val);
            vn[s * DH + c] = (bf16)f2bf(val * (1.f / sqrtf(q * (1.f / 64.f) + EPS)) * gs); }
        __syncthreads();
        for (int t = 0; t < 128; ++t) { float z = F.b_sp[h * 128 + t]; const bf16* wrow = WSM + ((size_t)h * 128 + t) * 128;
            for (int s = 0; s <= t; ++s) z += bf2f(wrow[s]) * bf2f(vn[s * DH + c]);
            const size_t m = (size_t)ch * 128 + t; const float y = bf2f(U[m * DH + c]) * z;
            Y[m * D + DH + c] = (bf16)f2bf(y); const float q = wave_sum(y * y); if (F.lane == 0) SSQY[m * 16 + h] = q; }
    }
    __syncthreads();
}
__device__ __forceinline__ void p3_sgu(Frame& F) {
    typedef short s16x4_t __attribute__((ext_vector_type(4))); typedef float f32x16_t __attribute__((ext_vector_type(16)));
    const bf16* U = (const bf16*)(F.ws + WS_U); const bf16* VS = U + (size_t)M * DH; const bf16* WSM = (const bf16*)(F.ws + WS_WSM);
    bf16* Y = (bf16*)(F.ws + WS_Y); float* SSQY = (float*)(F.ws + WS_SSQY);
    constexpr int RS = 144;
    const int h = F.wave, lane = F.lane, c8 = lane & 7, kg = lane >> 5, t32 = lane & 31;
    LAS unsigned char* vreg = F.lds + h * (128 * RS);
    LAS float* bsl = (LAS float*)(F.lds + 8 * 128 * RS) + h * 128;
    float gsc[8];
#pragma unroll
    for (int e = 0; e < 8; ++e) gsc[e] = F.g_sgu[h * 64 + c8 * 8 + e];
    const int trb = (8 * (lane >> 5) + ((lane & 15) >> 2)) * RS + (16 * ((lane >> 4) & 1) + 4 * (lane & 3)) * 2;
    for (int ch = blockIdx.x; ch < M / 128; ch += F.G) {
        const size_t row0 = (size_t)ch * 128;
        asm volatile("s_waitcnt lgkmcnt(0)" ::: "memory");
        uint4 pre[16];
#pragma unroll
        for (int it = 0; it < 16; ++it) pre[it] = *(const uint4*)(VS + (row0 + it * 8 + (lane >> 3)) * DH + h * 64 + c8 * 8);
#pragma unroll
        for (int it = 0; it < 16; ++it) { const int r = it * 8 + (lane >> 3); const uint4 w = pre[it]; const unsigned ww[4] = {w.x, w.y, w.z, w.w};
            float v[8]; float q = 0.f;
#pragma unroll
            for (int e = 0; e < 4; ++e) { v[2 * e] = __uint_as_float(ww[e] << 16); v[2 * e + 1] = __uint_as_float(ww[e] & 0xffff0000u); q += v[2 * e] * v[2 * e] + v[2 * e + 1] * v[2 * e + 1]; }
            q = DPP_ADD(q, 0xB1); q = DPP_ADD(q, 0x4E); q = DPP_ADD(q, 0x141);
            const float rstd = 1.f / sqrtf(q * (1.f / 64.f) + EPS);
            v4u o; o.x = pk2(v[0] * rstd * gsc[0], v[1] * rstd * gsc[1]); o.y = pk2(v[2] * rstd * gsc[2], v[3] * rstd * gsc[3]); o.z = pk2(v[4] * rstd * gsc[4], v[5] * rstd * gsc[5]); o.w = pk2(v[6] * rstd * gsc[6], v[7] * rstd * gsc[7]);
            *(LAS v4u*)(vreg + r * RS + c8 * 16) = o; }
        bsl[lane] = F.b_sp[h * 128 + lane]; bsl[lane + 64] = F.b_sp[h * 128 + 64 + lane];
        asm volatile("s_waitcnt lgkmcnt(0)" ::: "memory");
        f32x16_t acc[4][2];
#pragma unroll
        for (int tb = 0; tb < 4; ++tb) { acc[tb][0] = f32x16_t{}; acc[tb][1] = f32x16_t{}; }
#pragma unroll
        for (int tb = 0; tb < 4; ++tb)
#pragma unroll
            for (int ks = 0; ks < 2 * tb + 2; ++ks) {
                const bf16x8 a = *(const bf16x8*)(WSM + ((size_t)(h * 128 + 32 * tb + t32)) * 128 + 16 * ks + 8 * kg);
#pragma unroll
                for (int db = 0; db < 2; ++db) {
                    const s16x4_t lo = __builtin_bit_cast(s16x4_t, __builtin_amdgcn_ds_read_tr16_b64_v4i16((LAS s16x4_t*)(vreg + trb + (16 * ks) * RS + db * 64)));
                    const s16x4_t hi = __builtin_bit_cast(s16x4_t, __builtin_amdgcn_ds_read_tr16_b64_v4i16((LAS s16x4_t*)(vreg + trb + (16 * ks + 4) * RS + db * 64)));
                    const bf16x8 bfr = {lo[0], lo[1], lo[2], lo[3], hi[0], hi[1], hi[2], hi[3]};
                    acc[tb][db] = __builtin_amdgcn_mfma_f32_32x32x16_bf16(a, bfr, acc[tb][db], 0, 0, 0); } }
        asm volatile("s_waitcnt lgkmcnt(0)" ::: "memory");
#pragma unroll
        for (int tb = 0; tb < 4; ++tb)
#pragma unroll
            for (int db = 0; db < 2; ++db)
#pragma unroll
                for (int r = 0; r < 16; ++r) { const int t = 32 * tb + (r & 3) + 8 * (r >> 2) + 4 * kg;
                    *(LAS unsigned short*)(vreg + t * RS + (32 * db + t32) * 2) = (unsigned short)f2bf(acc[tb][db][r] + bsl[t]); }
        asm volatile("s_waitcnt lgkmcnt(0)" ::: "memory");
#pragma unroll
        for (int it = 0; it < 16; ++it) pre[it] = *(const uint4*)(U + (row0 + it * 8 + (lane >> 3)) * DH + h * 64 + c8 * 8);
#pragma unroll
        for (int it = 0; it < 16; ++it) { const int r = it * 8 + (lane >> 3); const v4u zz = *(const LAS v4u*)(vreg + r * RS + c8 * 16); const uint4 uu = pre[it];
            const unsigned zw[4] = {zz.x, zz.y, zz.z, zz.w}, uw[4] = {uu.x, uu.y, uu.z, uu.w}; unsigned ow[4]; float q = 0.f;
#pragma unroll
            for (int e = 0; e < 4; ++e) { const float y0 = __uint_as_float(zw[e] << 16) * __uint_as_float(uw[e] << 16), y1 = __uint_as_float(zw[e] & 0xffff0000u) * __uint_as_float(uw[e] & 0xffff0000u);
                q += y0 * y0 + y1 * y1; ow[e] = pk2(y0, y1); }
            q = DPP_ADD(q, 0xB1); q = DPP_ADD(q, 0x4E); q = DPP_ADD(q, 0x141);
            v4u o; o.x = ow[0]; o.y = ow[1]; o.z = ow[2]; o.w = ow[3];
            *(v4u*)(Y + (row0 + r) * D + DH + h * 64 + c8 * 8) = o;
            if (c8 == 0) SSQY[(row0 + r) * 16 + h] = q; }
    }
    asm volatile("s_waitcnt lgkmcnt(0)" ::: "memory");
    __syncthreads();
}
__device__ __forceinline__ void p3_attn_naive(Frame& F) {
    const bf16* Q = (const bf16*)(F.ws + WS_U) + (size_t)2 * M * DH; const bf16* K = Q + (size_t)M * DH; const bf16* V = K + (size_t)M * DH;
    const float* LC = (const float*)(F.ws + WS_LC); const float* CT = (const float*)(F.ws + WS_CT);
    bf16* Y = (bf16*)(F.ws + WS_Y); float* SSQY = (float*)(F.ws + WS_SSQY);
    LAS float* Gabs = (LAS float*)(F.lds);
    LAS float* pre = Gabs + T;
    for (int item = blockIdx.x; item < BATCH * NH * 8; item += F.G) {
        const int bh = item >> 3, r = item & 7, b = bh / NH, h = bh % NH;
        __syncthreads();
        if (F.tid < 64) { float a = 0.f; for (int c2 = 0; c2 < F.tid; ++c2) a += CT[bh * 64 + c2]; pre[F.tid] = a; }
        __syncthreads();
        for (int t = F.tid; t < T; t += NWAVES * 64) Gabs[t] = pre[t >> 7] + LC[(size_t)bh * T + t];
        __syncthreads();
        for (int n = F.wave; n < T / 8; n += NWAVES) {
            const int i = 8 * n + r; const size_t rowi = (size_t)b * T + i;
            float qf[64];
            { const uint4* q4 = (const uint4*)(Q + rowi * DH + h * HD);
#pragma unroll
              for (int c4 = 0; c4 < 8; ++c4) { const uint4 w = q4[c4]; const unsigned ww[4] = {w.x, w.y, w.z, w.w};
#pragma unroll
                  for (int e = 0; e < 4; ++e) { qf[c4 * 8 + 2 * e] = __uint_as_float(ww[e] << 16); qf[c4 * 8 + 2 * e + 1] = __uint_as_float(ww[e] & 0xffff0000u); } } }
            const float Gi = Gabs[i];
            float mx = -1e30f, l = 0.f; float o[64];
#pragma unroll
            for (int d = 0; d < 64; ++d) o[d] = 0.f;
            for (int j = F.lane; j <= i; j += 64) {
                const size_t rowj = (size_t)b * T + j; const uint4* k4 = (const uint4*)(K + rowj * DH + h * HD); const uint4* v4 = (const uint4*)(V + rowj * DH + h * HD);
                float s = 0.f;
#pragma unroll
                for (int c4 = 0; c4 < 8; ++c4) { const uint4 w = k4[c4]; const unsigned ww[4] = {w.x, w.y, w.z, w.w};
#pragma unroll
                    for (int e = 0; e < 4; ++e) { s += qf[c4 * 8 + 2 * e] * __uint_as_float(ww[e] << 16); s += qf[c4 * 8 + 2 * e + 1] * __uint_as_float(ww[e] & 0xffff0000u); } }
                s += Gabs[j] - Gi;
                if (s > mx) { const float f = __builtin_amdgcn_exp2f(mx - s); l *= f;
#pragma unroll
                    for (int d = 0; d < 64; ++d) o[d] *= f;
                    mx = s; }
                const float p = __builtin_amdgcn_exp2f(s - mx); l += p;
#pragma unroll
                for (int c4 = 0; c4 < 8; ++c4) { const uint4 w = v4[c4]; const unsigned ww[4] = {w.x, w.y, w.z, w.w};
#pragma unroll
                    for (int e = 0; e < 4; ++e) { o[c4 * 8 + 2 * e] += p * __uint_as_float(ww[e] << 16); o[c4 * 8 + 2 * e + 1] += p * __uint_as_float(ww[e] & 0xffff0000u); } }
            }
            const float Mx = wave_max(mx); const float f = __builtin_amdgcn_exp2f(mx - Mx); l *= f; const float L = wave_sum(l);
            float y = 0.f;
#pragma unroll
            for (int d = 0; d < 64; ++d) { const float od = wave_sum(o[d] * f); y = (F.lane == d) ? od : y; }
            y = y / L;
            Y[rowi * D + h * HD + F.lane] = (bf16)f2bf(y);
            const float q = wave_sum(y * y); if (F.lane == 0) SSQY[rowi * 16 + 8 + h] = q;
        }
    }
    __syncthreads();
}
__device__ __forceinline__ void p2_kx(Frame& F) {
    const float* LC = (const float*)(F.ws + WS_LC); const float* CT = (const float*)(F.ws + WS_CT);
    unsigned long long* KX8 = (unsigned long long*)(F.ws + WS_KX8); float* GF = (float*)(F.ws + WS_GF);
    const int gw = F.vcu * NWAVES + F.wave, NGW = F.G * NWAVES;
    for (int pr = gw; pr < BATCH * NH * (T / 128); pr += NGW) { const int bh = pr >> 6, ch = pr & 63;
        const float base = wave_sum(F.lane < ch ? CT[bh * 64 + F.lane] : 0.f);
#pragma unroll
        for (int e = 0; e < 2; ++e) { const size_t t = (size_t)bh * T + ch * 128 + e * 64 + F.lane; const float G = base + LC[t];
            const unsigned gh = f2bf(G); const float r1 = G - __uint_as_float(gh << 16); const unsigned gm = f2bf(r1); const float r2 = r1 - __uint_as_float(gm << 16); const unsigned gl = f2bf(r2);
            KX8[t] = (unsigned long long)(gh | (gm << 16)) | ((unsigned long long)(gl | (0x3F80u << 16)) << 32); GF[t] = G; } }
}
__device__ __forceinline__ void p6_load(Frame& F, f32x4 (&xv)[2][4], uint2 (&mv)[2][4], const bf16* MIX, int mrow) {
#pragma unroll
    for (int rr = 0; rr < 2; ++rr) { const size_t m = (size_t)mrow + rr; const f32x4* xr = (const f32x4*)(F.x + m * D) + F.lane; const uint2* mr = (const uint2*)(MIX + m * D) + F.lane;
#pragma unroll
        for (int j = 0; j < 4; ++j) { xv[rr][j] = xr[64 * j]; mv[rr][j] = mr[64 * j]; } }
}
__device__ __forceinline__ void p6_rows(Frame& F, f32x4 (&xv)[2][4], uint2 (&mv)[2][4], int m0, int r0, int RPW, const f32x4 (&cg1)[4], const f32x4 (&cA)[4], const f32x4 (&cB)[4],
                                        const LAS float* wrg, const LAS float* wre, LAS unsigned* lcnt, LAS unsigned* rinfo, bf16* H2, bf16* X1, float* TW) {
#pragma unroll
        for (int rr = 0; rr < 2; ++rr) { const int m = m0 + r0 + rr; float s = 0.f;
#pragma unroll
            for (int j = 0; j < 4; ++j) { f32x4 mx; mx[0] = __uint_as_float(mv[rr][j].x << 16); mx[1] = __uint_as_float(mv[rr][j].x & 0xffff0000u); mx[2] = __uint_as_float(mv[rr][j].y << 16); mx[3] = __uint_as_float(mv[rr][j].y & 0xffff0000u);
                xv[rr][j] = xv[rr][j] + cg1[j] * mx;
                ((unsigned long long*)(X1 + (size_t)m * D) + F.lane)[64 * j] = (unsigned long long)pk2(xv[rr][j].x, xv[rr][j].y) | ((unsigned long long)pk2(xv[rr][j].z, xv[rr][j].w) << 32);
                s += (xv[rr][j].x * xv[rr][j].x + xv[rr][j].y * xv[rr][j].y) + (xv[rr][j].z * xv[rr][j].z + xv[rr][j].w * xv[rr][j].w); }
            const float rstd = 1.f / sqrtf(wave_sum(s) * (1.f / D) + EPS);
            float lg[4] = {0.f, 0.f, 0.f, 0.f};
#if MOE_FP8
            int* o4 = (int*)((unsigned char*)H2 + (size_t)m * D) + F.lane;
#else
            unsigned long long* o8 = (unsigned long long*)(H2 + (size_t)m * D) + F.lane;
#endif
#pragma unroll
            for (int j = 0; j < 4; ++j) { const int k0 = 4 * F.lane + 256 * j; xv[rr][j] = xv[rr][j] * rstd * cA[j] + cB[j];
#if MOE_FP8
                { int p = 0; p = __builtin_amdgcn_cvt_pk_fp8_f32(__builtin_amdgcn_fmed3f(xv[rr][j].x, -448.f, 448.f), __builtin_amdgcn_fmed3f(xv[rr][j].y, -448.f, 448.f), p, false);
                  p = __builtin_amdgcn_cvt_pk_fp8_f32(__builtin_amdgcn_fmed3f(xv[rr][j].z, -448.f, 448.f), __builtin_amdgcn_fmed3f(xv[rr][j].w, -448.f, 448.f), p, true); o4[64 * j] = p; }
#else
                o8[64 * j] = (unsigned long long)pk2(xv[rr][j].x, xv[rr][j].y) | ((unsigned long long)pk2(xv[rr][j].z, xv[rr][j].w) << 32);
#endif
#pragma unroll
                for (int q = 0; q < 4; ++q) { const f32x4 w = *(const LAS f32x4*)(wrg + q * D + k0); lg[q] += (xv[rr][j].x * w.x + xv[rr][j].y * w.y) + (xv[rr][j].z * w.z + xv[rr][j].w * w.w); } }
            wave_sum4_all(lg, F.lane);
#pragma unroll
            for (int q = 0; q < 4; ++q) lg[q] += F.b_rg[q];
            int gs = 0; float best = lg[0];
#pragma unroll
            for (int q = 1; q < 4; ++q) if (lg[q] > best) { best = lg[q]; gs = q; }
            float den = 0.f;
#pragma unroll
            for (int q = 0; q < 4; ++q) den += expf(lg[q] - best);
            const float psel = 1.f / den;
            gs = __builtin_amdgcn_readfirstlane(gs);
            float le[4] = {0.f, 0.f, 0.f, 0.f}; const LAS float* wg = wre + gs * 4 * D;
#pragma unroll
            for (int j = 0; j < 4; ++j) { const int k0 = 4 * F.lane + 256 * j;
#pragma unroll
                for (int q = 0; q < 4; ++q) { const f32x4 w = *(const LAS f32x4*)(wg + q * D + k0); le[q] += (xv[rr][j].x * w.x + xv[rr][j].y * w.y) + (xv[rr][j].z * w.z + xv[rr][j].w * w.w); } }
            wave_sum4_all(le, F.lane);
#pragma unroll
            for (int q = 0; q < 4; ++q) le[q] += F.b_re[gs * 4 + q];
            int i0 = 0; float v0 = le[0];
#pragma unroll
            for (int q = 1; q < 4; ++q) if (le[q] > v0) { v0 = le[q]; i0 = q; }
            int i1 = -1; float v1 = -INFINITY;
#pragma unroll
            for (int q = 0; q < 4; ++q) if (q != i0 && le[q] > v1) { v1 = le[q]; i1 = q; }
            const float e1 = expf(v1 - v0); const float w0 = psel / (1.f + e1), w1 = psel * e1 / (1.f + e1);
            const int ea = i0 < i1 ? i0 : i1, eb = i0 < i1 ? i1 : i0; const float wa = i0 < i1 ? w0 : w1, wb = i0 < i1 ? w1 : w0;
            const int pair = ea == 0 ? eb - 1 : (ea == 1 ? eb + 1 : 5); const int cls = gs * 6 + pair;
            if (F.lane == 0) { TW[(size_t)m * 2] = wa; TW[(size_t)m * 2 + 1] = wb;
                const unsigned lr = __hip_atomic_fetch_add(lcnt + cls, 1u, __ATOMIC_RELAXED, __HIP_MEMORY_SCOPE_WORKGROUP);
                rinfo[F.wave * RPW + r0 + rr] = (unsigned)cls | (lr << 8); }
        }
}
__device__ __forceinline__ void p6_route(Frame& F) {
    const float* ADA = (const float*)(F.ws + WS_ADA); const bf16* MIX = (const bf16*)(F.ws + WS_MIX);
    bf16* H2 = (bf16*)(F.ws + WS_H2); bf16* X1 = (bf16*)(F.ws + WS_X1); int* INV = (int*)(F.ws + WS_INV); float* TW = (float*)(F.ws + WS_TW);
    LAS float* wrg = (LAS float*)(F.lds);
    LAS float* wre = wrg + 4 * D;
    LAS unsigned* lcnt = (LAS unsigned*)(wre + 16 * D);
    LAS unsigned* rinfo = lcnt + 32;
    __syncthreads();
    if (F.tid < 32) lcnt[F.tid] = 0u;
    for (int i = F.tid; i < 4 * D; i += NWAVES * 64) wrg[(i & 3) * D + (i >> 2)] = F.w_rg[i];
    for (int i = F.tid; i < 16 * D; i += NWAVES * 64) { const int g = i / (4 * D), r = i % (4 * D); wre[g * 4 * D + (r & 3) * D + (r >> 2)] = F.w_re[i]; }
    __syncthreads();
    const int gw = F.vcu * NWAVES + F.wave, NGW = F.G * NWAVES; const int RPW = M / NGW;
    const int m0 = gw * RPW; const int b = m0 / T;
    f32x4 cg1[4], cA[4], cB[4];
#pragma unroll
    for (int j = 0; j < 4; ++j) { const int k0 = 4 * F.lane + 256 * j; cg1[j] = *(const f32x4*)(ADA + (size_t)b * NADA + 2 * D + k0);
        const f32x4 g = *(const f32x4*)(F.g_ffn + k0), sc = *(const f32x4*)(ADA + (size_t)b * NADA + 4 * D + k0); cA[j] = g * (1.f + sc); cB[j] = *(const f32x4*)(ADA + (size_t)b * NADA + 3 * D + k0); }
    { f32x4 xa[2][4], xb[2][4]; uint2 ma[2][4], mb[2][4];
        p6_load(F, xa, ma, MIX, m0);
#pragma unroll 1
        for (int r0 = 0; r0 < RPW; r0 += 4) {
            p6_load(F, xb, mb, MIX, m0 + r0 + 2);
            p6_rows(F, xa, ma, m0, r0, RPW, cg1, cA, cB, wrg, wre, lcnt, rinfo, H2, X1, TW);
            if (r0 + 4 < RPW) p6_load(F, xa, ma, MIX, m0 + r0 + 4);
            p6_rows(F, xb, mb, m0, r0 + 2, RPW, cg1, cA, cB, wrg, wre, lcnt, rinfo, H2, X1, TW);
        } }
    __syncthreads();
    if (F.tid < NCLS) { const unsigned n = lcnt[F.tid]; lcnt[F.tid] = n ? __hip_atomic_fetch_add((unsigned*)(F.ctl + CW_CNT + F.tid * CNT_STRIDE), n, __ATOMIC_RELAXED, __HIP_MEMORY_SCOPE_AGENT) : 0u; }
    __syncthreads();
    for (int i = F.tid; i < NWAVES * RPW; i += NWAVES * 64) { const unsigned ri = rinfo[i]; const int cls = (int)(ri & 255u);
        INV[(size_t)cls * M + lcnt[cls] + (ri >> 8)] = (F.vcu * NWAVES + i / RPW) * RPW + i % RPW; }
    __syncthreads();
}
__device__ __forceinline__ void moe_tables(Frame& F) {
    LAS unsigned* lcnt = (LAS unsigned*)(F.lds + LCNT_OFF);
    __syncthreads();
    if (F.tid < NCLS) lcnt[F.tid] = __hip_atomic_load(F.ctl + CW_CNT + F.tid * CNT_STRIDE, RLX_AGENT);
    __syncthreads();
    if (F.tid == 0) { LAS unsigned char* tcls = F.lds + TCLS_OFF; LAS unsigned char* tfirst = F.lds + TFIRST_OFF; int nt = 0;
        for (int c = 0; c < NCLS; ++c) { const int n = ((int)lcnt[c] + 255) >> 8; tfirst[c] = (unsigned char)nt; for (int k = 0; k < n && nt < MAXTILES; ++k) tcls[nt++] = (unsigned char)c; }
        F.MISC[16] = (unsigned)nt; }
    __syncthreads();
}
template <class Order> __device__ __forceinline__ void moe_fill_toku(Frame& F, const Order& S) {
    const int* INV = (const int*)(F.ws + WS_INV); LAS unsigned* toku = (LAS unsigned*)(F.lds + TOKU_OFF);
    for (int i = 0; i < 5; ++i) { pg8::Unit u; if (!S.next(i, u)) break;
        if (F.tid < 256) { const int rank = u.rank0 + F.tid; const int tok = rank < u.cnt ? INV[(size_t)u.cls * M + rank] : 0; toku[i * 256 + F.tid] = (unsigned)tok * (unsigned)(D * MOE_ESZ); } }
    __syncthreads();
}
__device__ __forceinline__ void p10_final(Frame& F) {
    const float* ADA = (const float*)(F.ws + WS_ADA); const bf16* X1 = (const bf16*)(F.ws + WS_X1); const bf16* MOE = (const bf16*)(F.ws + WS_MOE);
    const int gw = F.vcu * NWAVES + F.wave, NGW = F.G * NWAVES; const int RPW = M / NGW; const int m0 = gw * RPW; const int b = m0 / T;
    f32x4 cg2[4], cgf[4];
#pragma unroll
    for (int j = 0; j < 4; ++j) { const int k0 = 4 * F.lane + 256 * j; cg2[j] = *(const f32x4*)(ADA + (size_t)b * NADA + 5 * D + k0); cgf[j] = *(const f32x4*)(F.g_fin + k0); }
    for (int r0 = 0; r0 < RPW; r0 += 4) {
        uint2 mv[4][4], ev[4][4];
#pragma unroll
        for (int rr = 0; rr < 4; ++rr) { const size_t m = (size_t)m0 + r0 + rr; const uint2* mr = (const uint2*)(X1 + m * D) + F.lane; const uint2* er = (const uint2*)(MOE + m * D) + F.lane;
#pragma unroll
            for (int j = 0; j < 4; ++j) { mv[rr][j] = mr[64 * j]; ev[rr][j] = er[64 * j]; } }
#pragma unroll
        for (int rr = 0; rr < 4; ++rr) { const size_t m = (size_t)m0 + r0 + rr; float s = 0.f; f32x4 xv[4];
#pragma unroll
            for (int j = 0; j < 4; ++j) { f32x4 mx, ex; mx[0] = __uint_as_float(mv[rr][j].x << 16); mx[1] = __uint_as_float(mv[rr][j].x & 0xffff0000u); mx[2] = __uint_as_float(mv[rr][j].y << 16); mx[3] = __uint_as_float(mv[rr][j].y & 0xffff0000u);
                ex[0] = __uint_as_float(ev[rr][j].x << 16); ex[1] = __uint_as_float(ev[rr][j].x & 0xffff0000u); ex[2] = __uint_as_float(ev[rr][j].y << 16); ex[3] = __uint_as_float(ev[rr][j].y & 0xffff0000u);
                xv[j] = mx + cg2[j] * ex; s += (xv[j].x * xv[j].x + xv[j].y * xv[j].y) + (xv[j].z * xv[j].z + xv[j].w * xv[j].w); }
            const float rstd = 1.f / sqrtf(wave_sum(s) * (1.f / D) + EPS);
            f32x4* orow = (f32x4*)(F.out + m * D) + F.lane;
#pragma unroll
            for (int j = 0; j < 4; ++j) orow[64 * j] = xv[j] * rstd * cgf[j]; }
    }
}

#define REFRESH() do { F.lane = lane_id_fresh(); F.tid = F.wave * 64 + F.lane; } while (0)
struct Args { const float* in[22]; float* out; unsigned char* ws; int ph_lo, ph_hi; };
__global__ void __launch_bounds__(NWAVES * 64, 2) mk_fwd(Args args) {
    extern __shared__ __attribute__((aligned(16))) unsigned char lds[];
    Frame F;
    F.lds = (LAS unsigned char*)lds;
    F.MISC = (volatile LAS unsigned*)(F.lds + MISC_OFF);
    F.tid = threadIdx.x; F.lane = F.tid & 63; F.wave = __builtin_amdgcn_readfirstlane(F.tid >> 6);
    F.G = gridDim.x; { const int bx = blockIdx.x; F.vcu = (F.G % 8 == 0) ? (bx % 8) * (F.G / 8) + bx / 8 : bx; }
    F.ws = args.ws; F.ctl = (gu32*)(args.ws + WS_CTL); F.out = args.out;
    F.x = args.in[0]; F.c = args.in[1]; F.w_ada = args.in[2]; F.b_ada = args.in[3]; F.g_mix = args.in[4]; F.w_in = args.in[5]; F.g_sgu = args.in[6]; F.w_sp = args.in[7]; F.b_sp = args.in[8]; F.b_fg = args.in[9];
    F.g_osgu = args.in[10]; F.g_ofox = args.in[11]; F.w_out = args.in[12]; F.g_ffn = args.in[13]; F.w_rg = args.in[14]; F.b_rg = args.in[15]; F.w_re = args.in[16]; F.b_re = args.in[17];
    F.w_gate = args.in[18]; F.w_up = args.in[19]; F.w_down = args.in[20]; F.g_fin = args.in[21];
    for (int u = F.tid; u < (LDS_BYTES - LDSCTL_OFF) / 4; u += NWAVES * 64) ((LAS unsigned*)(F.lds + LDSCTL_OFF))[u] = 0u;
    __syncthreads();
    XcdBarrier bar; bar.bar = (unsigned*)(F.ctl + CW_BAR); bar.x = 0; bar.st = nullptr;
    if (N_LAUNCHES == 1) bar = xcd_barrier_post((unsigned*)(F.ctl + CW_BAR), F.MISC + 8);
#define GRID_BAR() do { if (N_LAUNCHES == 1) xcd_barrier(bar); } while (0)
#if PROBE_MASK
#define PROBE_BEGIN(k) do { if (((PROBE_MASK) >> (k)) & 1) { if (blockIdx.x == 0 && F.tid == 0) F.MISC[22] = (unsigned)rt(); } } while (0)
#define PROBE_END(k) do { if (((PROBE_MASK) >> (k)) & 1) { if (blockIdx.x == 0 && F.tid == 0) F.MISC[20] = F.MISC[20] + ((unsigned)rt() - F.MISC[22]); } } while (0)
#else
#define PROBE_BEGIN(k) do {} while (0)
#define PROBE_END(k) do {} while (0)
#endif
    const int lo = args.ph_lo, hi = args.ph_hi;
#define IN(k) (lo <= (k) && (k) < hi)
#define BOTH(k) (IN(k) && IN((k) + 1))
    bf16* const XN = (bf16*)(F.ws + WS_XN); bf16* const U = (bf16*)(F.ws + WS_U); bf16* const Y = (bf16*)(F.ws + WS_Y);
    float* const ADA = (float*)(F.ws + WS_ADA);

    if (IN(0)) { PROBE_BEGIN(0); p0_prologue(F); if (BOTH(0)) GRID_BAR(); PROBE_END(0); }
    if (IN(1)) { REFRESH(); PROBE_BEGIN(1); p1_prenorm(F); if (BOTH(1)) GRID_BAR(); PROBE_END(1); }
    if (IN(2)) { REFRESH(); PROBE_BEGIN(2);
        p2_kx(F);
        pg8::Gemm g{XN, (const bf16*)(F.ws + WS_WIN), D, D, D, 127, 127}; pg8::StaticOrder S; S.init(M, NPROJ, D, D, F.G, (int)blockIdx.x);
        pg8::EpiProj E{U, (unsigned*)(F.ctl + CW_QKB)};
        pg8::gemm_phase<pg8::EpiProj, pg8::StaticOrder, true, true>(F.lds + RING_OFF, g, S, E, F.tid);
        if (BOTH(2)) GRID_BAR(); PROBE_END(2);
    }
    if (IN(3)) { REFRESH(); PROBE_BEGIN(3);
        PROBE_BEGIN(4);
#if NAIVE_SGU
        p3_sgu_naive(F);
#else
        p3_sgu(F);
#endif
        PROBE_END(4);
#if NAIVE_ATTN
        p3_attn_naive(F);
#else
        static_assert(attn_body::LDS_BYTES <= RING_BYTES, "attention LDS map");
        { const attn_body::bf16* Qp = (const attn_body::bf16*)(F.ws + WS_U) + (size_t)2 * M * DH;
          const attn_body::AttnTensors AT{Qp, Qp + (size_t)M * DH, Qp + (size_t)2 * M * DH, (attn_body::bf16*)(F.ws + WS_Y), (const unsigned long long*)(F.ws + WS_KX8), (const float*)(F.ws + WS_GF), (const float*)(F.ctl + CW_QKB), (float*)(F.ws + WS_SSQY)};
          const attn_body::StaticOrder S((int)F.G, (int)blockIdx.x);
          attn_body::AttnUnit u;
          for (int i = 0; S.next(i, u); ++i) {
              if (i == ((F.vcu >> 1) & 3)) p3_convert(F);
              attn_body::attn_unit<8>(u.bh / attn_body::NHEAD, u.bh % attn_body::NHEAD, u.qb, AT.Q, AT.K, AT.V, AT.O, AT.KX8, AT.GF, AT.QKB, AT.SSQ, (char*)lds + RING_OFF, F.tid); } }
#endif
        if (IN(3) && IN(5)) GRID_BAR(); PROBE_END(3); }
    if (IN(5)) { REFRESH(); PROBE_BEGIN(5);
        pg8::Gemm g{Y, (const bf16*)(F.ws + WS_WOUT), D, D, D, 127, 127}; pg8::StaticOrder S; S.init(M, D, D, D, F.G, (int)blockIdx.x);
        pg8::EpiMix E{(bf16*)(F.ws + WS_MIX), (const float*)(F.ws + WS_SSQY)};
        pg8::gemm_phase<pg8::EpiMix, pg8::StaticOrder, true, true>(F.lds + RING_OFF, g, S, E, F.tid);
        if (BOTH(5)) GRID_BAR(); PROBE_END(5);
    }
    if (IN(6)) { REFRESH(); PROBE_BEGIN(6); p6_route(F); if (IN(6) && IN(8)) GRID_BAR(); PROBE_END(6); }
    if (IN(8)) { REFRESH(); PROBE_BEGIN(8);
        moe_tables(F);
        pg8::Gemm g{(const bf16*)(F.ws + WS_H2), (const bf16*)(F.ws + WS_WGU), D * MOE_ESZ / 2, D * MOE_ESZ / 2, D * MOE_ESZ / 2, 127, 121};
        pg8::MoeUpOrder S{F.G, (int)blockIdx.x, (int)F.MISC[16], F.lds + TCLS_OFF, F.lds + TFIRST_OFF, (const LAS unsigned*)(F.lds + LCNT_OFF), (const LAS unsigned*)(F.lds + TOKU_OFF)};
        moe_fill_toku(F, S);
        pg8::EpiUp E{(bf16*)(F.ws + WS_ACT), (const float*)(F.ws + WS_TW), (const int*)(F.ws + WS_INV)};
        pg8::gemm_phase<pg8::EpiUp, pg8::MoeUpOrder, true, true, MOE_FP8 != 0>(F.lds + RING_OFF, g, S, E, F.tid);
        if (BOTH(8)) GRID_BAR(); PROBE_END(8);
    }
    if (IN(9)) { REFRESH(); PROBE_BEGIN(9);
        if (!IN(8)) moe_tables(F);
        pg8::Gemm g{(const bf16*)(F.ws + WS_ACT), (const bf16*)(F.ws + WS_WD), D * MOE_ESZ / 2, DEXP * MOE_ESZ / 2, D * MOE_ESZ / 2, 125, 121};
        pg8::MoeDownOrder S{F.G, (int)blockIdx.x, (int)F.MISC[16], F.lds + TCLS_OFF, F.lds + TFIRST_OFF, (const LAS unsigned*)(F.lds + LCNT_OFF)};
        pg8::EpiDown E{(bf16*)(F.ws + WS_MOE), (const int*)(F.ws + WS_INV)};
        pg8::gemm_phase<pg8::EpiDown, pg8::MoeDownOrder, true, true, MOE_FP8 != 0>(F.lds + RING_OFF, g, S, E, F.tid);
        if (BOTH(9)) GRID_BAR(); PROBE_END(9);
    }
    if (IN(10)) { REFRESH(); PROBE_BEGIN(10); p10_final(F); PROBE_END(10); }
#if PROBE_MASK
    if (blockIdx.x == 0 && F.tid == 0) { const unsigned long long t0 = rt(); const unsigned long long w = (unsigned long long)F.MISC[20] * (PROBE_MULT); while (rt() - t0 < w) __builtin_amdgcn_s_sleep(32); }
#endif
#undef IN
#undef BOTH
}

extern "C" void kernel_launch(void* const* d_in, const int* in_sizes, int n_in, void* d_out, int out_size, void* d_ws, size_t ws_size, hipStream_t stream) {
    static int grid = 0;
    if (grid == 0) {
        if (n_in != 22 || in_sizes[0] != M * D || out_size != M * D || ws_size < WS_END) { fprintf(stderr, "kernel_launch: unexpected shapes (n_in %d, in0 %d, out %d, ws %zu); nothing launched\n", n_in, n_in > 0 ? in_sizes[0] : -1, out_size, ws_size); grid = -1; return; }
        int dev = 0, cus = 0, per_cu = 0;
        if (hipGetDevice(&dev) != hipSuccess || hipDeviceGetAttribute(&cus, hipDeviceAttributeMultiprocessorCount, dev) != hipSuccess) { fprintf(stderr, "kernel_launch: device query failed\n"); grid = -1; return; }
        if (hipFuncSetAttribute((const void*)mk_fwd, hipFuncAttributeMaxDynamicSharedMemorySize, LDS_BYTES) != hipSuccess) { fprintf(stderr, "kernel_launch: hipFuncSetAttribute failed\n"); grid = -1; return; }
        if (hipOccupancyMaxActiveBlocksPerMultiprocessor(&per_cu, (const void*)mk_fwd, NWAVES * 64, LDS_BYTES) != hipSuccess || per_cu < 1) { fprintf(stderr, "kernel_launch: occupancy query reports %d workgroups per CU\n", per_cu); (void)hipGetLastError(); grid = -1; return; }
        grid = cus;
        if (grid != 256) { fprintf(stderr, "kernel_launch: built for a 256-CU device (static unit orders), found %d CUs; nothing launched\n", cus); grid = -1; return; }
    }
    if (grid < 0) return;
    if (hipMemsetAsync((char*)d_ws + WS_CTL, 0, CTL_ZERO_BYTES, stream) != hipSuccess) { fprintf(stderr, "kernel_launch: hipMemsetAsync failed\n"); return; }
    Args a{};
    for (int i = 0; i < 22; ++i) a.in[i] = (const float*)d_in[i];
    a.out = (float*)d_out; a.ws = (unsigned char*)d_ws;
    if (N_LAUNCHES == 1) {
        a.ph_lo = 0; a.ph_hi = N_PHASES;
        void* kargs[] = {&a};
        const hipError_t le = hipLaunchCooperativeKernel((const void*)mk_fwd, dim3(grid), dim3(NWAVES * 64), kargs, LDS_BYTES, stream);
        if (le != hipSuccess) fprintf(stderr, "kernel_launch: cooperative launch failed: %s (grid %d)\n", hipGetErrorName(le), grid);
    } else {
        for (int li = 0; li < N_PHASES; ++li) { a.ph_lo = li; a.ph_hi = li + 1;
            hipLaunchKernelGGL(mk_fwd, dim3(grid), dim3(NWAVES * 64), LDS_BYTES, stream, a);
            const hipError_t le = hipPeekAtLastError();
            if (le != hipSuccess) { fprintf(stderr, "kernel_launch: launch %d failed: %s\n", li, hipGetErrorName(le)); break; } }
    }
}
```

```cpp
#include <hip/hip_runtime.h>
#include <hip/hip_bf16.h>
#include <cstdio>
#include <cstdint>
#include <cmath>

#ifndef MK_N_LAUNCHES
#define MK_N_LAUNCHES 1
#endif
#ifndef PROBE_MASK
#define PROBE_MASK 0
#endif
#ifndef PROBE_MULT
#define PROBE_MULT 4
#endif
#ifndef MOE_FP8
#define MOE_FP8 1
#endif
#define MOE_ESZ (MOE_FP8 ? 1 : 2)
#ifndef NAIVE_SGU
#define NAIVE_SGU 0
#endif
#ifndef NAIVE_ATTN
#define NAIVE_ATTN 0
#endif

constexpr int BATCH = 4, T = 8192, D = 1024, NH = 8, HD = 64, DH = 512;
constexpr int M = BATCH * T;
constexpr int NPROJ = 2560;
constexpr int LDW_IN = 2568;
constexpr int NADA = 6 * D;
constexpr int NEXP = 16, DEXP = 512, NCLS = 24;
constexpr int MAXTILES = 152;
constexpr float EPS = 1e-6f;
constexpr float C2 = 0.125f * 1.4426950408889634f;
constexpr float LOG2E = 1.4426950408889634f;

namespace pg8 {
#define PG8_LAS __attribute__((address_space(3)))
typedef unsigned short bf16_t;
typedef short bf16x8 __attribute__((ext_vector_type(8)));
typedef float f32x4 __attribute__((ext_vector_type(4)));
typedef unsigned u32x4 __attribute__((ext_vector_type(4)));
constexpr int BM = 256, BK = 64, HALF = 128, HTB = HALF * BK * 2  , STAGE_BYTES = 8 * HTB, NXCD = 8, WGM = 8;

__host__ __device__ __forceinline__ int lds_byte(int r, int c) { const int st = (r >> 4) * 2 + (c >> 5), rr = r & 15, cc = c & 31, ob = rr * 64 + cc * 2; return st * 1024 + (ob ^ (((ob >> 9) & 1) << 5)); }
__host__ __device__ __forceinline__ void stage_rc(int b, int& R, int& C) { const int st = b / 1024, sb = b % 1024, swz = sb ^ (((sb >> 9) & 1) << 5); R = (st >> 1) * 16 + swz / 64; C = (st & 1) * 32 + (swz % 64) / 2; }
__host__ __device__ __forceinline__ int perm32(int rho) { const int n = rho >> 4, i = rho & 15; return 8 * (i >> 2) + 4 * n + (i & 3); }

struct Unit { int pm, pn, aux; long aoff, boff, dboff; int cls, rank0, cnt, ord; };
struct Gemm { const bf16_t* A; const bf16_t* Bt; int lda, ldb, K; int scA, scB; };

struct StaticOrder {
    static constexpr bool GATHER = false;
    int nM, nN, nwg, G, c; long ta, tb;
    __host__ __device__ void init(int M, int N, int lda, int ldb, int G_, int c_) { nM = M / BM; nN = N / BM; nwg = nM * nN; G = G_; c = c_; ta = (long)BM * lda * 2; tb = (long)BM * ldb * 2; }
    __host__ __device__ bool next(int i, Unit& u) const {
        const long L = (long)i * G + c; if (L >= nwg) return false;
        int wgid = (int)L; { const int q = nwg / NXCD, r = nwg % NXCD, xcd = wgid % NXCD, off = wgid / NXCD; wgid = (xcd < r ? xcd * (q + 1) : r * (q + 1) + (xcd - r) * q) + off; }
        const int nig = WGM * nN, gid = wgid / nig, fm = gid * WGM, gsz = (nM - fm) < WGM ? (nM - fm) : WGM;
        u.pm = fm + ((wgid % nig) % gsz); u.pn = (wgid % nig) / gsz; u.aux = 0; u.aoff = u.pm * ta; u.boff = u.pn * tb; u.dboff = 0; u.cls = 0; u.rank0 = 0; u.cnt = 0; u.ord = i; return true;
    }
    __device__ __forceinline__ void a_ready(const Unit&) const {}
    __device__ __forceinline__ void done(const Unit&) const {}
};


__device__ __forceinline__ unsigned cvt_pk_bf16(float lo, float hi) { unsigned r; asm volatile("v_cvt_pk_bf16_f32 %0, %1, %2" : "=v"(r) : "v"(lo), "v"(hi)); return r; }
__device__ __forceinline__ float gelu_tanh(float v) {
    const float u = v * (1.5957691216057308f + 0.0713548162726f * v * v);
    return v * __builtin_amdgcn_rcpf(1.0f + __builtin_amdgcn_exp2f(-1.4426950408889634f * u));
}
__device__ __forceinline__ float silu_f(float v) { return v * __builtin_amdgcn_rcpf(1.0f + __builtin_amdgcn_exp2f(-1.4426950408889634f * v)); }

struct NoState {};
#define PG8_DPP_MAX(v, ctrl) fmaxf((v), __builtin_bit_cast(float, __builtin_amdgcn_update_dpp(0, __builtin_bit_cast(int, (v)), (ctrl), 0xf, 0xf, false)))
__device__ __forceinline__ float wave_max_nonneg(float v) {
    v = PG8_DPP_MAX(v, 0xB1); v = PG8_DPP_MAX(v, 0x4E); v = PG8_DPP_MAX(v, 0x141); v = PG8_DPP_MAX(v, 0x140);
    const int iv = __builtin_bit_cast(int, v);
    return fmaxf(fmaxf(__builtin_bit_cast(float, __builtin_amdgcn_readlane(iv, 0)), __builtin_bit_cast(float, __builtin_amdgcn_readlane(iv, 16))), fmaxf(__builtin_bit_cast(float, __builtin_amdgcn_readlane(iv, 32)), __builtin_bit_cast(float, __builtin_amdgcn_readlane(iv, 48))));
}
struct EpiProj {
    static constexpr bool PERM = true, AFTER_DRAIN = false, MID = false; typedef NoState State;
    bf16_t* O; unsigned* qkb;
    __device__ __forceinline__ void operator()(const f32x4 (&acc)[2][2][4][2], const State&, const Unit& u, int wr, int wc, int fr, int fq) const {
        const int row0 = u.pm * BM + wr * 64 + fr; const int seg = u.pn >> 1; float nmx[2] = {0.f, 0.f};
        bf16_t* base = O + (size_t)seg * ((size_t)M * 512);
        const int col0 = (u.pn & 1) * 256 + wc * 32 + 8 * fq;
#pragma unroll
        for (int ai = 0; ai < 2; ++ai)
#pragma unroll
            for (int m = 0; m < 4; ++m) { bf16_t* rowp = base + (size_t)(row0 + ai * HALF + m * 16) * 512 + col0;
#pragma unroll
                for (int bj = 0; bj < 2; ++bj) { f32x4 v0 = acc[ai][bj][m][0], v1 = acc[ai][bj][m][1];
                    if (seg < 2) {
#pragma unroll
                        for (int j = 0; j < 4; ++j) { v0[j] = gelu_tanh(v0[j]); v1[j] = gelu_tanh(v1[j]); }
                    } else if (seg == 2) { v0 = v0 * C2; v1 = v1 * C2; }
                    if (seg == 2 || seg == 3) { float s8 = ((v0[0] * v0[0] + v0[1] * v0[1]) + (v0[2] * v0[2] + v0[3] * v0[3])) + ((v1[0] * v1[0] + v1[1] * v1[1]) + (v1[2] * v1[2] + v1[3] * v1[3]));
                        { const auto r16 = __builtin_amdgcn_permlane16_swap(__float_as_uint(s8), __float_as_uint(s8), false, false); s8 = __uint_as_float(r16[0]) + __uint_as_float(r16[1]);
                          const auto r32 = __builtin_amdgcn_permlane32_swap(__float_as_uint(s8), __float_as_uint(s8), false, false); s8 = __uint_as_float(r32[0]) + __uint_as_float(r32[1]); }
                        nmx[bj] = fmaxf(nmx[bj], s8); }
                    u32x4 w; w.x = cvt_pk_bf16(v0[0], v0[1]); w.y = cvt_pk_bf16(v0[2], v0[3]); w.z = cvt_pk_bf16(v1[0], v1[1]); w.w = cvt_pk_bf16(v1[2], v1[3]);
                    *(u32x4*)(rowp + bj * HALF) = w; } }
        if (seg == 2 || seg == 3) {
#pragma unroll
            for (int bj = 0; bj < 2; ++bj) { const float wm = wave_max_nonneg(nmx[bj]); const int bh = (u.pm >> 5) * 8 + 4 * (u.pn & 1) + 2 * bj + (wc >> 1);
                if (fr == 0 && fq == 0) __hip_atomic_fetch_max(qkb + (seg == 3 ? bh * 16 + (u.pm & 15) : 512 + bh * 32 + (u.pm & 31)), __float_as_uint(wm), __ATOMIC_RELAXED, __HIP_MEMORY_SCOPE_AGENT); } }
    }
};
struct EpiMix {
    static constexpr bool PERM = true, AFTER_DRAIN = false, MID = true; struct State { float rs[2][4]; };
    bf16_t* O; const PG8_LAS float* rsr;
    __device__ __forceinline__ void mid(f32x4 (&acc)[2][2][4][2], State& st, const Unit& u, int wr, int fr) const {
#pragma unroll
        for (int ai = 0; ai < 2; ++ai)
#pragma unroll
            for (int m = 0; m < 4; ++m) { const int rl = ai * HALF + wr * 64 + m * 16 + fr; const float rs = rsr[(u.ord * BM + rl) * 2], ratio = rsr[(u.ord * BM + rl) * 2 + 1]; st.rs[ai][m] = rs;
#pragma unroll
                for (int bj = 0; bj < 2; ++bj)
#pragma unroll
                    for (int n = 0; n < 2; ++n) acc[ai][bj][m][n] = acc[ai][bj][m][n] * ratio; }
    }
    __device__ __forceinline__ void operator()(const f32x4 (&acc)[2][2][4][2], const State& st, const Unit& u, int wr, int wc, int fr, int fq) const {
        const int row0 = u.pm * BM + wr * 64 + fr; const int col0 = u.pn * BM + wc * 32 + 8 * fq;
#pragma unroll
        for (int ai = 0; ai < 2; ++ai)
#pragma unroll
            for (int m = 0; m < 4; ++m) { bf16_t* rowp = O + (size_t)(row0 + ai * HALF + m * 16) * D + col0; const float rs = st.rs[ai][m];
#pragma unroll
                for (int bj = 0; bj < 2; ++bj) { const f32x4 v0 = acc[ai][bj][m][0] * rs, v1 = acc[ai][bj][m][1] * rs;
                    u32x4 w; w.x = cvt_pk_bf16(v0[0], v0[1]); w.y = cvt_pk_bf16(v0[2], v0[3]); w.z = cvt_pk_bf16(v1[0], v1[1]); w.w = cvt_pk_bf16(v1[2], v1[3]);
                    *(u32x4*)(rowp + bj * HALF) = w; } }
    }
};
struct EpiUp {
    static constexpr bool PERM = true, AFTER_DRAIN = false, MID = false; typedef NoState State;
    bf16_t* ACT; const PG8_LAS unsigned* tokw;
    __device__ __forceinline__ void operator()(const f32x4 (&acc)[2][2][4][2], const State&, const Unit& u, int wr, int wc, int fr, int fq) const {
        const int s = u.aux >> 2, t = u.aux & 3; const int col0 = s * 512 + t * 128 + wc * 32 + 8 * fq;
#pragma unroll
        for (int ai = 0; ai < 2; ++ai)
#pragma unroll
            for (int m = 0; m < 4; ++m) { const int rl = ai * HALF + wr * 64 + m * 16 + fr; const int r = u.pm * BM + rl; const unsigned wp = tokw[u.ord * BM + rl];
                const float w = __uint_as_float(s ? (wp & 0xffff0000u) : (wp << 16));
                float a[8];
#pragma unroll
                for (int n = 0; n < 2; ++n)
#pragma unroll
                    for (int j = 0; j < 4; ++j) a[n * 4 + j] = silu_f(acc[ai][0][m][n][j]) * acc[ai][1][m][n][j] * w;
#if MOE_FP8
                int p0 = 0, p1 = 0;
#pragma unroll
                for (int j = 0; j < 8; ++j) a[j] = __builtin_amdgcn_fmed3f(a[j] * 4.f, -448.f, 448.f);
                p0 = __builtin_amdgcn_cvt_pk_fp8_f32(a[0], a[1], p0, false); p0 = __builtin_amdgcn_cvt_pk_fp8_f32(a[2], a[3], p0, true);
                p1 = __builtin_amdgcn_cvt_pk_fp8_f32(a[4], a[5], p1, false); p1 = __builtin_amdgcn_cvt_pk_fp8_f32(a[6], a[7], p1, true);
                typedef int v2i_t __attribute__((ext_vector_type(2)));
                *(v2i_t*)((unsigned char*)ACT + (size_t)r * D + col0) = (v2i_t){p0, p1}; }
#else
                u32x4 o; o.x = cvt_pk_bf16(a[0], a[1]); o.y = cvt_pk_bf16(a[2], a[3]); o.z = cvt_pk_bf16(a[4], a[5]); o.w = cvt_pk_bf16(a[6], a[7]);
                *(u32x4*)(ACT + (size_t)r * D + col0) = o; }
#endif
    }
};
struct EpiDown {
    static constexpr bool PERM = true, AFTER_DRAIN = false, MID = false; typedef NoState State;
    bf16_t* O; const PG8_LAS int* tokd;
    __device__ __forceinline__ void operator()(const f32x4 (&acc)[2][2][4][2], const State&, const Unit& u, int wr, int wc, int fr, int fq) const {
        const int col0 = u.aux * BM + wc * 32 + 8 * fq;
#pragma unroll
        for (int ai = 0; ai < 2; ++ai)
#pragma unroll
            for (int m = 0; m < 4; ++m) { const int rl = ai * HALF + wr * 64 + m * 16 + fr;
                const int tok = tokd[u.ord * BM + rl];
                if (tok >= 0) { bf16_t* rowp = O + (size_t)tok * D + col0;
#pragma unroll
                    for (int bj = 0; bj < 2; ++bj) { const f32x4 v0 = acc[ai][bj][m][0], v1 = acc[ai][bj][m][1];
                        u32x4 w; w.x = cvt_pk_bf16(v0[0], v0[1]); w.y = cvt_pk_bf16(v0[2], v0[3]); w.z = cvt_pk_bf16(v1[0], v1[1]); w.w = cvt_pk_bf16(v1[2], v1[3]);
                        *(u32x4*)(rowp + bj * HALF) = w; } } }
    }
};
__device__ __forceinline__ int cls_expert(int cls, int s) { const int g = cls / 6, p = cls % 6; const int a = p < 3 ? 0 : (p < 5 ? 1 : 2); const int b = p < 3 ? p + 1 : (p < 5 ? p - 1 : 3); return g * 4 + (s ? b : a); }
struct MoeUpOrder {
    static constexpr bool GATHER = true;
    int G, c, NT; const PG8_LAS unsigned char* tcls; const PG8_LAS unsigned char* tfirst; const PG8_LAS unsigned* lcnt; const PG8_LAS unsigned* toku;
    __device__ __forceinline__ bool next(int i, Unit& u) const {
        const int x = c & 7, j = (c >> 3) + (G >> 3) * i; const int pm = 8 * (j >> 3) + x; if (pm >= NT) return false;
        const int st = j & 7; const int cls = (int)tcls[pm]; u.pm = pm; u.aux = st; u.pn = cls_expert(cls, st >> 2) * 4 + (st & 3);
        u.aoff = 0; u.boff = (long)u.pn * (BM * D * MOE_ESZ); u.dboff = 0; u.cls = cls; u.rank0 = (pm - (int)tfirst[cls]) * BM; u.cnt = (int)lcnt[cls]; u.ord = i; return true;
    }
    __device__ __forceinline__ unsigned row_off(const Unit& u, int r) const { return toku[u.ord * BM + r]; }
    __device__ __forceinline__ void a_ready(const Unit&) const {}
    __device__ __forceinline__ void done(const Unit&) const {}
};
struct MoeDownOrder {
    static constexpr bool GATHER = false;
    int G, c, NT; const PG8_LAS unsigned char* tcls; const PG8_LAS unsigned char* tfirst; const PG8_LAS unsigned* lcnt;
    __device__ __forceinline__ bool next(int i, Unit& u) const {
        const int x = c & 7, j = (c >> 3) + (G >> 3) * i; const int pm = 8 * (j >> 2) + x; if (pm >= NT) return false;
        const int nt = j & 3; const int cls = (int)tcls[pm]; const int ea = cls_expert(cls, 0), eb = cls_expert(cls, 1); u.pm = pm; u.aux = nt; u.pn = 0;
        u.aoff = (long)pm * (BM * D * MOE_ESZ); u.boff = ((long)ea * D + nt * BM) * (DEXP * MOE_ESZ); u.dboff = (long)(eb - ea) * D * (DEXP * MOE_ESZ) - DEXP * MOE_ESZ;
        u.cls = cls; u.rank0 = (pm - (int)tfirst[cls]) * BM; u.cnt = (int)lcnt[cls]; u.ord = i; return true;
    }
    __device__ __forceinline__ void a_ready(const Unit&) const {}
    __device__ __forceinline__ void done(const Unit&) const {}
};

template <class Epi, class Sched, bool ALIGN_EPI = false, bool SP2 = false, bool FP8 = false>
__device__ __forceinline__ void gemm_phase(PG8_LAS unsigned char* lds, const Gemm g, const Sched& S, const Epi& E, const int tid) {
    typedef int v4i_t __attribute__((ext_vector_type(4))); typedef int v8i_t __attribute__((ext_vector_type(8)));
    const int wid = __builtin_amdgcn_readfirstlane(tid >> 6), lane = tid & 63, wr = wid >> 2, wc = wid & 3, fr = lane & 15, fq = lane >> 4;
    const int K = g.K, nt = K / BK;
    static_assert(SP2, "only the two-super-phase loop is kept");
    const int nth = nt / 2;
    unsigned voffB[2]; int RR[2], CC2[2];
    unsigned cvo[2][2];
#pragma unroll
    for (int i = 0; i < 2; ++i) { int R, C; stage_rc(tid * 16 + i * 8192, R, C); const int Rb = Epi::PERM ? ((R & ~31) + perm32(R & 31)) : R;
        RR[i] = R; CC2[i] = C * 2; voffB[i] = (unsigned)(Rb * g.ldb + C) * 2u; }
#define PG8_AOFFS(dst, u) do { _Pragma("unroll") for (int _h = 0; _h < 2; ++_h) _Pragma("unroll") for (int _i = 0; _i < 2; ++_i) { \
        if constexpr (Sched::GATHER) dst[_h][_i] = S.row_off(u, _h * HALF + RR[_i]) + (unsigned)CC2[_i]; else dst[_h][_i] = (unsigned)((_h * HALF + RR[_i]) * g.lda) * 2u + (unsigned)CC2[_i]; } } while (0)
    const size_t kstep = (size_t)(BK * 2);
    const size_t hstep = (size_t)HALF * g.ldb * 2;
    const unsigned ldsw = (unsigned)wid * 1024u;
    int aofs[2], bofs[2];
    if constexpr (FP8) { aofs[0] = lds_byte(wr * 64 + fr, 16 * (fq & 1)) + (fq >> 1) * 1024; aofs[1] = lds_byte(wr * 64 + fr, 16 * (fq & 1) + 8) + (fq >> 1) * 1024;
                         bofs[0] = lds_byte(wc * 32 + fr, 16 * (fq & 1)) + (fq >> 1) * 1024; bofs[1] = lds_byte(wc * 32 + fr, 16 * (fq & 1) + 8) + (fq >> 1) * 1024; }
    else { aofs[0] = lds_byte(wr * 64 + fr, fq * 8); aofs[1] = aofs[0] + 1024; bofs[0] = lds_byte(wc * 32 + fr, fq * 8); bofs[1] = bofs[0] + 1024; }
#define PG8_SA(b, h) (((b) * 2 + (h)) * HTB)
#define PG8_SB(b, h) ((4 + (b) * 2 + (h)) * HTB)
#define PG8_STAGE(bufoff, gbase, voff) do { _Pragma("unroll") for (int _i = 0; _i < 2; ++_i) \
        __builtin_amdgcn_global_load_lds((const unsigned*)((const char*)(gbase) + (voff)[_i]), (PG8_LAS unsigned*)(lds + (bufoff) + ldsw + _i * 8192), 16, 0, 0); } while (0)
#define PG8_LD16(off) (*(const PG8_LAS v4i_t*)(lds + (off)))
#define PG8_LDA(dst, b, h) do { if constexpr (FP8) { _Pragma("unroll") for (int m = 0; m < 4; ++m) dst##8[m] = *(const PG8_LAS v8i_t*)(lds + PG8_SA(b, h) + aofs[0] + m * 2048); }     \
        else { _Pragma("unroll") for (int m = 0; m < 4; ++m) _Pragma("unroll") for (int k = 0; k < 2; ++k) dst[m][k] = *(const PG8_LAS bf16x8*)(lds + PG8_SA(b, h) + aofs[k] + m * 2048); } } while (0)
#define PG8_LDB(dst, b, h) do { if constexpr (FP8) { _Pragma("unroll") for (int n = 0; n < 2; ++n) dst##8[n] = *(const PG8_LAS v8i_t*)(lds + PG8_SB(b, h) + bofs[0] + n * 2048); } \
        else { _Pragma("unroll") for (int n = 0; n < 2; ++n) _Pragma("unroll") for (int k = 0; k < 2; ++k) dst[n][k] = *(const PG8_LAS bf16x8*)(lds + PG8_SB(b, h) + bofs[k] + n * 2048); } } while (0)
#define PG8_PINACC(ai, bj) do { if constexpr (FP8) { _Pragma("unroll") for (int m = 0; m < 4; ++m) _Pragma("unroll") for (int n = 0; n < 2; ++n) asm volatile("" : "+v"(acc[ai][bj][m][n])); } } while (0)
#define PG8_MMA(ai, bj, At, Bt) do { PG8_PINACC(ai, bj); __builtin_amdgcn_s_setprio(1); _Pragma("unroll") for (int m = 0; m < 4; ++m) _Pragma("unroll") for (int n = 0; n < 2; ++n) { \
        if constexpr (FP8) acc[ai][bj][m][n] = __builtin_amdgcn_mfma_scale_f32_16x16x128_f8f6f4(Bt##8[n], At##8[m], acc[ai][bj][m][n], 0, 0, 0, g.scB, 0, g.scA); \
        else { _Pragma("unroll") for (int k = 0; k < 2; ++k) acc[ai][bj][m][n] = __builtin_amdgcn_mfma_f32_16x16x32_bf16(Bt[n][k], At[m][k], acc[ai][bj][m][n], 0, 0, 0); } } \
        PG8_PINACC(ai, bj); __builtin_amdgcn_s_setprio(0); } while (0)
#define PG8_WAIT_V(n) asm volatile("s_waitcnt vmcnt(" #n ")" ::: "memory")
#define PG8_WAIT_L(n) asm volatile("s_waitcnt lgkmcnt(" #n ")" ::: "memory")
#define PG8_BAR __builtin_amdgcn_s_barrier()
#define PG8_SCHED __builtin_amdgcn_sched_barrier(0)
    Unit cur, nxt; int ui = 0;
    if (!S.next(0, cur)) return;
    f32x4 acc[2][2][4][2]; typename Epi::State est;
#pragma unroll
    for (int a = 0; a < 2; ++a)
#pragma unroll
        for (int b = 0; b < 2; ++b)
#pragma unroll
            for (int m = 0; m < 4; ++m)
#pragma unroll
                for (int n = 0; n < 2; ++n) acc[a][b][m][n] = (f32x4){0.f, 0.f, 0.f, 0.f};
    bf16x8 At[4][2], B0[2][2], B1[2][2]; v8i_t At8[4], B08[2], B18[2];
    const char* cA = (const char*)g.A + cur.aoff; const char* cB = (const char*)g.Bt + cur.boff;
    S.a_ready(cur);
    PG8_AOFFS(cvo, cur);
    if constexpr (SP2) {
        PG8_STAGE(PG8_SB(0, 0), cB, voffB); PG8_STAGE(PG8_SB(0, 1), cB + hstep, voffB); PG8_STAGE(PG8_SA(0, 0), cA, cvo[0]); PG8_STAGE(PG8_SA(0, 1), cA, cvo[1]);
        if (wr == 1) PG8_BAR;
        PG8_WAIT_V(2); PG8_BAR;
        PG8_STAGE(PG8_SB(1, 0), cB + kstep, voffB); PG8_STAGE(PG8_SA(1, 0), cA + kstep, cvo[0]); PG8_STAGE(PG8_SB(1, 1), cB + hstep + kstep, voffB);
        PG8_WAIT_V(6); PG8_BAR;
    }
    for (;;) {
        const bool has_next = S.next(ui + 1, nxt);
        const char* nA = has_next ? (const char*)g.A + nxt.aoff : cA; const char* nB = has_next ? (const char*)g.Bt + nxt.boff : cB;
#pragma unroll 1
        for (int t = 0; t < nt; t += 2) {
            if constexpr (Epi::MID) { if (t == nt / 2) E.mid(acc, est, cur, wr, fr); }
            const bool last = (t == nt - 2);
            const char* a1 = cA + (size_t)(t + 1) * kstep;
            const char* a2 = last ? nA : cA + (size_t)(t + 2) * kstep; const char* b2 = last ? nB : cB + (size_t)(t + 2) * kstep + ((t + 2 >= nth) ? cur.dboff : 0);
            unsigned xo[2][2];
            if constexpr (Sched::GATHER) { if (last && has_next) { PG8_AOFFS(xo, nxt); } else { xo[0][0] = cvo[0][0]; xo[0][1] = cvo[0][1]; xo[1][0] = cvo[1][0]; xo[1][1] = cvo[1][1]; } }
            else { xo[0][0] = cvo[0][0]; xo[0][1] = cvo[0][1]; xo[1][0] = cvo[1][0]; xo[1][1] = cvo[1][1]; }
            const char* a3 = a2 + kstep; const char* b3 = b2 + kstep;
            if (last && has_next) S.a_ready(nxt);
            if constexpr (SP2) {
            PG8_LDB(B0, 0, 0); PG8_LDB(B1, 0, 1); PG8_SCHED; PG8_LDA(At, 0, 0); PG8_STAGE(PG8_SA(1, 1), a1, cvo[1]);
            PG8_WAIT_V(8); PG8_WAIT_L(0); PG8_BAR; PG8_MMA(0, 0, At, B0); PG8_MMA(0, 1, At, B1); PG8_BAR; PG8_SCHED;
            PG8_LDA(At, 0, 1); PG8_STAGE(PG8_SB(0, 0), b2, voffB); PG8_STAGE(PG8_SB(0, 1), b2 + hstep, voffB); PG8_STAGE(PG8_SA(0, 0), a2, xo[0]);
            PG8_WAIT_V(8); PG8_WAIT_L(0); PG8_BAR; PG8_MMA(1, 0, At, B0); PG8_MMA(1, 1, At, B1); PG8_BAR; PG8_SCHED;
            PG8_LDB(B0, 1, 0); PG8_LDB(B1, 1, 1); PG8_SCHED; PG8_LDA(At, 1, 0); PG8_STAGE(PG8_SA(0, 1), a2, xo[1]);
            PG8_WAIT_V(8); PG8_WAIT_L(0); PG8_BAR; PG8_MMA(0, 0, At, B0); PG8_MMA(0, 1, At, B1); PG8_BAR; PG8_SCHED;
            PG8_LDA(At, 1, 1); PG8_STAGE(PG8_SB(1, 0), b3, voffB); PG8_STAGE(PG8_SB(1, 1), b3 + hstep, voffB); PG8_STAGE(PG8_SA(1, 0), a3, xo[0]);
            if constexpr (Sched::GATHER) { if (last) { cvo[0][0] = xo[0][0]; cvo[0][1] = xo[0][1]; cvo[1][0] = xo[1][0]; cvo[1][1] = xo[1][1]; } }
            PG8_WAIT_V(8); PG8_WAIT_L(0); PG8_BAR; PG8_MMA(1, 0, At, B0); PG8_MMA(1, 1, At, B1); PG8_BAR; PG8_SCHED;
            }
        }
        if constexpr (ALIGN_EPI) { if (wr == 0) PG8_BAR; }
        if constexpr (!Epi::AFTER_DRAIN) { E(acc, est, cur, wr, wc, fr, fq); S.done(cur); }
        if (!has_next) break;
#pragma unroll
        for (int a = 0; a < 2; ++a)
#pragma unroll
            for (int b = 0; b < 2; ++b)
#pragma unroll
                for (int m = 0; m < 4; ++m)
#pragma unroll
                    for (int n = 0; n < 2; ++n) acc[a][b][m][n] = (f32x4){0.f, 0.f, 0.f, 0.f};
        cur = nxt; cA = nA; cB = nB; ++ui;
        if constexpr (ALIGN_EPI) { if (wr == 1) PG8_BAR; }
    }
    PG8_WAIT_V(0);
    if constexpr (!ALIGN_EPI) { if (wr == 0) PG8_BAR; }
    PG8_BAR;
#undef PG8_SA
#undef PG8_SB
#undef PG8_STAGE
#undef PG8_AOFFS
#undef PG8_LDA
#undef PG8_LD16
#undef PG8_LDB
#undef PG8_MMA
#undef PG8_PINACC
#undef PG8_WAIT_V
#undef PG8_WAIT_L
#undef PG8_BAR
#undef PG8_SCHED
}
}
namespace attn_body {
using bf16=__hip_bfloat16;
using bf16x8=__attribute__((ext_vector_type(8)))short;
using s16x4=__attribute__((ext_vector_type(4)))short;
using f32x16=__attribute__((ext_vector_type(16)))float;
using u32x4=__attribute__((ext_vector_type(4)))unsigned;
constexpr int BATCH=4,NHEAD=8,SEQ=8192,D=64,DM=NHEAD*D,OPITCH=1024;
constexpr int NW=8,QBLK=32,QB=QBLK*NW,KVBLK=64,NQB=SEQ/QB;
constexpr int ATTN_PITCH=DM, ATTN_UNIT_ROWS=QB;
__device__ __forceinline__ int crow(int r,int hi){return (r&3)+8*(r>>2)+4*hi;}
#define SBAR() __builtin_amdgcn_sched_barrier(0)
__device__ __forceinline__ void cmask(f32x16&p0,f32x16&p1,int jb,int qrel,int hi){
  const float NEG=-INFINITY; int kb=64*jb+4*hi-qrel; asm volatile("":"+v"(kb));
  #pragma unroll
  for(int r=0;r<16;++r){const int c=(r&3)+8*(r>>2); if(kb>-c)p0[r]=NEG; if(kb>-c-32)p1[r]=NEG;}
}

constexpr int NSLOT=3, SLOTB=8192;
constexpr float TCUT=45.f;
constexpr int LDS_K=0, LDS_V=NSLOT*SLOTB, LDS_WS=2*NSLOT*SLOTB, LDS_OST=LDS_WS+NW*64*4, LDS_TAB=LDS_OST+NW*4096, LDS_BYTES=LDS_TAB+SEQ*8;
__device__ __forceinline__ void glds16(const void*gsrc,unsigned lds_dst){unsigned keep;
  asm volatile("s_mov_b32 %0, m0\n\ts_mov_b32 m0, %2\n\ts_nop 0\n\tglobal_load_lds_dwordx4 %1, off\n\ts_mov_b32 m0, %0":"=&s"(keep):"v"(gsrc),"s"(lds_dst):"memory");}
__device__ __forceinline__ void glds16s(const void*sbase,unsigned voff,unsigned lds_dst){unsigned keep;
  asm volatile("s_nop 4\n\ts_mov_b32 %0, m0\n\ts_mov_b32 m0, %3\n\ts_nop 0\n\tglobal_load_lds_dwordx4 %1, %2\n\ts_mov_b32 m0, %0":"=&s"(keep):"v"(voff),"s"(sbase),"s"(lds_dst):"memory");}
__device__ __forceinline__ float max3f(float a,float b,float c){float r;asm("v_max3_f32 %0, %1, %2, %3":"=v"(r):"v"(a),"v"(b),"v"(c));return r;}
__device__ __forceinline__ float max2f(float a,float b){float r;asm("v_max_f32_e32 %0, %1, %2":"=v"(r):"v"(a),"v"(b));return r;}
__device__ __forceinline__ float fadd_s(float a,float b){float r;asm("v_add_f32_e32 %0, %1, %2":"=v"(r):"v"(a),"v"(b));return r;}
__device__ __forceinline__ float fsub_s(float a,float b){float r;asm("v_sub_f32_e32 %0, %1, %2":"=v"(r):"v"(a),"v"(b));return r;}
typedef float f32x2_t __attribute__((ext_vector_type(2))); typedef __bf16 bf16x2_t __attribute__((ext_vector_type(2)));
__device__ __forceinline__ unsigned cvtpk_s(float lo,float hi){f32x2_t v={lo,hi};bf16x2_t b=__builtin_convertvector(v,bf16x2_t);return __builtin_bit_cast(unsigned,b);}
#define WAIT_BAR(N) asm volatile("s_waitcnt vmcnt(" #N ") lgkmcnt(0)\n\ts_barrier":::"memory")

__device__ __forceinline__ void qkt(f32x16&p0,f32x16&p1,const char*Kslot,const bf16x8*qr,const bf16x8 qx,const bf16x8 kx0,const bf16x8 kx1,int r32,int hi){
  const f32x16 negm=f32x16{};
  const char*kb=Kslot+hi*1024+r32*16;
  #pragma unroll
  for(int d0=0;d0<4;++d0){
    const bf16x8 b0=*reinterpret_cast<const bf16x8*>(kb+d0*2048);
    const bf16x8 b1=*reinterpret_cast<const bf16x8*>(kb+d0*2048+512);
    if(d0==0){p0=__builtin_amdgcn_mfma_f32_32x32x16_bf16(b0,qr[0],negm,0,0,0);p1=__builtin_amdgcn_mfma_f32_32x32x16_bf16(b1,qr[0],negm,0,0,0);}
    else{p0=__builtin_amdgcn_mfma_f32_32x32x16_bf16(b0,qr[d0],p0,0,0,0);p1=__builtin_amdgcn_mfma_f32_32x32x16_bf16(b1,qr[d0],p1,0,0,0);}}
  p0=__builtin_amdgcn_mfma_f32_32x32x16_bf16(kx0,qx,p0,0,0,0);p1=__builtin_amdgcn_mfma_f32_32x32x16_bf16(kx1,qx,p1,0,0,0);
}
typedef __attribute__((address_space(3))) const char* lds_cptr;
typedef short v4i16_t __attribute__((ext_vector_type(4)));
__device__ __forceinline__ void kload8(bf16x8*kf,lds_cptr kp){
  kf[0]=*(const __attribute__((address_space(3))) bf16x8*)(kp);      kf[1]=*(const __attribute__((address_space(3))) bf16x8*)(kp+512);
  kf[2]=*(const __attribute__((address_space(3))) bf16x8*)(kp+2048); kf[3]=*(const __attribute__((address_space(3))) bf16x8*)(kp+2560);
  kf[4]=*(const __attribute__((address_space(3))) bf16x8*)(kp+4096); kf[5]=*(const __attribute__((address_space(3))) bf16x8*)(kp+4608);
  kf[6]=*(const __attribute__((address_space(3))) bf16x8*)(kp+6144); kf[7]=*(const __attribute__((address_space(3))) bf16x8*)(kp+6656);
}
__device__ __forceinline__ void kload2(bf16x8*kf,lds_cptr kp,int j){ kf[2*j]=*(const __attribute__((address_space(3))) bf16x8*)(kp+j*2048); kf[2*j+1]=*(const __attribute__((address_space(3))) bf16x8*)(kp+j*2048+512); }
__device__ __forceinline__ s16x4 vtr(lds_cptr p){ return __builtin_bit_cast(s16x4,__builtin_amdgcn_ds_read_tr16_b64_v4i16((__attribute__((address_space(3))) v4i16_t*)p)); }
typedef unsigned u32x2_t __attribute__((ext_vector_type(2)));
__device__ __forceinline__ u32x2_t ldkx_raw(lds_cptr p){ return *(const __attribute__((address_space(3))) u32x2_t*)p; }
__device__ __forceinline__ bf16x8 mkkx(u32x2_t w){ const u32x4 v={w.x,w.y,0x3F803F80u,0u}; return __builtin_bit_cast(bf16x8,v); }
__device__ __forceinline__ bf16x8 ldkx(lds_cptr p){ const u32x2_t w=*(const __attribute__((address_space(3))) u32x2_t*)p; const u32x4 v={w.x,w.y,0x3F803F80u,0u}; return __builtin_bit_cast(bf16x8,v); }
__device__ __forceinline__ bf16x8 make_qx(float a,int hi){
  const unsigned ah=cvtpk_s(a,0.f)&0xffffu; const float r1=a-__uint_as_float(ah<<16);
  const unsigned am=cvtpk_s(r1,0.f)&0xffffu; const float r2=r1-__uint_as_float(am<<16);
  u32x4 v={0x3F803F80u,0x3F80u|(ah<<16),cvtpk_s(r1,r2),0u};
  if(hi){v=(u32x4){0u,0u,0u,0u};}
  return __builtin_bit_cast(bf16x8,v);
}
__device__ __forceinline__ float rowmax(const f32x16&p0,const f32x16&p1){
  float a=max3f(p0[0],p0[1],p1[0]),b=max3f(p0[2],p0[3],p1[1]);a=max3f(a,p1[2],p1[3]);
  #pragma unroll
  for(int r=4;r<16;r+=4){a=max3f(a,p0[r],p0[r+1]);b=max3f(b,p0[r+2],p0[r+3]);a=max3f(a,p1[r],p1[r+1]);b=max3f(b,p1[r+2],p1[r+3]);}
  const float m=max2f(a,b);
  auto rr=__builtin_amdgcn_permlane32_swap(__float_as_uint(m),__float_as_uint(m),false,false);
  return max2f(__uint_as_float(rr[0]),__uint_as_float(rr[1]));
}
__device__ __forceinline__ void pv(f32x16*o,int vb,bf16x8 pa0,bf16x8 pa1,bf16x8 pa2,bf16x8 pa3){
  #pragma unroll
  for(int d0=0;d0<2;++d0){s16x4 lo[4],hi[4];
    #pragma unroll
    for(int ks=0;ks<4;++ks){
      asm volatile("ds_read_b64_tr_b16 %0,%1 offset:%c2":"=&v"(lo[ks]):"v"(vb),"i"(d0*4096+ks*1024):"memory");
      asm volatile("ds_read_b64_tr_b16 %0,%1 offset:%c2":"=&v"(hi[ks]):"v"(vb),"i"(d0*4096+ks*1024+512):"memory");}
    asm volatile("s_waitcnt lgkmcnt(0)":::"memory");SBAR();
    #define PK(k) (bf16x8){lo[k][0],lo[k][1],lo[k][2],lo[k][3],hi[k][0],hi[k][1],hi[k][2],hi[k][3]}
    o[d0]=__builtin_amdgcn_mfma_f32_32x32x16_bf16(pa0,PK(0),o[d0],0,0,0);
    o[d0]=__builtin_amdgcn_mfma_f32_32x32x16_bf16(pa1,PK(1),o[d0],0,0,0);
    o[d0]=__builtin_amdgcn_mfma_f32_32x32x16_bf16(pa2,PK(2),o[d0],0,0,0);
    o[d0]=__builtin_amdgcn_mfma_f32_32x32x16_bf16(pa3,PK(3),o[d0],0,0,0);
    #undef PK
  }
}

#ifndef ATTN_STORE16
#define ATTN_STORE16(p,v) (*(u32x4*)(p)=(v))
#endif
template<int THRL> __device__ __forceinline__ void attn_unit(int b,int h,int qb,const bf16*Q,const bf16*__restrict__ K,const bf16*__restrict__ V,bf16*O,const unsigned long long*KX8,const float*GF,const float*QKB,float*SSQ,char*shm,const int tid){
  const int lane=tid&63,r32=lane&31,hi=lane>>5; const int wid=__builtin_amdgcn_readfirstlane(tid>>6);
  const long rowbase=(long)b*SEQ; const int q0=qb*QB;
  const bf16*Qw=Q+(rowbase+q0+wid*QBLK)*DM+h*D;
  const bf16*Kh=K+rowbase*DM+h*D,*Vh=V+rowbase*DM+h*D;
  const unsigned lds0=(unsigned)(uintptr_t)shm;
  float*wsf=(float*)(shm+LDS_WS)+wid*64;
  const bf16*ksrc=Kh+wid*8;
  const bf16*vsrc=Vh+(long)(16*(wid&3))*DM+(wid>>2)*32;
  const unsigned kvoff=(unsigned)lane*(DM*2), vvoff=(unsigned)((lane>>2)*DM+(lane&3)*8)*2u;
  const unsigned kdst=lds0+LDS_K+wid*1024, vdst=lds0+LDS_V+wid*1024;
  #define DMA_K(t,slot) glds16s(ksrc+(long)(NT-1-(t))*KVBLK*DM,kvoff,(unsigned)__builtin_amdgcn_readfirstlane(kdst+(slot)))
  #define DMA_V(t,slot) glds16s(vsrc+(long)(NT-1-(t))*KVBLK*DM,vvoff,(unsigned)__builtin_amdgcn_readfirstlane(vdst+(slot)))
  const int vb0=(int)(lds0+LDS_V)+((lane>>4)&1)*32+(lane&3)*8+(4*hi+((lane&15)>>2))*64;
  const char*Kbase=shm+LDS_K; bf16x8 kf[8];
  const lds_cptr shm3=(lds_cptr)shm; const lds_cptr kp0=shm3+LDS_K+hi*1024+r32*16; const lds_cptr vp0=shm3+LDS_V+((lane>>4)&1)*32+(lane&3)*8+(4*hi+((lane&15)>>2))*64;
  const int NT=(q0+QB)/KVBLK;
  const lds_cptr tp0=shm3+LDS_TAB+r32*8;
  const float nGi=-GF[(long)(b*NHEAD+h)*SEQ+q0+wid*QBLK+r32];
  float gl0,gl1,gthr,bqk;
  { const float*gfh=GF+(long)(b*NHEAD+h)*SEQ; gl0=(lane<NT)?gfh[64*lane+63]:3.0e38f; gl1=(lane+64<NT)?gfh[64*(lane+64)+63]:3.0e38f;
    float kp=QKB[(b*NHEAD+h)*16+(lane&15)];
    #define DPPMAX_(v,c) fmaxf((v),__builtin_bit_cast(float,__builtin_amdgcn_update_dpp(0,__builtin_bit_cast(int,(v)),(c),0xf,0xf,false)))
    kp=DPPMAX_(kp,0xB1);kp=DPPMAX_(kp,0x4E);kp=DPPMAX_(kp,0x141);kp=DPPMAX_(kp,0x140);
    #undef DPPMAX_
    const float bq=2.04f*sqrtf(QKB[512+(b*NHEAD+h)*32+qb]*kp);
    gthr=gfh[q0]-(TCUT+2.f*bq); bqk=bq; }
  DMA_K(0,0);DMA_V(0,0);DMA_K(1,SLOTB);
  bf16x8 qr[4];
  #pragma unroll
  for(int d0=0;d0<4;++d0)qr[d0]=*reinterpret_cast<const bf16x8*>(&Qw[(long)r32*DM+d0*16+hi*8]);
  { float dd=0.f; const bf16*Kd=Kh+(long)(q0+wid*QBLK+r32)*DM+hi*8;
    #pragma unroll
    for(int d0=0;d0<4;++d0){ const bf16x8 kk=*reinterpret_cast<const bf16x8*>(Kd+d0*16);
      #pragma unroll
      for(int j=0;j<8;++j)dd+=__uint_as_float((unsigned)(unsigned short)qr[d0][j]<<16)*__uint_as_float((unsigned)(unsigned short)kk[j]<<16); }
    { const auto rr=__builtin_amdgcn_permlane32_swap(__float_as_uint(dd),__float_as_uint(dd),false,false); dd=__uint_as_float(rr[0])+__uint_as_float(rr[1]); }
    float vm=dd-nGi;
    #define DPPMIN_(v,c) fminf((v),__builtin_bit_cast(float,__builtin_amdgcn_update_dpp(0,__builtin_bit_cast(int,(v)),(c),0xf,0xf,false)))
    vm=DPPMIN_(vm,0xB1);vm=DPPMIN_(vm,0x4E);vm=DPPMIN_(vm,0x141);vm=DPPMIN_(vm,0x140);
    #undef DPPMIN_
    { const auto rr=__builtin_amdgcn_permlane16_swap(__float_as_uint(vm),__float_as_uint(vm),false,false); vm=fminf(__uint_as_float(rr[0]),__uint_as_float(rr[1])); }
    if(lane==0)wsf[0]=vm; }
  int NS=NT;
  { const int cnt=__builtin_popcountll(__ballot(gl0<gthr))+__builtin_popcountll(__ballot(gl1<gthr)); int tlo=cnt&~1; if(tlo>NT-4)tlo=NT-4; NS=__builtin_amdgcn_readfirstlane(NT-tlo); }
  { const char*tsrc=(const char*)(KX8+(long)(b*NHEAD+h)*SEQ); const int npc=2*(qb+1);
    for(int pc=((NT-NS)>>1)+wid;pc<npc;pc+=NW)glds16s(tsrc+(long)pc*1024,(unsigned)lane*16u,(unsigned)__builtin_amdgcn_readfirstlane(lds0+LDS_TAB+pc*1024)); }
  float mhat=0.f,l_reg=0.f;f32x16 o[2];o[0]=f32x16{};o[1]=f32x16{};bf16x8 qx=make_qx(nGi,hi);const f32x16 zc=f32x16{};
  if(hi==0)wsf[32+r32]=nGi;
  const int qrel=wid*QBLK+r32;
  #define CMASK(P0,P1,t) do{int jb_=3-(t); if(jb_>=0)cmask(P0,P1,jb_,qrel,hi);}while(0)
  bool resc=false;
  #define START(P0,P1) do{ const float rm=rowmax(P0,P1); resc=false; \
    { const float dl=(rm<-1e30f)?0.f:rm; mhat=fadd_s(mhat,dl); \
      _Pragma("unroll") for(int r=0;r<16;++r){P0[r]=fsub_s(P0[r],dl);P1[r]=fsub_s(P1[r],dl);} \
      qx=make_qx(nGi-mhat,hi); } \
    _Pragma("unroll") for(int r=0;r<16;++r)P0[r]=__builtin_amdgcn_exp2f(P0[r]); }while(0)
  #define RESC() do{ if(resc){ asm volatile("s_waitcnt lgkmcnt(0)":::"memory"); \
      _Pragma("unroll") for(int d_=0;d_<2;++d_) _Pragma("unroll") for(int r=0;r<16;++r)o[d_][r]*=wsf[crow(r,hi)]; } }while(0)
  f32x16 pA0,pA1,pB0,pB1;
  int sl_prev=0,sl_cur=0,sl_next=SLOTB;
  #define ROT() do{sl_prev=sl_cur;sl_cur=sl_next;sl_next=(sl_next==(NSLOT-1)*SLOTB)?0:sl_next+SLOTB;}while(0)
  DMA_K(2,2*SLOTB);
  WAIT_BAR(1);
  { float bm=((const float*)(shm+LDS_WS))[0];
    #pragma unroll
    for(int w_=1;w_<NW;++w_)bm=fminf(bm,((const float*)(shm+LDS_WS))[w_*64]);
    const float gthr2=bm-bqk-TCUT-0.05f;
    const int cnt=__builtin_popcountll(__ballot(gl0<gthr2))+__builtin_popcountll(__ballot(gl1<gthr2)); int tlo=cnt&~1; if(tlo>NT-4)tlo=NT-4; const int ns2=__builtin_amdgcn_readfirstlane(NT-tlo); if(ns2<NS)NS=ns2; }
  qkt(pA0,pA1,Kbase,qr,qx,ldkx(tp0+(NT-1)*512),ldkx(tp0+(NT-1)*512+256),r32,hi);asm volatile("s_nop 15\n\ts_nop 7":"+v"(pA0),"+v"(pA1));CMASK(pA0,pA1,0);
  START(pA0,pA1);
  _Pragma("unroll") for(int r=0;r<16;++r)pA1[r]=__builtin_amdgcn_exp2f(pA1[r]);
  WAIT_BAR(0);
  DMA_K(3,0);DMA_V(1,SLOTB);
  ROT();
  kload8(kf,kp0+sl_cur);
  WAIT_BAR(2);
  s16x4 vlo[8],vhi[8]; u32x4 pw0,pw1,pw2,pw3;
  #define PKW(P,B) cvtpk_s(P[B],P[B+1])
  #define PAF(k) __builtin_bit_cast(bf16x8,pw##k)
  #define VFR(i) (bf16x8){vlo[i][0],vlo[i][1],vlo[i][2],vlo[i][3],vhi[i][0],vhi[i][1],vhi[i][2],vhi[i][3]}
  #define PIN(x) asm volatile("":"+v"(x))
  #define MX3(a,b,c) __builtin_fmaxf(__builtin_fmaxf((a),(b)),(c))
  #define GAPA(MF,A0,A1,A2,A3,W0,W1,PW) do{ MF; sacc+=A0; sacc+=A1; sacc+=A2; sacc+=A3; PIN(sacc); W0; W1; PIN(PW); SBAR(); }while(0)
  #define EX(v) __builtin_amdgcn_exp2f(v)
  #define GAPB(MF,X,B) do{ MF; X[B]=EX(X[B]); X[B+1]=EX(X[B+1]); X[B+2]=EX(X[B+2]); X[B+3]=EX(X[B+3]); PIN(X); SBAR(); }while(0)
  #define VRD(i) do{ vlo[i]=vtr(vp_+(((i)>>2)*4096+((i)&3)*1024)); vhi[i]=vtr(vp_+(((i)>>2)*4096+((i)&3)*1024+512)); }while(0)
  #define KRD(G,j) do{ if(G){ kload2(kf,kp0+sl_next,j); SBAR(); } }while(0)
  #define STEP(C0,C1,P0,P1,t,GK,GV,GL) do{ SBAR(); \
    const lds_cptr vp_=vp0+sl_prev; \
    const u32x2_t kq0_=ldkx_raw(tp0+(NT-1-(t))*512), kq1_=ldkx_raw(tp0+(NT-1-(t))*512+256); \
    VRD(0); SBAR(); float sacc=(P0[0]+P0[1]); \
    GAPA(C0=__builtin_amdgcn_mfma_f32_32x32x16_bf16(kf[0],qr[0],zc,0,0,0), P0[2],P0[3],P0[4],P0[5],     pw0[0]=PKW(P0,0), pw0[1]=PKW(P0,2), pw0); \
    VRD(4); SBAR(); GAPA(C1=__builtin_amdgcn_mfma_f32_32x32x16_bf16(kf[1],qr[0],zc,0,0,0), P0[6],P0[7],P0[8],P0[9],     pw0[2]=PKW(P0,4), pw0[3]=PKW(P0,6), pw0); \
    C0=__builtin_amdgcn_mfma_f32_32x32x16_bf16(mkkx(kq0_),qx,C0,0,0,0); SBAR(); C1=__builtin_amdgcn_mfma_f32_32x32x16_bf16(mkkx(kq1_),qx,C1,0,0,0); SBAR(); \
    VRD(1); SBAR(); GAPA(C0=__builtin_amdgcn_mfma_f32_32x32x16_bf16(kf[2],qr[1],C0,0,0,0),   P0[10],P0[11],P0[12],P0[13], pw1[0]=PKW(P0,8), pw1[1]=PKW(P0,10), pw1); \
    VRD(5); SBAR(); GAPA(C1=__builtin_amdgcn_mfma_f32_32x32x16_bf16(kf[3],qr[1],C1,0,0,0),   P0[14],P0[15],P1[0],P1[1],   pw1[2]=PKW(P0,12),pw1[3]=PKW(P0,14), pw1); \
    VRD(2); SBAR(); GAPA(C0=__builtin_amdgcn_mfma_f32_32x32x16_bf16(kf[4],qr[2],C0,0,0,0),   P1[2],P1[3],P1[4],P1[5],     pw2[0]=PKW(P1,0), pw2[1]=PKW(P1,2), pw2); \
    VRD(6); SBAR(); GAPA(C1=__builtin_amdgcn_mfma_f32_32x32x16_bf16(kf[5],qr[2],C1,0,0,0),   P1[6],P1[7],P1[8],P1[9],     pw2[2]=PKW(P1,4), pw2[3]=PKW(P1,6), pw2); \
    VRD(3); SBAR(); GAPA(C0=__builtin_amdgcn_mfma_f32_32x32x16_bf16(kf[6],qr[3],C0,0,0,0),   P1[10],P1[11],P1[12],P1[13], pw3[0]=PKW(P1,8), pw3[1]=PKW(P1,10), pw3); \
    VRD(7); SBAR(); GAPA(C1=__builtin_amdgcn_mfma_f32_32x32x16_bf16(kf[7],qr[3],C1,0,0,0),   P1[14],P1[15],0.f,0.f,       pw3[2]=PKW(P1,12),pw3[3]=PKW(P1,14), pw3); \
    l_reg+=sacc; \
    if(GK){DMA_K((t)+3,sl_cur);} if(GV){DMA_V((t)+1,sl_next);} \
    CMASK(C0,C1,t); \
    { float a=MX3(C0[0],C0[1],C1[0]),b=MX3(C0[2],C0[3],C1[1]); a=MX3(a,C1[2],C1[3]); \
      _Pragma("unroll") for(int r=4;r<16;r+=4){a=MX3(a,C0[r],C0[r+1]);b=MX3(b,C0[r+2],C0[r+3]);a=MX3(a,C1[r],C1[r+1]);b=MX3(b,C1[r+2],C1[r+3]);} \
      float rm=__builtin_fmaxf(a,b); { auto rr=__builtin_amdgcn_permlane32_swap(__float_as_uint(rm),__float_as_uint(rm),false,false); rm=__builtin_fmaxf(__uint_as_float(rr[0]),__uint_as_float(rr[1])); } \
      resc=false; \
      if(__builtin_expect(__any(rm>(float)THRL),0)){ const float dl=__builtin_fmaxf(rm,0.f); mhat+=dl; \
        _Pragma("unroll") for(int r=0;r<16;++r){C0[r]-=dl;C1[r]-=dl;} \
        qx=make_qx(wsf[32+r32]-mhat,hi); \
        const float f=__builtin_amdgcn_exp2f(-dl); l_reg*=f; if(hi==0)wsf[r32]=f; resc=true; } } \
    SBAR(); \
    GAPB(o[0]=__builtin_amdgcn_mfma_f32_32x32x16_bf16(PAF(0),VFR(0),o[0],0,0,0), C0,0); \
    GAPB(o[1]=__builtin_amdgcn_mfma_f32_32x32x16_bf16(PAF(0),VFR(4),o[1],0,0,0), C0,4); \
    KRD(GL,0); GAPB(o[0]=__builtin_amdgcn_mfma_f32_32x32x16_bf16(PAF(1),VFR(1),o[0],0,0,0), C0,8); \
    KRD(GL,1); GAPB(o[1]=__builtin_amdgcn_mfma_f32_32x32x16_bf16(PAF(1),VFR(5),o[1],0,0,0), C0,12); \
    KRD(GL,2); GAPB(o[0]=__builtin_amdgcn_mfma_f32_32x32x16_bf16(PAF(2),VFR(2),o[0],0,0,0), C1,0); \
    KRD(GL,3); GAPB(o[1]=__builtin_amdgcn_mfma_f32_32x32x16_bf16(PAF(2),VFR(6),o[1],0,0,0), C1,4); \
    GAPB(o[0]=__builtin_amdgcn_mfma_f32_32x32x16_bf16(PAF(3),VFR(3),o[0],0,0,0), C1,8); \
    GAPB(o[1]=__builtin_amdgcn_mfma_f32_32x32x16_bf16(PAF(3),VFR(7),o[1],0,0,0), C1,12); \
    }while(0)
  int t=1;
  #define ENDW(tt) do{ if((tt)+3<NS){WAIT_BAR(2);} else if((tt)+2<NS){WAIT_BAR(1);} else {WAIT_BAR(0);} }while(0)
  for(;t<5&&t+1<NS;t+=2){
    STEP(pB0,pB1,pA0,pA1,t,(t+3<NS),(t+1<NS),(t+1<NS));       ENDW(t);   RESC(); ROT();
    STEP(pA0,pA1,pB0,pB1,t+1,(t+4<NS),(t+2<NS),(t+2<NS));     ENDW(t+1); RESC(); ROT();
  }
  #undef CMASK
  #define CMASK(P0,P1,t) do{}while(0)
  for(;t+5<NS;t+=2){
    STEP(pB0,pB1,pA0,pA1,t,true,true,true);     WAIT_BAR(2); RESC(); ROT();
    STEP(pA0,pA1,pB0,pB1,t+1,true,true,true);   WAIT_BAR(2); RESC(); ROT();
  }
  #undef CMASK
  #define CMASK(P0,P1,t) do{int jb_=3-(t); if(jb_>=0)cmask(P0,P1,jb_,qrel,hi);}while(0)
  for(;t+1<NS;t+=2){
    STEP(pB0,pB1,pA0,pA1,t,(t+3<NS),(t+1<NS),(t+1<NS));       ENDW(t);   RESC(); ROT();
    STEP(pA0,pA1,pB0,pB1,t+1,(t+4<NS),(t+2<NS),(t+2<NS));     ENDW(t+1); RESC(); ROT();
  }
  STEP(pB0,pB1,pA0,pA1,NS-1,false,false,false); RESC();
  { float sacc=pB0[0]+pB0[1]; _Pragma("unroll") for(int r=2;r<16;++r)sacc+=pB0[r]; _Pragma("unroll") for(int r=0;r<16;++r)sacc+=pB1[r]; l_reg+=sacc;
    pw0=(u32x4){PKW(pB0,0),PKW(pB0,2),PKW(pB0,4),PKW(pB0,6)};pw1=(u32x4){PKW(pB0,8),PKW(pB0,10),PKW(pB0,12),PKW(pB0,14)};pw2=(u32x4){PKW(pB1,0),PKW(pB1,2),PKW(pB1,4),PKW(pB1,6)};pw3=(u32x4){PKW(pB1,8),PKW(pB1,10),PKW(pB1,12),PKW(pB1,14)};
    SBAR(); pv(o,vb0+sl_cur,PAF(0),PAF(1),PAF(2),PAF(3)); }
  #undef PKW
  #undef PAF
  #undef VFR
  #undef PIN
  #undef MX3
  #undef GAPA
  #undef GAPB
  #undef EX
  #undef VRD
  #undef KRD
  #undef STEP
  #undef ENDW
  {auto rr=__builtin_amdgcn_permlane32_swap(__float_as_uint(l_reg),__float_as_uint(l_reg),false,false);l_reg=__uint_as_float(rr[0])+__uint_as_float(rr[1]);}
  if(hi==0)wsf[32+r32]=l_reg;asm volatile("s_waitcnt lgkmcnt(0)":::"memory");
  float rli[16];
  #pragma unroll
  for(int r=0;r<16;++r)rli[r]=__builtin_amdgcn_rcpf(wsf[32+crow(r,hi)]);
  bf16*Ow=O+(rowbase+q0+wid*QBLK)*OPITCH+h*D;
  { bf16*stg=(bf16*)(shm+LDS_OST)+wid*2048;
    #pragma unroll
    for(int r=0;r<16;++r){const int orow=crow(r,hi);
      #pragma unroll
      for(int d0=0;d0<2;++d0)stg[orow*64+d0*32+r32]=__float2bfloat16(o[d0][r]*rli[r]);}
    asm volatile("s_waitcnt lgkmcnt(0)":::"memory");
    #pragma unroll
    for(int i=0;i<4;++i){const int row=i*8+(lane>>3),ch=lane&7; const u32x4 v=*(const u32x4*)(stg+row*64+ch*8); ATTN_STORE16(Ow+(long)row*OPITCH+ch*8,v);
      float q=0.f;
      #pragma unroll
      for(int e=0;e<4;++e){const float lo=__uint_as_float(v[e]<<16),hh=__uint_as_float(v[e]&0xffff0000u);q+=lo*lo+hh*hh;}
      q+=__shfl_xor(q,1);q+=__shfl_xor(q,2);q+=__shfl_xor(q,4);
      if(ch==0)SSQ[(rowbase+q0+wid*QBLK+row)*16+8+h]=q;} }
  asm volatile("s_waitcnt lgkmcnt(0)\n\ts_barrier":::"memory");
  #undef DMA_K
  #undef DMA_V
  #undef CMASK
  #undef START
  #undef RESC
  #undef ROT
}
constexpr int ATTN_LDS_BYTES=LDS_BYTES;
struct AttnTensors { const bf16* Q; const bf16* K; const bf16* V; bf16* O; const unsigned long long* KX8; const float* GF; const float* QKB; float* SSQ; };
struct AttnUnit { int bh; int qb; };
struct StaticOrder {
  int vcu;
  __device__ __forceinline__ explicit StaticOrder(int grid,int block):vcu((block%8)*(grid/8)+block/8){}
  __device__ __forceinline__ bool next(int i,AttnUnit&u)const{ if(i>=4)return false; const int s=vcu&7; u.bh=((vcu>>3)+8*i)&31;     u.qb=(i==0)?s:(i==1)?15-s:(i==2)?16+s:31-s; return true; }
  __device__ __forceinline__ void a_ready(const AttnUnit&)const{}
  __device__ __forceinline__ void done(const AttnUnit&)const{}
};
template<class Sched,int THRL=8> __device__ __forceinline__ void attn_phase(char*lds,const AttnTensors&T,const Sched&S,const int tid){
  AttnUnit u;
  for(int i=0;S.next(i,u);++i){ S.a_ready(u); attn_unit<THRL>(u.bh/NHEAD,u.bh%NHEAD,u.qb,T.Q,T.K,T.V,T.O,T.KX8,T.GF,T.QKB,T.SSQ,lds,tid); S.done(u); }
}
#undef SBAR
#undef WAIT_BAR
}

constexpr int NWAVES = 8;
constexpr int N_PHASES = 11;
constexpr int N_LAUNCHES = MK_N_LAUNCHES;

constexpr size_t MiB = 1u << 20;
constexpr size_t WS_CTL = 0, CTL_ZERO_BYTES = 64 * 1024;
constexpr size_t WS_ADAP = 14 * MiB;
constexpr size_t WS_ADA = 2 * MiB;
constexpr size_t WS_WSM = WS_ADA + 128 * 1024;
constexpr size_t WS_LC = 3 * MiB;
constexpr size_t WS_CT = 4 * MiB;
constexpr size_t WS_TOKC = WS_CT + 64 * 1024;
constexpr size_t WS_TW = WS_TOKC + 256 * 1024;
constexpr size_t WS_SSQY = 5 * MiB;
constexpr size_t WS_SSQ1 = 7 * MiB;
constexpr size_t WS_SSQ2 = 9 * MiB;
constexpr size_t WS_INV = 11 * MiB;
constexpr size_t WS_TOK = 14 * MiB;
constexpr size_t WS_SW = WS_TOK + 256 * 1024;
constexpr size_t WS_WIN = 16 * MiB;
constexpr size_t WS_WOUT = 22 * MiB;
constexpr size_t WS_WGU = 24 * MiB;
constexpr size_t WS_WD = 56 * MiB;
constexpr size_t WS_XN = 104 * MiB;
constexpr size_t WS_U = 168 * MiB;
constexpr size_t WS_Y = 328 * MiB;
constexpr size_t WS_H2 = WS_XN;
constexpr size_t WS_H2S = 168 * MiB;
constexpr size_t WS_ACT = 244 * MiB;
constexpr size_t WS_KX8 = 392 * MiB;
constexpr size_t WS_GF = 394 * MiB;
constexpr size_t WS_MIX = 396 * MiB;
constexpr size_t WS_MOE = WS_XN;
constexpr size_t WS_X1 = WS_Y;
constexpr size_t WS_END = 460 * MiB;
static_assert(WS_ACT + (size_t)MAXTILES * 256 * 1024 * 2 <= WS_Y && WS_H2S + (size_t)MAXTILES * 256 * 1024 * 2 <= WS_ACT, "d_ws map");
constexpr int CW_TMO = 0, CW_CODE = 1;
constexpr int CW_CNT = 64, CNT_STRIDE = 64;
constexpr int CW_QKB = 2048;
constexpr int CW_BAR = 4096;
constexpr int RING_OFF = 0, RING_BYTES = 151552;
constexpr int LDSCTL_OFF = RING_BYTES, MISC_OFF = LDSCTL_OFF + 320;
constexpr int TCLS_OFF = LDSCTL_OFF + 512;
constexpr int TFIRST_OFF = LDSCTL_OFF + 704;
constexpr int LCNT_OFF = LDSCTL_OFF + 768;
constexpr int TOKU_OFF = LDSCTL_OFF + 1024;
constexpr int TOKW_OFF = TOKU_OFF + 5120;
static_assert(TOKW_OFF + 5120 <= 163840, "LDS control region");
constexpr int LDS_BYTES = 163840;

#define GAS __attribute__((address_space(1)))
#define LAS __attribute__((address_space(3)))
typedef unsigned short bf16;
typedef unsigned v4u __attribute__((ext_vector_type(4)));
typedef float f32x4 __attribute__((ext_vector_type(4)));
typedef short bf16x8 __attribute__((ext_vector_type(8)));
typedef GAS unsigned gu32;
typedef GAS unsigned long long gu64;
#define RLX_AGENT __ATOMIC_RELAXED, __HIP_MEMORY_SCOPE_AGENT
#define LDS_WAIT() asm volatile("s_waitcnt lgkmcnt(0)" ::: "memory")
#define VM_WAIT() asm volatile("s_waitcnt vmcnt(0)" ::: "memory")
__device__ __forceinline__ unsigned long long rt() { return __builtin_amdgcn_s_memrealtime(); }
__device__ __forceinline__ unsigned f2bf(float f) { unsigned u = __builtin_bit_cast(unsigned, f); return (u + 0x7fffu + ((u >> 16) & 1u)) >> 16; }
typedef float f32x2_hw __attribute__((ext_vector_type(2))); typedef __bf16 bf16x2_hw __attribute__((ext_vector_type(2)));
__device__ __forceinline__ unsigned pk2(float lo, float hi) { const f32x2_hw v = {lo, hi}; const bf16x2_hw b = __builtin_convertvector(v, bf16x2_hw); return __builtin_bit_cast(unsigned, b); }

#define XB_TMO      128
#define XB_XCNT(j)  (256  + 64 * (j))
#define XB_XSUB(j)  (1280 + 64 * (j))
#define XB_XGEN(j)  (2304 + 64 * (j))
#define XB_TOP      3328
#define XB_TOPGEN   3392
#define XCD_BAR_WORDS 3456
#define XB_SPIN_CAP (1u << 18)

__device__ __forceinline__ unsigned xb_ld(unsigned* p)              { return __hip_atomic_load(p, __ATOMIC_RELAXED, __HIP_MEMORY_SCOPE_AGENT); }
__device__ __forceinline__ unsigned xb_add(unsigned* p, unsigned v) { return __hip_atomic_fetch_add(p, v, __ATOMIC_RELAXED, __HIP_MEMORY_SCOPE_AGENT); }
__device__ __forceinline__ unsigned xb_xcc_id() { return (unsigned)__builtin_amdgcn_s_getreg((3 << 11) | 20) & 0xFu; }
#define XB_SPIN(cond, bar) do { unsigned _sp = 0; while (cond) { __builtin_amdgcn_s_sleep(1); \
    if ((++_sp & 255u) == 0u) { if (xb_ld(&(bar)[XB_TMO])) break; if (_sp > XB_SPIN_CAP) { atomicAdd(&(bar)[XB_TMO], 1u); break; } } } } while (0)

struct XcdBarrier {
    unsigned* bar; unsigned x;
    volatile LAS unsigned* st;
};

__device__ __forceinline__ XcdBarrier xcd_barrier_post(unsigned* bar, volatile LAS unsigned* st) {
    XcdBarrier b; b.bar = bar; b.x = xb_xcc_id(); b.st = st;
    if (threadIdx.x == 0) (void)xb_add(&bar[XB_XCNT(b.x)], 1u);
    return b;
}
__device__ __forceinline__ void xcd_barrier_complete(unsigned* bar, unsigned x, unsigned& nloc, unsigned& nx) {
    const unsigned G = gridDim.x * gridDim.y * gridDim.z;
    unsigned sum, cnt, mine, sp = 0u;
    for (;;) {
        sum = 0u; cnt = 0u; mine = 0u;
#pragma unroll
        for (unsigned j = 0; j < 16; ++j) { const unsigned c = xb_ld(&bar[XB_XCNT(j)]); sum += c; cnt += (c > 0u) ? 1u : 0u; mine = (j == x) ? c : mine; }
        if (sum == G) break;
        __builtin_amdgcn_s_sleep(1);
        if ((++sp & 255u) == 0u) { if (xb_ld(&bar[XB_TMO])) break; if (sp > XB_SPIN_CAP) { atomicAdd(&bar[XB_TMO], 1u); break; } }
    }
    nloc = mine > 0u ? mine : 1u; nx = cnt > 0u ? cnt : 1u;
}

__device__ __forceinline__ void xcd_barrier(const XcdBarrier& b) {
    asm volatile("s_waitcnt vmcnt(0)" ::: "memory");
    __syncthreads();
    if (threadIdx.x == 0) {
        unsigned* bar = b.bar;
        __builtin_amdgcn_s_waitcnt(0);
        unsigned nloc = b.st[0], nx = b.st[1];
        if (nloc == 0u) { xcd_barrier_complete(bar, b.x, nloc, nx); b.st[0] = nloc; b.st[1] = nx; }
        const unsigned old = xb_add(&bar[XB_XSUB(b.x)], 1u);
        const unsigned gen = old / nloc;
        if (old + 1u == (gen + 1u) * nloc) {
            __builtin_amdgcn_fence(__ATOMIC_RELEASE, "agent");
            asm volatile("s_waitcnt vmcnt(0)" ::: "memory");
            const unsigned og = xb_add(&bar[XB_TOP], 1u);
            const unsigned tg = og / nx;
            if (og + 1u == (tg + 1u) * nx) xb_add(&bar[XB_TOPGEN], 1u);
            else XB_SPIN(xb_ld(&bar[XB_TOPGEN]) == tg, bar);
            __builtin_amdgcn_fence(__ATOMIC_ACQUIRE, "agent");
            xb_add(&bar[XB_XGEN(b.x)], 1u);
            asm volatile("s_waitcnt vmcnt(0)" ::: "memory");
        } else {
            XB_SPIN(xb_ld(&bar[XB_XGEN(b.x)]) == gen, bar);
            __builtin_amdgcn_fence(__ATOMIC_ACQUIRE, "agent");
            asm volatile("s_waitcnt vmcnt(0)" ::: "memory");
        }
    }
    __syncthreads();
}

struct Frame {
    LAS unsigned char* lds;
    volatile LAS unsigned* MISC;
    gu32* ctl;
    int tid, lane, wave;
    int vcu, G;
    unsigned char* ws;
    const float *x, *c, *w_ada, *b_ada, *g_mix, *w_in, *g_sgu, *w_sp, *b_sp, *b_fg, *g_osgu, *g_ofox, *w_out, *g_ffn, *w_rg, *b_rg, *w_re, *b_re, *w_gate, *w_up, *w_down, *g_fin;
    float* out;
};
#define DPP_ADD(v, ctrl) ((v) + __builtin_bit_cast(float, __builtin_amdgcn_update_dpp(0, __builtin_bit_cast(int, (v)), (ctrl), 0xf, 0xf, false)))
__device__ __forceinline__ float wave_sum(float v) {
    v = DPP_ADD(v, 0xB1); v = DPP_ADD(v, 0x4E); v = DPP_ADD(v, 0x141); v = DPP_ADD(v, 0x140);
    const int iv = __builtin_bit_cast(int, v);
    const float a = __builtin_bit_cast(float, __builtin_amdgcn_readlane(iv, 0)), b = __builtin_bit_cast(float, __builtin_amdgcn_readlane(iv, 16)), c = __builtin_bit_cast(float, __builtin_amdgcn_readlane(iv, 32)), e = __builtin_bit_cast(float, __builtin_amdgcn_readlane(iv, 48));
    return (a + b) + (c + e);
}
#define DPP_MOV(v, ctrl) __builtin_bit_cast(float, __builtin_amdgcn_update_dpp(0, __builtin_bit_cast(int, (v)), (ctrl), 0xf, 0xf, false))
#define SWZ_ADD(v, pat) ((v) + __builtin_bit_cast(float, __builtin_amdgcn_ds_swizzle(__builtin_bit_cast(int, (v)), (pat))))
__device__ __forceinline__ float sum_b2_b5(float v) { v = SWZ_ADD(v, 0x101F); v = SWZ_ADD(v, 0x201F); v = SWZ_ADD(v, 0x401F);
    const auto rr = __builtin_amdgcn_permlane32_swap(__float_as_uint(v), __float_as_uint(v), false, false); return __uint_as_float(rr[0]) + __uint_as_float(rr[1]); }
__device__ __forceinline__ void wave_sum8_t(const float (&v)[8], int lane, float& r0, float& r1) {
    const bool b0 = (lane & 1) != 0, b1 = (lane & 2) != 0; float a[4], c[2];
#pragma unroll
    for (int i = 0; i < 4; ++i) { const float keep = b0 ? v[i + 4] : v[i], send = b0 ? v[i] : v[i + 4]; a[i] = keep + DPP_MOV(send, 0xB1); }
#pragma unroll
    for (int i = 0; i < 2; ++i) { const float keep = b1 ? a[i + 2] : a[i], send = b1 ? a[i] : a[i + 2]; c[i] = keep + DPP_MOV(send, 0x4E); }
    r0 = sum_b2_b5(c[0]); r1 = sum_b2_b5(c[1]);
}
__device__ __forceinline__ void wave_sum4_all(float (&v)[4], int lane) {
    const bool b0 = (lane & 1) != 0, b1 = (lane & 2) != 0; float a[2];
#pragma unroll
    for (int i = 0; i < 2; ++i) { const float keep = b0 ? v[i + 2] : v[i], send = b0 ? v[i] : v[i + 2]; a[i] = keep + DPP_MOV(send, 0xB1); }
    const float keep = b1 ? a[1] : a[0], send = b1 ? a[0] : a[1]; float c = keep + DPP_MOV(send, 0x4E);
    c = sum_b2_b5(c); const int ic = __builtin_bit_cast(int, c);
    v[0] = __builtin_bit_cast(float, __builtin_amdgcn_readlane(ic, 0)); v[1] = __builtin_bit_cast(float, __builtin_amdgcn_readlane(ic, 2)); v[2] = __builtin_bit_cast(float, __builtin_amdgcn_readlane(ic, 1)); v[3] = __builtin_bit_cast(float, __builtin_amdgcn_readlane(ic, 3));
}
__device__ __forceinline__ float wave_max(float v) {
#pragma unroll
    for (int o = 1; o < 64; o <<= 1) v = fmaxf(v, __shfl_xor(v, o));
    return v;
}
__device__ __forceinline__ int lane_id_fresh() { int t, l; asm volatile("v_mbcnt_lo_u32_b32 %0, -1, 0" : "=v"(t)); asm volatile("v_mbcnt_hi_u32_b32 %0, -1, %1" : "=v"(l) : "v"(t)); return l; }
__device__ __forceinline__ float bf2f(unsigned short h) { return __uint_as_float((unsigned)h << 16); }

__device__ __forceinline__ void p0_tr_item(const float* W, int ldw, int k0, int n0, bf16* dst, int ldt, const float* kscale, LAS float* scr, int lane) {
    typedef float f32x2_t __attribute__((ext_vector_type(2)));
    f32x2_t tv[32];
#pragma unroll
    for (int i = 0; i < 32; ++i) { const int kk = 2 * i + (lane >> 5); tv[i] = *(const f32x2_t*)(W + (size_t)(k0 + kk) * ldw + n0 + 2 * (lane & 31)); }
    if (kscale) {
#pragma unroll
        for (int i = 0; i < 32; ++i) tv[i] = tv[i] * kscale[k0 + 2 * i + (lane >> 5)]; }
#pragma unroll
    for (int i = 0; i < 32; ++i) { LAS float* p = scr + (2 * i + (lane >> 5)) * 65 + 2 * (lane & 31); p[0] = tv[i].x; p[1] = tv[i].y; }
    LDS_WAIT(); asm volatile("" ::: "memory");
    const int c = lane & 7;
#pragma unroll
    for (int j = 0; j < 8; ++j) { const int n = (lane >> 3) + 8 * j; const LAS float* s = scr + (8 * c) * 65 + n;
        v4u o; o.x = pk2(s[0 * 65], s[1 * 65]); o.y = pk2(s[2 * 65], s[3 * 65]); o.z = pk2(s[4 * 65], s[5 * 65]); o.w = pk2(s[6 * 65], s[7 * 65]);
        *(GAS v4u*)(dst + (size_t)n * ldt + 8 * c) = o; }
    LDS_WAIT(); asm volatile("" ::: "memory");
}
__device__ __forceinline__ void p0_tr_item8(const float* W, int ldw, int k0, int n0, unsigned char* dst, int ldt, float scale, LAS float* scr, int lane) {
    typedef float f32x2_t __attribute__((ext_vector_type(2))); typedef int v2i_t __attribute__((ext_vector_type(2)));
    f32x2_t tv[32];
#pragma unroll
    for (int i = 0; i < 32; ++i) { const int kk = 2 * i + (lane >> 5); tv[i] = *(const f32x2_t*)(W + (size_t)(k0 + kk) * ldw + n0 + 2 * (lane & 31)); }
#pragma unroll
    for (int i = 0; i < 32; ++i) { LAS float* p = scr + (2 * i + (lane >> 5)) * 65 + 2 * (lane & 31); p[0] = __builtin_amdgcn_fmed3f(tv[i].x * scale, -448.f, 448.f); p[1] = __builtin_amdgcn_fmed3f(tv[i].y * scale, -448.f, 448.f); }
    LDS_WAIT(); asm volatile("" ::: "memory");
    const int c = lane & 7;
#pragma unroll
    for (int j = 0; j < 8; ++j) { const int n = (lane >> 3) + 8 * j; const LAS float* s = scr + (8 * c) * 65 + n; int p0 = 0, p1 = 0;
        p0 = __builtin_amdgcn_cvt_pk_fp8_f32(s[0 * 65], s[1 * 65], p0, false); p0 = __builtin_amdgcn_cvt_pk_fp8_f32(s[2 * 65], s[3 * 65], p0, true);
        p1 = __builtin_amdgcn_cvt_pk_fp8_f32(s[4 * 65], s[5 * 65], p1, false); p1 = __builtin_amdgcn_cvt_pk_fp8_f32(s[6 * 65], s[7 * 65], p1, true);
        *(v2i_t*)(dst + (size_t)n * ldt + 8 * c) = (v2i_t){p0, p1}; }
    LDS_WAIT(); asm volatile("" ::: "memory");
}
__device__ __forceinline__ void p0_prologue(Frame& F) {
    LAS float* scr = (LAS float*)(F.lds + RING_OFF + F.wave * 16896);
    const int gw = F.vcu * NWAVES + F.wave, NGW = F.G * NWAVES;
    bf16* WIN = (bf16*)(F.ws + WS_WIN); bf16* WOUT = (bf16*)(F.ws + WS_WOUT); bf16* WGU = (bf16*)(F.ws + WS_WGU); bf16* WD = (bf16*)(F.ws + WS_WD);
    constexpr int I_ADA = 16 * 24;
    constexpr int I_IN = (D / 64) * (NPROJ / 64);
    constexpr int I_OUT = (D / 64) * (D / 64);
    constexpr int I_GU1 = (D / 64) * (DEXP / 64);
    constexpr int I_GU = NEXP * 2 * I_GU1;
    constexpr int I_DC1 = (DEXP / 64) * (D / 64);
    constexpr int I_DC = NEXP * I_DC1;
    constexpr int I_SM = 8 * 128 * 128 / 512;
    constexpr int NITEMS = I_ADA + I_IN + I_OUT + I_SM;
    for (int it = gw; it < NITEMS; it += NGW) {
        int r = it;
        if (r < I_ADA) {
            const int kp = r / 24, cg = r % 24; const int n = cg * 256 + F.lane * 4;
            f32x4 a0 = {0.f, 0.f, 0.f, 0.f}, a1 = a0, a2 = a0, a3 = a0;
#pragma unroll
            for (int q = 0; q < 4; ++q) { const int idx = q * 64 + F.lane; const float cv = F.c[(idx >> 6) * D + kp * 64 + (idx & 63)]; scr[idx] = cv / (1.f + __expf(-cv)); }
            LDS_WAIT(); asm volatile("" ::: "memory");
#pragma unroll 2
            for (int k0 = 0; k0 < 64; k0 += 32) { f32x4 w[32];
#pragma unroll
                for (int kk = 0; kk < 32; ++kk) w[kk] = *(const f32x4*)(F.w_ada + (size_t)(kp * 64 + k0 + kk) * NADA + n);
#pragma unroll
                for (int kk = 0; kk < 32; ++kk) { a0 += w[kk] * scr[k0 + kk]; a1 += w[kk] * scr[64 + k0 + kk]; a2 += w[kk] * scr[128 + k0 + kk]; a3 += w[kk] * scr[192 + k0 + kk]; } }
            LDS_WAIT(); asm volatile("" ::: "memory");
            float* P = (float*)(F.ws + WS_ADAP) + (size_t)kp * 4 * NADA + n;
            *(f32x4*)(P) = a0; *(f32x4*)(P + NADA) = a1; *(f32x4*)(P + 2 * NADA) = a2; *(f32x4*)(P + 3 * NADA) = a3;
            continue; }
        r -= I_ADA;
        if (r < I_IN) { const int kb = r / (NPROJ / 64), nb = r % (NPROJ / 64); p0_tr_item(F.w_in, LDW_IN, 64 * kb, 64 * nb, WIN + (size_t)(64 * nb) * D + 64 * kb, D, nullptr, scr, F.lane); continue; }
        r -= I_IN;
        if (r < I_OUT) { const int kb = r / (D / 64), nb = r % (D / 64); const int k0 = 64 * kb;
            p0_tr_item(F.w_out, D, k0, 64 * nb, WOUT + (size_t)(64 * nb) * D + (k0 < DH ? k0 + DH : k0 - DH), D, k0 < DH ? F.g_osgu : F.g_ofox - DH, scr, F.lane); continue; }
        r -= I_OUT;
        { bf16* WSM = (bf16*)(F.ws + WS_WSM);
#pragma unroll
          for (int j = 0; j < 8; ++j) { const int idx = r * 512 + j * 64 + F.lane; const int tt = (idx >> 7) & 127, ss = idx & 127; const float v = F.w_sp[idx]; WSM[idx] = (bf16)f2bf(ss <= tt ? v : 0.f); } }
    }
}

__device__ __forceinline__ void p3_convert(Frame& F) {
    int lane = lane_id_fresh();
    LAS float* scr = (LAS float*)(F.lds + RING_OFF + F.wave * 16896);
    bf16* WGU = (bf16*)(F.ws + WS_WGU); bf16* WD = (bf16*)(F.ws + WS_WD);
    constexpr int I_GU1 = (D / 64) * (DEXP / 64), I_GU = NEXP * 2 * I_GU1, I_DC1 = (DEXP / 64) * (D / 64), I_DC = NEXP * I_DC1, NIT = I_GU + I_DC;
    const int per = (NIT + F.G - 1) / F.G;
    __syncthreads();
    for (int it = F.vcu * per + F.wave; it < (F.vcu + 1) * per && it < NIT; it += NWAVES) {
        int r = it;
        if (r < I_GU) { const int e = r / (2 * I_GU1), r2 = r % (2 * I_GU1), isup = r2 / I_GU1, r3 = r2 % I_GU1; const int kb = r3 / (DEXP / 64), nb = r3 % (DEXP / 64); const int n0 = 64 * nb;
            const float* W = (isup ? F.w_up : F.w_gate) + (size_t)e * D * DEXP; const int drow = (n0 >> 7) * 256 + isup * 128 + (n0 & 127);
#if MOE_FP8
            p0_tr_item8(W, DEXP, 64 * kb, n0, (unsigned char*)WGU + ((size_t)e * 1024 + drow) * D + 64 * kb, D, 64.f, scr, lane); continue; }
#else
            p0_tr_item(W, DEXP, 64 * kb, n0, WGU + ((size_t)e * 1024 + drow) * D + 64 * kb, D, nullptr, scr, lane); continue; }
#endif
        r -= I_GU;
        if (r < I_DC) { const int e = r / I_DC1, r3 = r % I_DC1; const int kb = r3 / (D / 64), nb = r3 % (D / 64);
#if MOE_FP8
            p0_tr_item8(F.w_down + (size_t)e * DEXP * D, D, 64 * kb, 64 * nb, (unsigned char*)WD + ((size_t)e * D + 64 * nb) * DEXP + 64 * kb, DEXP, 64.f, scr, lane); continue; }
#else
            p0_tr_item(F.w_down + (size_t)e * DEXP * D, D, 64 * kb, 64 * nb, WD + ((size_t)e * D + 64 * nb) * DEXP + 64 * kb, DEXP, nullptr, scr, lane); continue; }
#endif
    }
    __syncthreads();
}
__device__ __forceinline__ void p1_load(Frame& F, f32x4 (&v)[2][4], int ch, int rl) {
#pragma unroll
    for (int rr = 0; rr < 2; ++rr) { const f32x4* xr = (const f32x4*)(F.x + (size_t)(ch * 128 + rl + 8 * rr) * D) + F.lane;
#pragma unroll
        for (int j = 0; j < 4; ++j) v[rr][j] = xr[64 * j]; }
}
__device__ __forceinline__ void p1_rows(Frame& F, f32x4 (&v)[2][4], int ch, int rl, const LAS float* modA, const LAS float* modB, const LAS float* wf, LAS float* gi, bf16* XN) {
            float s[2] = {0.f, 0.f};
#pragma unroll
            for (int rr = 0; rr < 2; ++rr)
#pragma unroll
                for (int j = 0; j < 4; ++j) s[rr] += (v[rr][j].x * v[rr][j].x + v[rr][j].y * v[rr][j].y) + (v[rr][j].z * v[rr][j].z + v[rr][j].w * v[rr][j].w);
#pragma unroll
            for (int rr = 0; rr < 2; ++rr) { const int m = ch * 128 + rl + 8 * rr;
                const float rstd = 1.f / sqrtf(wave_sum(s[rr]) * (1.f / D) + EPS);
                float fl[8];
#pragma unroll
                for (int q = 0; q < 8; ++q) fl[q] = 0.f;
                unsigned long long* o8 = (unsigned long long*)(XN + (size_t)m * D) + F.lane;
#pragma unroll
                for (int j = 0; j < 4; ++j) { const int k0 = 4 * F.lane + 256 * j; float h[4];
#pragma unroll
                    for (int e = 0; e < 4; ++e) { h[e] = v[rr][j][e] * rstd * modA[k0 + e] + modB[k0 + e];
#pragma unroll
                        for (int q = 0; q < 8; ++q) fl[q] += h[e] * wf[q * D + k0 + e]; }
                    o8[64 * j] = (unsigned long long)pk2(h[0], h[1]) | ((unsigned long long)pk2(h[2], h[3]) << 32); }
                float r0, r1; wave_sum8_t(fl, F.lane, r0, r1);
                if (F.lane < 4) { const int q0 = 4 * (F.lane & 1) + 2 * (F.lane >> 1);
#pragma unroll
                    for (int e = 0; e < 2; ++e) { const float z = (e ? r1 : r0) + F.b_fg[q0 + e];
                        const float sp = fmaxf(-z, 0.f) + log1pf(expf(-fabsf(z)));
                        gi[(rl + 8 * rr) * 8 + q0 + e] = sp * LOG2E; } } }
}
__device__ __forceinline__ void p1_prenorm(Frame& F) {
    const float* ADAP = (const float*)(F.ws + WS_ADAP); float* ADA = (float*)(F.ws + WS_ADA);
    for (int i = blockIdx.x * (NWAVES * 64) + F.tid; i < BATCH * NADA; i += F.G * NWAVES * 64) { float s = F.b_ada[i % NADA];
#pragma unroll
        for (int p = 0; p < 16; ++p) s += ADAP[(size_t)p * BATCH * NADA + i];
        ADA[i] = s; }
    LAS float* modA = (LAS float*)(F.lds);
    LAS float* modB = modA + 1024;
    LAS float* wf = modB + 1024;
    LAS float* gi = wf + 8192;
    bf16* XN = (bf16*)(F.ws + WS_XN); float* LC = (float*)(F.ws + WS_LC); float* CT = (float*)(F.ws + WS_CT);
    for (int ch = blockIdx.x; ch < M / 128; ch += F.G) {
        const int b = ch / (T / 128);
        __syncthreads();
        for (int k = F.tid; k < D; k += NWAVES * 64) { float sh = F.b_ada[k], sc = F.b_ada[D + k];
#pragma unroll
            for (int p = 0; p < 16; ++p) { sh += ADAP[((size_t)p * BATCH + b) * NADA + k]; sc += ADAP[((size_t)p * BATCH + b) * NADA + D + k]; }
            modA[k] = F.g_mix[k] * (1.f + sc); modB[k] = sh; }
        for (int i = F.tid; i < D * 8; i += NWAVES * 64) wf[(i & 7) * D + (i >> 3)] = F.w_in[(size_t)(i >> 3) * LDW_IN + NPROJ + (i & 7)];
        __syncthreads();
        { f32x4 va[2][4], vb[2][4];
            p1_load(F, va, ch, F.wave);
#pragma unroll 1
            for (int it = 0; it < 4; ++it) {
                p1_load(F, vb, ch, F.wave + 16 * (2 * it + 1));
                p1_rows(F, va, ch, F.wave + 16 * (2 * it), modA, modB, wf, gi, XN);
                if (it < 3) p1_load(F, va, ch, F.wave + 16 * (2 * it + 2));
                p1_rows(F, vb, ch, F.wave + 16 * (2 * it + 1), modA, modB, wf, gi, XN);
            } }
        __syncthreads();
        { const int h = F.wave; float* lc = LC + ((size_t)b * NH + h) * T + (ch % (T / 128)) * 128;
            const float a0 = gi[(2 * F.lane) * 8 + h], a1 = gi[(2 * F.lane + 1) * 8 + h]; float sc = a0 + a1;
#pragma unroll
            for (int o = 1; o < 64; o <<= 1) { const float t = __shfl_up(sc, o); if (F.lane >= o) sc += t; }
            lc[2 * F.lane] = sc - a1; lc[2 * F.lane + 1] = sc;
            if (F.lane == 63) CT[((size_t)b * NH + h) * (T / 128) + (ch % (T / 128))] = sc; }
    }
    __syncthreads();
}

__device__ __forceinline__ void p3_sgu_naive(Frame& F) {
    const bf16* U = (const bf16*)(F.ws + WS_U); const bf16* VS = U + (size_t)M * DH; const bf16* WSM = (const bf16*)(F.ws + WS_WSM);
    bf16* Y = (bf16*)(F.ws + WS_Y); float* SSQY = (float*)(F.ws + WS_SSQY);
    LAS bf16* vn = (LAS bf16*)(F.lds);
    const int h = F.wave, c = F.tid;
    for (int ch = blockIdx.x; ch < M / 128; ch += F.G) {
        __syncthreads();
        const float gs = F.g_sgu[h * 64 + F.lane];
        for (int s = 0; s < 128; ++s) { const size_t m = (size_t)ch * 128 + s; const float val = bf2f(VS[m * DH + c]); const float q = wave_sum(val * val);
            vn[s * DH + c] = (bf16)f2bf(val * (1.f / sqrtf(q * (1.f / 64.f) + EPS)) * gs); }
        __syncthreads();
        for (int t = 0; t < 128; ++t) { float z = F.b_sp[h * 128 + t]; const bf16* wrow = WSM + ((size_t)h * 128 + t) * 128;
            for (int s = 0; s <= t; ++s) z += bf2f(wrow[s]) * bf2f(vn[s * DH + c]);
            const size_t m = (size_t)ch * 128 + t; const float y = bf2f(U[m * DH + c]) * z;
            Y[m * D + DH + c] = (bf16)f2bf(y); const float q = wave_sum(y * y); if (F.lane == 0) SSQY[m * 16 + h] = q; }
    }
    __syncthreads();
}
__device__ __forceinline__ void p3_sgu(Frame& F) {
    typedef short s16x4_t __attribute__((ext_vector_type(4))); typedef float f32x16_t __attribute__((ext_vector_type(16)));
    const bf16* U = (const bf16*)(F.ws + WS_U); const bf16* VS = U + (size_t)M * DH; const bf16* WSM = (const bf16*)(F.ws + WS_WSM);
    bf16* Y = (bf16*)(F.ws + WS_Y); float* SSQY = (float*)(F.ws + WS_SSQY);
    constexpr int RS = 144;
    const int h = F.wave, lane = F.lane, c8 = lane & 7, kg = lane >> 5, t32 = lane & 31;
    LAS unsigned char* vreg = F.lds + h * (128 * RS);
    LAS float* bsl = (LAS float*)(F.lds + 8 * 128 * RS) + h * 128;
    float gsc[8];
#pragma unroll
    for (int e = 0; e < 8; ++e) gsc[e] = F.g_sgu[h * 64 + c8 * 8 + e];
    const int trb = (8 * (lane >> 5) + ((lane & 15) >> 2)) * RS + (16 * ((lane >> 4) & 1) + 4 * (lane & 3)) * 2;
    for (int ch = blockIdx.x; ch < M / 128; ch += F.G) {
        const size_t row0 = (size_t)ch * 128;
        asm volatile("s_waitcnt lgkmcnt(0)" ::: "memory");
        uint4 pre[16];
#pragma unroll
        for (int it = 0; it < 16; ++it) pre[it] = *(const uint4*)(VS + (row0 + it * 8 + (lane >> 3)) * DH + h * 64 + c8 * 8);
#pragma unroll
        for (int it = 0; it < 16; ++it) { const int r = it * 8 + (lane >> 3); const uint4 w = pre[it]; const unsigned ww[4] = {w.x, w.y, w.z, w.w};
            float v[8]; float q = 0.f;
#pragma unroll
            for (int e = 0; e < 4; ++e) { v[2 * e] = __uint_as_float(ww[e] << 16); v[2 * e + 1] = __uint_as_float(ww[e] & 0xffff0000u); q += v[2 * e] * v[2 * e] + v[2 * e + 1] * v[2 * e + 1]; }
            q = DPP_ADD(q, 0xB1); q = DPP_ADD(q, 0x4E); q = DPP_ADD(q, 0x141);
            const float rstd = 1.f / sqrtf(q * (1.f / 64.f) + EPS);
            v4u o; o.x = pk2(v[0] * rstd * gsc[0], v[1] * rstd * gsc[1]); o.y = pk2(v[2] * rstd * gsc[2], v[3] * rstd * gsc[3]); o.z = pk2(v[4] * rstd * gsc[4], v[5] * rstd * gsc[5]); o.w = pk2(v[6] * rstd * gsc[6], v[7] * rstd * gsc[7]);
            *(LAS v4u*)(vreg + r * RS + c8 * 16) = o; }
        bsl[lane] = F.b_sp[h * 128 + lane]; bsl[lane + 64] = F.b_sp[h * 128 + 64 + lane];
        asm volatile("s_waitcnt lgkmcnt(0)" ::: "memory");
        f32x16_t acc[4][2];
#pragma unroll
        for (int tb = 0; tb < 4; ++tb) { acc[tb][0] = f32x16_t{}; acc[tb][1] = f32x16_t{}; }
#pragma unroll
        for (int tb = 0; tb < 4; ++tb)
#pragma unroll
            for (int ks = 0; ks < 2 * tb + 2; ++ks) {
                const bf16x8 a = *(const bf16x8*)(WSM + ((size_t)(h * 128 + 32 * tb + t32)) * 128 + 16 * ks + 8 * kg);
#pragma unroll
                for (int db = 0; db < 2; ++db) {
                    const s16x4_t lo = __builtin_bit_cast(s16x4_t, __builtin_amdgcn_ds_read_tr16_b64_v4i16((LAS s16x4_t*)(vreg + trb + (16 * ks) * RS + db * 64)));
                    const s16x4_t hi = __builtin_bit_cast(s16x4_t, __builtin_amdgcn_ds_read_tr16_b64_v4i16((LAS s16x4_t*)(vreg + trb + (16 * ks + 4) * RS + db * 64)));
                    const bf16x8 bfr = {lo[0], lo[1], lo[2], lo[3], hi[0], hi[1], hi[2], hi[3]};
                    acc[tb][db] = __builtin_amdgcn_mfma_f32_32x32x16_bf16(a, bfr, acc[tb][db], 0, 0, 0); } }
        asm volatile("s_waitcnt lgkmcnt(0)" ::: "memory");
#pragma unroll
        for (int tb = 0; tb < 4; ++tb)
#pragma unroll
            for (int db = 0; db < 2; ++db)
#pragma unroll
                for (int r = 0; r < 16; ++r) { const int t = 32 * tb + (r & 3) + 8 * (r >> 2) + 4 * kg;
                    *(LAS unsigned short*)(vreg + t * RS + (32 * db + t32) * 2) = (unsigned short)f2bf(acc[tb][db][r] + bsl[t]); }
        asm volatile("s_waitcnt lgkmcnt(0)" ::: "memory");
#pragma unroll
        for (int it = 0; it < 16; ++it) pre[it] = *(const uint4*)(U + (row0 + it * 8 + (lane >> 3)) * DH + h * 64 + c8 * 8);
#pragma unroll
        for (int it = 0; it < 16; ++it) { const int r = it * 8 + (lane >> 3); const v4u zz = *(const LAS v4u*)(vreg + r * RS + c8 * 16); const uint4 uu = pre[it];
            const unsigned zw[4] = {zz.x, zz.y, zz.z, zz.w}, uw[4] = {uu.x, uu.y, uu.z, uu.w}; unsigned ow[4]; float q = 0.f;
#pragma unroll
            for (int e = 0; e < 4; ++e) { const float y0 = __uint_as_float(zw[e] << 16) * __uint_as_float(uw[e] << 16), y1 = __uint_as_float(zw[e] & 0xffff0000u) * __uint_as_float(uw[e] & 0xffff0000u);
                q += y0 * y0 + y1 * y1; ow[e] = pk2(y0, y1); }
            q = DPP_ADD(q, 0xB1); q = DPP_ADD(q, 0x4E); q = DPP_ADD(q, 0x141);
            v4u o; o.x = ow[0]; o.y = ow[1]; o.z = ow[2]; o.w = ow[3];
            *(v4u*)(Y + (row0 + r) * D + DH + h * 64 + c8 * 8) = o;
            if (c8 == 0) SSQY[(row0 + r) * 16 + h] = q; }
    }
    asm volatile("s_waitcnt lgkmcnt(0)" ::: "memory");
    __syncthreads();
}
__device__ __forceinline__ void p3_attn_naive(Frame& F) {
    const bf16* Q = (const bf16*)(F.ws + WS_U) + (size_t)2 * M * DH; const bf16* K = Q + (size_t)M * DH; const bf16* V = K + (size_t)M * DH;
    const float* LC = (const float*)(F.ws + WS_LC); const float* CT = (const float*)(F.ws + WS_CT);
    bf16* Y = (bf16*)(F.ws + WS_Y); float* SSQY = (float*)(F.ws + WS_SSQY);
    LAS float* Gabs = (LAS float*)(F.lds);
    LAS float* pre = Gabs + T;
    for (int item = blockIdx.x; item < BATCH * NH * 8; item += F.G) {
        const int bh = item >> 3, r = item & 7, b = bh / NH, h = bh % NH;
        __syncthreads();
        if (F.tid < 64) { float a = 0.f; for (int c2 = 0; c2 < F.tid; ++c2) a += CT[bh * 64 + c2]; pre[F.tid] = a; }
        __syncthreads();
        for (int t = F.tid; t < T; t += NWAVES * 64) Gabs[t] = pre[t >> 7] + LC[(size_t)bh * T + t];
        __syncthreads();
        for (int n = F.wave; n < T / 8; n += NWAVES) {
            const int i = 8 * n + r; const size_t rowi = (size_t)b * T + i;
            float qf[64];
            { const uint4* q4 = (const uint4*)(Q + rowi * DH + h * HD);
#pragma unroll
              for (int c4 = 0; c4 < 8; ++c4) { const uint4 w = q4[c4]; const unsigned ww[4] = {w.x, w.y, w.z, w.w};
#pragma unroll
                  for (int e = 0; e < 4; ++e) { qf[c4 * 8 + 2 * e] = __uint_as_float(ww[e] << 16); qf[c4 * 8 + 2 * e + 1] = __uint_as_float(ww[e] & 0xffff0000u); } } }
            const float Gi = Gabs[i];
            float mx = -1e30f, l = 0.f; float o[64];
#pragma unroll
            for (int d = 0; d < 64; ++d) o[d] = 0.f;
            for (int j = F.lane; j <= i; j += 64) {
                const size_t rowj = (size_t)b * T + j; const uint4* k4 = (const uint4*)(K + rowj * DH + h * HD); const uint4* v4 = (const uint4*)(V + rowj * DH + h * HD);
                float s = 0.f;
#pragma unroll
                for (int c4 = 0; c4 < 8; ++c4) { const uint4 w = k4[c4]; const unsigned ww[4] = {w.x, w.y, w.z, w.w};
#pragma unroll
                    for (int e = 0; e < 4; ++e) { s += qf[c4 * 8 + 2 * e] * __uint_as_float(ww[e] << 16); s += qf[c4 * 8 + 2 * e + 1] * __uint_as_float(ww[e] & 0xffff0000u); } }
                s += Gabs[j] - Gi;
                if (s > mx) { const float f = __builtin_amdgcn_exp2f(mx - s); l *= f;
#pragma unroll
                    for (int d = 0; d < 64; ++d) o[d] *= f;
                    mx = s; }
                const float p = __builtin_amdgcn_exp2f(s - mx); l += p;
#pragma unroll
                for (int c4 = 0; c4 < 8; ++c4) { const uint4 w = v4[c4]; const unsigned ww[4] = {w.x, w.y, w.z, w.w};
#pragma unroll
                    for (int e = 0; e < 4; ++e) { o[c4 * 8 + 2 * e] += p * __uint_as_float(ww[e] << 16); o[c4 * 8 + 2 * e + 1] += p * __uint_as_float(ww[e] & 0xffff0000u); } }
            }
            const float Mx = wave_max(mx); const float f = __builtin_amdgcn_exp2f(mx - Mx); l *= f; const float L = wave_sum(l);
            float y = 0.f;
#pragma unroll
            for (int d = 0; d < 64; ++d) { const float od = wave_sum(o[d] * f); y = (F.lane == d) ? od : y; }
            y = y / L;
            Y[rowi * D + h * HD + F.lane] = (bf16)f2bf(y);
            const float q = wave_sum(y * y); if (F.lane == 0) SSQY[rowi * 16 + 8 + h] = q;
        }
    }
    __syncthreads();
}
__device__ __forceinline__ void p2_kx(Frame& F) {
    const float* LC = (const float*)(F.ws + WS_LC); const float* CT = (const float*)(F.ws + WS_CT);
    unsigned long long* KX8 = (unsigned long long*)(F.ws + WS_KX8); float* GF = (float*)(F.ws + WS_GF);
    const int gw = F.vcu * NWAVES + F.wave, NGW = F.G * NWAVES;
    for (int pr = gw; pr < BATCH * NH * (T / 128); pr += NGW) { const int bh = pr >> 6, ch = pr & 63;
        const float base = wave_sum(F.lane < ch ? CT[bh * 64 + F.lane] : 0.f);
#pragma unroll
        for (int e = 0; e < 2; ++e) { const size_t t = (size_t)bh * T + ch * 128 + e * 64 + F.lane; const float G = base + LC[t];
            const unsigned gh = f2bf(G); const float r1 = G - __uint_as_float(gh << 16); const unsigned gm = f2bf(r1); const float r2 = r1 - __uint_as_float(gm << 16); const unsigned gl = f2bf(r2);
            KX8[t] = (unsigned long long)(gh | (gm << 16)) | ((unsigned long long)(gl | (0x3F80u << 16)) << 32); GF[t] = G; } }
}
__device__ __forceinline__ void p6_load(Frame& F, f32x4 (&xv)[2][4], uint2 (&mv)[2][4], const bf16* MIX, int mrow) {
#pragma unroll
    for (int rr = 0; rr < 2; ++rr) { const size_t m = (size_t)mrow + rr; const f32x4* xr = (const f32x4*)(F.x + m * D) + F.lane; const uint2* mr = (const uint2*)(MIX + m * D) + F.lane;
#pragma unroll
        for (int j = 0; j < 4; ++j) { xv[rr][j] = xr[64 * j]; mv[rr][j] = mr[64 * j]; } }
}
__device__ __forceinline__ void p6_rows(Frame& F, f32x4 (&xv)[2][4], uint2 (&mv)[2][4], int m0, int r0, int RPW, const f32x4 (&cg1)[4], const f32x4 (&cA)[4], const f32x4 (&cB)[4],
                                        const LAS float* wrg, const LAS float* wre, LAS unsigned* lcnt, LAS unsigned* rinfo, bf16* H2, bf16* X1, float* TW) {
#pragma unroll
        for (int rr = 0; rr < 2; ++rr) { const int m = m0 + r0 + rr; float s = 0.f;
#pragma unroll
            for (int j = 0; j < 4; ++j) { f32x4 mx; mx[0] = __uint_as_float(mv[rr][j].x << 16); mx[1] = __uint_as_float(mv[rr][j].x & 0xffff0000u); mx[2] = __uint_as_float(mv[rr][j].y << 16); mx[3] = __uint_as_float(mv[rr][j].y & 0xffff0000u);
                xv[rr][j] = xv[rr][j] + cg1[j] * mx;
                ((unsigned long long*)(X1 + (size_t)m * D) + F.lane)[64 * j] = (unsigned long long)pk2(xv[rr][j].x, xv[rr][j].y) | ((unsigned long long)pk2(xv[rr][j].z, xv[rr][j].w) << 32);
                s += (xv[rr][j].x * xv[rr][j].x + xv[rr][j].y * xv[rr][j].y) + (xv[rr][j].z * xv[rr][j].z + xv[rr][j].w * xv[rr][j].w); }
            const float rstd = 1.f / sqrtf(wave_sum(s) * (1.f / D) + EPS);
            float lg[4] = {0.f, 0.f, 0.f, 0.f};
#if MOE_FP8
            int* o4 = (int*)((unsigned char*)H2 + (size_t)m * D) + F.lane;
#else
            unsigned long long* o8 = (unsigned long long*)(H2 + (size_t)m * D) + F.lane;
#endif
#pragma unroll
            for (int j = 0; j < 4; ++j) { const int k0 = 4 * F.lane + 256 * j; xv[rr][j] = xv[rr][j] * rstd * cA[j] + cB[j];
#if MOE_FP8
                { int p = 0; p = __builtin_amdgcn_cvt_pk_fp8_f32(__builtin_amdgcn_fmed3f(xv[rr][j].x, -448.f, 448.f), __builtin_amdgcn_fmed3f(xv[rr][j].y, -448.f, 448.f), p, false);
                  p = __builtin_amdgcn_cvt_pk_fp8_f32(__builtin_amdgcn_fmed3f(xv[rr][j].z, -448.f, 448.f), __builtin_amdgcn_fmed3f(xv[rr][j].w, -448.f, 448.f), p, true); o4[64 * j] = p; }
#else
                o8[64 * j] = (unsigned long long)pk2(xv[rr][j].x, xv[rr][j].y) | ((unsigned long long)pk2(xv[rr][j].z, xv[rr][j].w) << 32);
#endif
#pragma unroll
                for (int q = 0; q < 4; ++q) { const f32x4 w = *(const LAS f32x4*)(wrg + q * D + k0); lg[q] += (xv[rr][j].x * w.x + xv[rr][j].y * w.y) + (xv[rr][j].z * w.z + xv[rr][j].w * w.w); } }
            wave_sum4_all(lg, F.lane);
#pragma unroll
            for (int q = 0; q < 4; ++q) lg[q] += F.b_rg[q];
            int gs = 0; float best = lg[0];
#pragma unroll
            for (int q = 1; q < 4; ++q) if (lg[q] > best) { best = lg[q]; gs = q; }
            float den = 0.f;
#pragma unroll
            for (int q = 0; q < 4; ++q) den += expf(lg[q] - best);
            const float psel = 1.f / den;
            gs = __builtin_amdgcn_readfirstlane(gs);
            float le[4] = {0.f, 0.f, 0.f, 0.f}; const LAS float* wg = wre + gs * 4 * D;
#pragma unroll
            for (int j = 0; j < 4; ++j) { const int k0 = 4 * F.lane + 256 * j;
#pragma unroll
                for (int q = 0; q < 4; ++q) { const f32x4 w = *(const LAS f32x4*)(wg + q * D + k0); le[q] += (xv[rr][j].x * w.x + xv[rr][j].y * w.y) + (xv[rr][j].z * w.z + xv[rr][j].w * w.w); } }
            wave_sum4_all(le, F.lane);
#pragma unroll
            for (int q = 0; q < 4; ++q) le[q] += F.b_re[gs * 4 + q];
            int i0 = 0; float v0 = le[0];
#pragma unroll
            for (int q = 1; q < 4; ++q) if (le[q] > v0) { v0 = le[q]; i0 = q; }
            int i1 = -1; float v1 = -INFINITY;
#pragma unroll
            for (int q = 0; q < 4; ++q) if (q != i0 && le[q] > v1) { v1 = le[q]; i1 = q; }
            const float e1 = expf(v1 - v0); const float w0 = psel / (1.f + e1), w1 = psel * e1 / (1.f + e1);
            const int ea = i0 < i1 ? i0 : i1, eb = i0 < i1 ? i1 : i0; const float wa = i0 < i1 ? w0 : w1, wb = i0 < i1 ? w1 : w0;
            const int pair = ea == 0 ? eb - 1 : (ea == 1 ? eb + 1 : 5); const int cls = gs * 6 + pair;
            if (F.lane == 0) { TW[(size_t)m * 2] = wa; TW[(size_t)m * 2 + 1] = wb;
                const unsigned lr = __hip_atomic_fetch_add(lcnt + cls, 1u, __ATOMIC_RELAXED, __HIP_MEMORY_SCOPE_WORKGROUP);
                rinfo[F.wave * RPW + r0 + rr] = (unsigned)cls | (lr << 8); }
        }
}
__device__ __forceinline__ void p6_route(Frame& F) {
    const float* ADA = (const float*)(F.ws + WS_ADA); const bf16* MIX = (const bf16*)(F.ws + WS_MIX);
    bf16* H2 = (bf16*)(F.ws + WS_H2); bf16* X1 = (bf16*)(F.ws + WS_X1); int* INV = (int*)(F.ws + WS_INV); float* TW = (float*)(F.ws + WS_TW);
    LAS float* wrg = (LAS float*)(F.lds);
    LAS float* wre = wrg + 4 * D;
    LAS unsigned* lcnt = (LAS unsigned*)(wre + 16 * D);
    LAS unsigned* rinfo = lcnt + 32;
    __syncthreads();
    if (F.tid < 32) lcnt[F.tid] = 0u;
    for (int i = F.tid; i < 4 * D; i += NWAVES * 64) wrg[(i & 3) * D + (i >> 2)] = F.w_rg[i];
    for (int i = F.tid; i < 16 * D; i += NWAVES * 64) { const int g = i / (4 * D), r = i % (4 * D); wre[g * 4 * D + (r & 3) * D + (r >> 2)] = F.w_re[i]; }
    __syncthreads();
    const int gw = F.vcu * NWAVES + F.wave, NGW = F.G * NWAVES; const int RPW = M / NGW;
    const int m0 = gw * RPW; const int b = m0 / T;
    f32x4 cg1[4], cA[4], cB[4];
#pragma unroll
    for (int j = 0; j < 4; ++j) { const int k0 = 4 * F.lane + 256 * j; cg1[j] = *(const f32x4*)(ADA + (size_t)b * NADA + 2 * D + k0);
        const f32x4 g = *(const f32x4*)(F.g_ffn + k0), sc = *(const f32x4*)(ADA + (size_t)b * NADA + 4 * D + k0); cA[j] = g * (1.f + sc); cB[j] = *(const f32x4*)(ADA + (size_t)b * NADA + 3 * D + k0); }
    { f32x4 xa[2][4], xb[2][4]; uint2 ma[2][4], mb[2][4];
        p6_load(F, xa, ma, MIX, m0);
#pragma unroll 1
        for (int r0 = 0; r0 < RPW; r0 += 4) {
            p6_load(F, xb, mb, MIX, m0 + r0 + 2);
            p6_rows(F, xa, ma, m0, r0, RPW, cg1, cA, cB, wrg, wre, lcnt, rinfo, H2, X1, TW);
            if (r0 + 4 < RPW) p6_load(F, xa, ma, MIX, m0 + r0 + 4);
            p6_rows(F, xb, mb, m0, r0 + 2, RPW, cg1, cA, cB, wrg, wre, lcnt, rinfo, H2, X1, TW);
        } }
    __syncthreads();
    if (F.tid < NCLS) { const unsigned n = lcnt[F.tid]; lcnt[F.tid] = n ? __hip_atomic_fetch_add((unsigned*)(F.ctl + CW_CNT + F.tid * CNT_STRIDE), n, __ATOMIC_RELAXED, __HIP_MEMORY_SCOPE_AGENT) : 0u; }
    __syncthreads();
    for (int i = F.tid; i < NWAVES * RPW; i += NWAVES * 64) { const unsigned ri = rinfo[i]; const int cls = (int)(ri & 255u);
        INV[(size_t)cls * M + lcnt[cls] + (ri >> 8)] = (F.vcu * NWAVES + i / RPW) * RPW + i % RPW; }
    __syncthreads();
}
__device__ __forceinline__ void moe_tables(Frame& F) {
    LAS unsigned* lcnt = (LAS unsigned*)(F.lds + LCNT_OFF);
    __syncthreads();
    if (F.tid < NCLS) lcnt[F.tid] = __hip_atomic_load(F.ctl + CW_CNT + F.tid * CNT_STRIDE, RLX_AGENT);
    __syncthreads();
    if (F.tid == 0) { LAS unsigned char* tcls = F.lds + TCLS_OFF; LAS unsigned char* tfirst = F.lds + TFIRST_OFF; int nt = 0;
        for (int c = 0; c < NCLS; ++c) { const int n = ((int)lcnt[c] + 255) >> 8; tfirst[c] = (unsigned char)nt; for (int k = 0; k < n && nt < MAXTILES; ++k) tcls[nt++] = (unsigned char)c; }
        F.MISC[16] = (unsigned)nt; }
    __syncthreads();
}
template <class Order> __device__ __forceinline__ void moe_fill_up(Frame& F, const Order& S) {
    const int* INV = (const int*)(F.ws + WS_INV); const float* TW = (const float*)(F.ws + WS_TW); LAS unsigned* toku = (LAS unsigned*)(F.lds + TOKU_OFF); LAS unsigned* tokw = (LAS unsigned*)(F.lds + TOKW_OFF);
    for (int i = 0; i < 5; ++i) { pg8::Unit u; if (!S.next(i, u)) break;
        if (F.tid < 256) { const int rank = u.rank0 + F.tid; int tok = 0; unsigned wp = 0u;
            if (rank < u.cnt) { tok = INV[(size_t)u.cls * M + rank]; wp = pk2(TW[(size_t)tok * 2], TW[(size_t)tok * 2 + 1]); }
            toku[i * 256 + F.tid] = (unsigned)tok * (unsigned)(D * MOE_ESZ); tokw[i * 256 + F.tid] = wp; } }
    __syncthreads();
}
template <class Order> __device__ __forceinline__ void moe_fill_down(Frame& F, const Order& S) {
    const int* INV = (const int*)(F.ws + WS_INV); LAS int* tokd = (LAS int*)(F.lds + TOKU_OFF);
    for (int i = 0; i < 5; ++i) { pg8::Unit u; if (!S.next(i, u)) break;
        if (F.tid < 256) { const int rank = u.rank0 + F.tid; tokd[i * 256 + F.tid] = rank < u.cnt ? INV[(size_t)u.cls * M + rank] : -1; } }
    __syncthreads();
}
__device__ __forceinline__ void p10_final(Frame& F) {
    const float* ADA = (const float*)(F.ws + WS_ADA); const bf16* X1 = (const bf16*)(F.ws + WS_X1); const bf16* MOE = (const bf16*)(F.ws + WS_MOE);
    const int gw = F.vcu * NWAVES + F.wave, NGW = F.G * NWAVES; const int RPW = M / NGW; const int m0 = gw * RPW; const int b = m0 / T;
    f32x4 cg2[4], cgf[4];
#pragma unroll
    for (int j = 0; j < 4; ++j) { const int k0 = 4 * F.lane + 256 * j; cg2[j] = *(const f32x4*)(ADA + (size_t)b * NADA + 5 * D + k0); cgf[j] = *(const f32x4*)(F.g_fin + k0); }
    for (int r0 = 0; r0 < RPW; r0 += 4) {
        uint2 mv[4][4], ev[4][4];
#pragma unroll
        for (int rr = 0; rr < 4; ++rr) { const size_t m = (size_t)m0 + r0 + rr; const uint2* mr = (const uint2*)(X1 + m * D) + F.lane; const uint2* er = (const uint2*)(MOE + m * D) + F.lane;
#pragma unroll
            for (int j = 0; j < 4; ++j) { mv[rr][j] = mr[64 * j]; ev[rr][j] = er[64 * j]; } }
#pragma unroll
        for (int rr = 0; rr < 4; ++rr) { const size_t m = (size_t)m0 + r0 + rr; float s = 0.f; f32x4 xv[4];
#pragma unroll
            for (int j = 0; j < 4; ++j) { f32x4 mx, ex; mx[0] = __uint_as_float(mv[rr][j].x << 16); mx[1] = __uint_as_float(mv[rr][j].x & 0xffff0000u); mx[2] = __uint_as_float(mv[rr][j].y << 16); mx[3] = __uint_as_float(mv[rr][j].y & 0xffff0000u);
                ex[0] = __uint_as_float(ev[rr][j].x << 16); ex[1] = __uint_as_float(ev[rr][j].x & 0xffff0000u); ex[2] = __uint_as_float(ev[rr][j].y << 16); ex[3] = __uint_as_float(ev[rr][j].y & 0xffff0000u);
                xv[j] = mx + cg2[j] * ex; s += (xv[j].x * xv[j].x + xv[j].y * xv[j].y) + (xv[j].z * xv[j].z + xv[j].w * xv[j].w); }
            const float rstd = 1.f / sqrtf(wave_sum(s) * (1.f / D) + EPS);
            f32x4* orow = (f32x4*)(F.out + m * D) + F.lane;
#pragma unroll
            for (int j = 0; j < 4; ++j) orow[64 * j] = xv[j] * rstd * cgf[j]; }
    }
}

#define REFRESH() do { F.lane = lane_id_fresh(); F.tid = F.wave * 64 + F.lane; } while (0)
struct Args { const float* in[22]; float* out; unsigned char* ws; int ph_lo, ph_hi; };
__global__ void __launch_bounds__(NWAVES * 64, 2) mk_fwd(Args args) {
    extern __shared__ __attribute__((aligned(16))) unsigned char lds[];
    Frame F;
    F.lds = (LAS unsigned char*)lds;
    F.MISC = (volatile LAS unsigned*)(F.lds + MISC_OFF);
    F.tid = threadIdx.x; F.lane = F.tid & 63; F.wave = __builtin_amdgcn_readfirstlane(F.tid >> 6);
    F.G = gridDim.x; { const int bx = blockIdx.x; F.vcu = (F.G % 8 == 0) ? (bx % 8) * (F.G / 8) + bx / 8 : bx; }
    F.ws = args.ws; F.ctl = (gu32*)(args.ws + WS_CTL); F.out = args.out;
    F.x = args.in[0]; F.c = args.in[1]; F.w_ada = args.in[2]; F.b_ada = args.in[3]; F.g_mix = args.in[4]; F.w_in = args.in[5]; F.g_sgu = args.in[6]; F.w_sp = args.in[7]; F.b_sp = args.in[8]; F.b_fg = args.in[9];
    F.g_osgu = args.in[10]; F.g_ofox = args.in[11]; F.w_out = args.in[12]; F.g_ffn = args.in[13]; F.w_rg = args.in[14]; F.b_rg = args.in[15]; F.w_re = args.in[16]; F.b_re = args.in[17];
    F.w_gate = args.in[18]; F.w_up = args.in[19]; F.w_down = args.in[20]; F.g_fin = args.in[21];
    for (int u = F.tid; u < (LDS_BYTES - LDSCTL_OFF) / 4; u += NWAVES * 64) ((LAS unsigned*)(F.lds + LDSCTL_OFF))[u] = 0u;
    __syncthreads();
    XcdBarrier bar; bar.bar = (unsigned*)(F.ctl + CW_BAR); bar.x = 0; bar.st = nullptr;
    if (N_LAUNCHES == 1) bar = xcd_barrier_post((unsigned*)(F.ctl + CW_BAR), F.MISC + 8);
#define GRID_BAR() do { if (N_LAUNCHES == 1) xcd_barrier(bar); } while (0)
#if PROBE_MASK
#define PROBE_BEGIN(k) do { if (((PROBE_MASK) >> (k)) & 1) { if (blockIdx.x == 0 && F.tid == 0) F.MISC[22] = (unsigned)rt(); } } while (0)
#define PROBE_END(k) do { if (((PROBE_MASK) >> (k)) & 1) { if (blockIdx.x == 0 && F.tid == 0) F.MISC[20] = F.MISC[20] + ((unsigned)rt() - F.MISC[22]); } } while (0)
#else
#define PROBE_BEGIN(k) do {} while (0)
#define PROBE_END(k) do {} while (0)
#endif
    const int lo = args.ph_lo, hi = args.ph_hi;
#define IN(k) (lo <= (k) && (k) < hi)
#define BOTH(k) (IN(k) && IN((k) + 1))
    bf16* const XN = (bf16*)(F.ws + WS_XN); bf16* const U = (bf16*)(F.ws + WS_U); bf16* const Y = (bf16*)(F.ws + WS_Y);
    float* const ADA = (float*)(F.ws + WS_ADA);

    if (IN(0)) { PROBE_BEGIN(0); p0_prologue(F); if (BOTH(0)) GRID_BAR(); PROBE_END(0); }
    if (IN(1)) { REFRESH(); PROBE_BEGIN(1); p1_prenorm(F); if (BOTH(1)) GRID_BAR(); PROBE_END(1); }
    if (IN(2)) { REFRESH(); PROBE_BEGIN(2);
        p2_kx(F);
        pg8::Gemm g{XN, (const bf16*)(F.ws + WS_WIN), D, D, D, 127, 127}; pg8::StaticOrder S; S.init(M, NPROJ, D, D, F.G, (int)blockIdx.x);
        pg8::EpiProj E{U, (unsigned*)(F.ctl + CW_QKB)};
        pg8::gemm_phase<pg8::EpiProj, pg8::StaticOrder, true, true>(F.lds + RING_OFF, g, S, E, F.tid);
        if (BOTH(2)) GRID_BAR(); PROBE_END(2);
    }
    if (IN(3)) { REFRESH(); PROBE_BEGIN(3);
        PROBE_BEGIN(4);
#if NAIVE_SGU
        p3_sgu_naive(F);
#else
        p3_sgu(F);
#endif
        PROBE_END(4);
#if NAIVE_ATTN
        p3_attn_naive(F);
#else
        static_assert(attn_body::LDS_BYTES <= RING_BYTES, "attention LDS map");
        { const attn_body::bf16* Qp = (const attn_body::bf16*)(F.ws + WS_U) + (size_t)2 * M * DH;
          const attn_body::AttnTensors AT{Qp, Qp + (size_t)M * DH, Qp + (size_t)2 * M * DH, (attn_body::bf16*)(F.ws + WS_Y), (const unsigned long long*)(F.ws + WS_KX8), (const float*)(F.ws + WS_GF), (const float*)(F.ctl + CW_QKB), (float*)(F.ws + WS_SSQY)};
          const attn_body::StaticOrder S((int)F.G, (int)blockIdx.x);
          attn_body::AttnUnit u;
          for (int i = 0; S.next(i, u); ++i) {
              if (i == ((F.vcu >> 1) & 3)) p3_convert(F);
              attn_body::attn_unit<8>(u.bh / attn_body::NHEAD, u.bh % attn_body::NHEAD, u.qb, AT.Q, AT.K, AT.V, AT.O, AT.KX8, AT.GF, AT.QKB, AT.SSQ, (char*)lds + RING_OFF, F.tid); } }
#endif
        if (IN(3) && IN(5)) GRID_BAR(); PROBE_END(3); }
    if (IN(5)) { REFRESH(); PROBE_BEGIN(5);
        pg8::Gemm g{Y, (const bf16*)(F.ws + WS_WOUT), D, D, D, 127, 127}; pg8::StaticOrder S; S.init(M, D, D, D, F.G, (int)blockIdx.x);
        { const float* SSQY = (const float*)(F.ws + WS_SSQY); LAS float* rsr = (LAS float*)(F.lds + TOKU_OFF);
          __syncthreads();
          for (int i = 0; i < 4; ++i) { pg8::Unit u; if (!S.next(i, u)) break;
              if (F.tid < 256) { const f32x4* p = (const f32x4*)(SSQY + (size_t)(u.pm * 256 + F.tid) * 16); const f32x4 s0 = p[0], s1 = p[1], f0 = p[2], f1 = p[3];
                  const float a = ((s0[0] + s0[1]) + (s0[2] + s0[3])) + ((s1[0] + s1[1]) + (s1[2] + s1[3])), c = ((f0[0] + f0[1]) + (f0[2] + f0[3])) + ((f1[0] + f1[1]) + (f1[2] + f1[3]));
                  const float rs = 1.f / sqrtf(a * (1.f / 512.f) + EPS), rf = 1.f / sqrtf(c * (1.f / 512.f) + EPS); rsr[(i * 256 + F.tid) * 2] = rs; rsr[(i * 256 + F.tid) * 2 + 1] = rf / rs; } }
          __syncthreads(); }
        pg8::EpiMix E{(bf16*)(F.ws + WS_MIX), (const LAS float*)(F.lds + TOKU_OFF)};
        pg8::gemm_phase<pg8::EpiMix, pg8::StaticOrder, true, true>(F.lds + RING_OFF, g, S, E, F.tid);
        if (BOTH(5)) GRID_BAR(); PROBE_END(5);
    }
    if (IN(6)) { REFRESH(); PROBE_BEGIN(6); p6_route(F); if (IN(6) && IN(8)) GRID_BAR(); PROBE_END(6); }
    if (IN(8)) { REFRESH(); PROBE_BEGIN(8);
        moe_tables(F);
        pg8::Gemm g{(const bf16*)(F.ws + WS_H2), (const bf16*)(F.ws + WS_WGU), D * MOE_ESZ / 2, D * MOE_ESZ / 2, D * MOE_ESZ / 2, 127, 121};
        pg8::MoeUpOrder S{F.G, (int)blockIdx.x, (int)F.MISC[16], F.lds + TCLS_OFF, F.lds + TFIRST_OFF, (const LAS unsigned*)(F.lds + LCNT_OFF), (const LAS unsigned*)(F.lds + TOKU_OFF)};
        moe_fill_up(F, S);
        pg8::EpiUp E{(bf16*)(F.ws + WS_ACT), (const LAS unsigned*)(F.lds + TOKW_OFF)};
        pg8::gemm_phase<pg8::EpiUp, pg8::MoeUpOrder, true, true, MOE_FP8 != 0>(F.lds + RING_OFF, g, S, E, F.tid);
        if (BOTH(8)) GRID_BAR(); PROBE_END(8);
    }
    if (IN(9)) { REFRESH(); PROBE_BEGIN(9);
        if (!IN(8)) moe_tables(F);
        pg8::Gemm g{(const bf16*)(F.ws + WS_ACT), (const bf16*)(F.ws + WS_WD), D * MOE_ESZ / 2, DEXP * MOE_ESZ / 2, D * MOE_ESZ / 2, 125, 121};
        pg8::MoeDownOrder S{F.G, (int)blockIdx.x, (int)F.MISC[16], F.lds + TCLS_OFF, F.lds + TFIRST_OFF, (const LAS unsigned*)(F.lds + LCNT_OFF)};
        moe_fill_down(F, S);
        pg8::EpiDown E{(bf16*)(F.ws + WS_MOE), (const LAS int*)(F.lds + TOKU_OFF)};
        pg8::gemm_phase<pg8::EpiDown, pg8::MoeDownOrder, true, true, MOE_FP8 != 0>(F.lds + RING_OFF, g, S, E, F.tid);
        if (BOTH(9)) GRID_BAR(); PROBE_END(9);
    }
    if (IN(10)) { REFRESH(); PROBE_BEGIN(10); p10_final(F); PROBE_END(10); }
#if PROBE_MASK
    if (blockIdx.x == 0 && F.tid == 0) { const unsigned long long t0 = rt(); const unsigned long long w = (unsigned long long)F.MISC[20] * (PROBE_MULT); while (rt() - t0 < w) __builtin_amdgcn_s_sleep(32); }
#endif
#undef IN
#undef BOTH
}

extern "C" void kernel_launch(void* const* d_in, const int* in_sizes, int n_in, void* d_out, int out_size, void* d_ws, size_t ws_size, hipStream_t stream) {
    static int grid = 0;
    if (grid == 0) {
        if (n_in != 22 || in_sizes[0] != M * D || out_size != M * D || ws_size < WS_END) { fprintf(stderr, "kernel_launch: unexpected shapes (n_in %d, in0 %d, out %d, ws %zu); nothing launched\n", n_in, n_in > 0 ? in_sizes[0] : -1, out_size, ws_size); grid = -1; return; }
        int dev = 0, cus = 0, per_cu = 0;
        if (hipGetDevice(&dev) != hipSuccess || hipDeviceGetAttribute(&cus, hipDeviceAttributeMultiprocessorCount, dev) != hipSuccess) { fprintf(stderr, "kernel_launch: device query failed\n"); grid = -1; return; }
        if (hipFuncSetAttribute((const void*)mk_fwd, hipFuncAttributeMaxDynamicSharedMemorySize, LDS_BYTES) != hipSuccess) { fprintf(stderr, "kernel_launch: hipFuncSetAttribute failed\n"); grid = -1; return; }
        if (hipOccupancyMaxActiveBlocksPerMultiprocessor(&per_cu, (const void*)mk_fwd, NWAVES * 64, LDS_BYTES) != hipSuccess || per_cu < 1) { fprintf(stderr, "kernel_launch: occupancy query reports %d workgroups per CU\n", per_cu); (void)hipGetLastError(); grid = -1; return; }
        grid = cus;
        if (grid != 256) { fprintf(stderr, "kernel_launch: built for a 256-CU device (static unit orders), found %d CUs; nothing launched\n", cus); grid = -1; return; }
    }
    if (grid < 0) return;
    if (hipMemsetAsync((char*)d_ws + WS_CTL, 0, CTL_ZERO_BYTES, stream) != hipSuccess) { fprintf(stderr, "kernel_launch: hipMemsetAsync failed\n"); return; }
    Args a{};
    for (int i = 0; i < 22; ++i) a.in[i] = (const float*)d_in[i];
    a.out = (float*)d_out; a.ws = (unsigned char*)d_ws;
    if (N_LAUNCHES == 1) {
        a.ph_lo = 0; a.ph_hi = N_PHASES;
        void* kargs[] = {&a};
        const hipError_t le = hipLaunchCooperativeKernel((const void*)mk_fwd, dim3(grid), dim3(NWAVES * 64), kargs, LDS_BYTES, stream);
        if (le != hipSuccess) fprintf(stderr, "kernel_launch: cooperative launch failed: %s (grid %d)\n", hipGetErrorName(le), grid);
    } else {
        for (int li = 0; li < N_PHASES; ++li) { a.ph_lo = li; a.ph_hi = li + 1;
            hipLaunchKernelGGL(mk_fwd, dim3(grid), dim3(NWAVES * 64), LDS_BYTES, stream, a);
            const hipError_t le = hipPeekAtLastError();
            if (le != hipSuccess) { fprintf(stderr, "kernel_launch: launch %d failed: %s\n", li, hipGetErrorName(le)); break; } }
    }
}
```

```cpp
#include <hip/hip_runtime.h>
#include <hip/hip_bf16.h>
#include <cstdio>
#include <cstdint>
#include <cmath>

#ifndef MK_N_LAUNCHES
#define MK_N_LAUNCHES 1
#endif
#ifndef PROBE_MASK
#define PROBE_MASK 0
#endif
#ifndef PROBE_MULT
#define PROBE_MULT 4
#endif
#ifndef MOE_FP8
#define MOE_FP8 1
#endif
#define MOE_ESZ (MOE_FP8 ? 1 : 2)
#ifndef NAIVE_SGU
#define NAIVE_SGU 0
#endif
#ifndef NAIVE_ATTN
#define NAIVE_ATTN 0
#endif

constexpr int BATCH = 4, T = 8192, D = 1024, NH = 8, HD = 64, DH = 512;
constexpr int M = BATCH * T;
constexpr int NPROJ = 2560;
constexpr int LDW_IN = 2568;
constexpr int NADA = 6 * D;
constexpr int NEXP = 16, DEXP = 512, NCLS = 24;
constexpr int MAXTILES = 152;
constexpr float EPS = 1e-6f;
constexpr float C2 = 0.125f * 1.4426950408889634f;
constexpr float LOG2E = 1.4426950408889634f;

namespace pg8 {
#define PG8_LAS __attribute__((address_space(3)))
typedef unsigned short bf16_t;
typedef short bf16x8 __attribute__((ext_vector_type(8)));
typedef float f32x4 __attribute__((ext_vector_type(4)));
typedef unsigned u32x4 __attribute__((ext_vector_type(4)));
constexpr int BM = 256, BK = 64, HALF = 128, HTB = HALF * BK * 2  , STAGE_BYTES = 8 * HTB, NXCD = 8, WGM = 8;

__host__ __device__ __forceinline__ int lds_byte(int r, int c) { const int st = (r >> 4) * 2 + (c >> 5), rr = r & 15, cc = c & 31, ob = rr * 64 + cc * 2; return st * 1024 + (ob ^ (((ob >> 9) & 1) << 5)); }
__host__ __device__ __forceinline__ void stage_rc(int b, int& R, int& C) { const int st = b / 1024, sb = b % 1024, swz = sb ^ (((sb >> 9) & 1) << 5); R = (st >> 1) * 16 + swz / 64; C = (st & 1) * 32 + (swz % 64) / 2; }
__host__ __device__ __forceinline__ int perm32(int rho) { const int n = rho >> 4, i = rho & 15; return 8 * (i >> 2) + 4 * n + (i & 3); }

struct Unit { int pm, pn, aux; long aoff, boff, dboff; int cls, rank0, cnt, ord; };
struct Gemm { const bf16_t* A; const bf16_t* Bt; int lda, ldb, K; int scA, scB; };

struct StaticOrder {
    static constexpr bool GATHER = false;
    int nM, nN, nwg, G, c; long ta, tb;
    __host__ __device__ void init(int M, int N, int lda, int ldb, int G_, int c_) { nM = M / BM; nN = N / BM; nwg = nM * nN; G = G_; c = c_; ta = (long)BM * lda * 2; tb = (long)BM * ldb * 2; }
    __host__ __device__ bool next(int i, Unit& u) const {
        const long L = (long)i * G + c; if (L >= nwg) return false;
        int wgid = (int)L; { const int q = nwg / NXCD, r = nwg % NXCD, xcd = wgid % NXCD, off = wgid / NXCD; wgid = (xcd < r ? xcd * (q + 1) : r * (q + 1) + (xcd - r) * q) + off; }
        const int nig = WGM * nN, gid = wgid / nig, fm = gid * WGM, gsz = (nM - fm) < WGM ? (nM - fm) : WGM;
        u.pm = fm + ((wgid % nig) % gsz); u.pn = (wgid % nig) / gsz; u.aux = 0; u.aoff = u.pm * ta; u.boff = u.pn * tb; u.dboff = 0; u.cls = 0; u.rank0 = 0; u.cnt = 0; u.ord = i; return true;
    }
    __device__ __forceinline__ void a_ready(const Unit&) const {}
    __device__ __forceinline__ void done(const Unit&) const {}
};


__device__ __forceinline__ unsigned cvt_pk_bf16(float lo, float hi) { unsigned r; asm volatile("v_cvt_pk_bf16_f32 %0, %1, %2" : "=v"(r) : "v"(lo), "v"(hi)); return r; }
__device__ __forceinline__ float gelu_tanh(float v) {
    const float u = v * (1.5957691216057308f + 0.0713548162726f * v * v);
    return v * __builtin_amdgcn_rcpf(1.0f + __builtin_amdgcn_exp2f(-1.4426950408889634f * u));
}
__device__ __forceinline__ float silu_f(float v) { return v * __builtin_amdgcn_rcpf(1.0f + __builtin_amdgcn_exp2f(-1.4426950408889634f * v)); }

struct NoState {};
#define PG8_DPP_MAX(v, ctrl) fmaxf((v), __builtin_bit_cast(float, __builtin_amdgcn_update_dpp(0, __builtin_bit_cast(int, (v)), (ctrl), 0xf, 0xf, false)))
__device__ __forceinline__ float wave_max_nonneg(float v) {
    v = PG8_DPP_MAX(v, 0xB1); v = PG8_DPP_MAX(v, 0x4E); v = PG8_DPP_MAX(v, 0x141); v = PG8_DPP_MAX(v, 0x140);
    const int iv = __builtin_bit_cast(int, v);
    return fmaxf(fmaxf(__builtin_bit_cast(float, __builtin_amdgcn_readlane(iv, 0)), __builtin_bit_cast(float, __builtin_amdgcn_readlane(iv, 16))), fmaxf(__builtin_bit_cast(float, __builtin_amdgcn_readlane(iv, 32)), __builtin_bit_cast(float, __builtin_amdgcn_readlane(iv, 48))));
}
struct EpiProj {
    static constexpr bool PERM = true, AFTER_DRAIN = false, MID = false; typedef NoState State;
    bf16_t* O; unsigned* qkb;
    __device__ __forceinline__ void operator()(const f32x4 (&acc)[2][2][4][2], const State&, const Unit& u, int wr, int wc, int fr, int fq) const {
        const int row0 = u.pm * BM + wr * 64 + fr; const int seg = u.pn >> 1; float nmx[2] = {0.f, 0.f};
        bf16_t* base = O + (size_t)seg * ((size_t)M * 512);
        const int col0 = (u.pn & 1) * 256 + wc * 32 + 8 * fq;
#pragma unroll
        for (int ai = 0; ai < 2; ++ai)
#pragma unroll
            for (int m = 0; m < 4; ++m) { bf16_t* rowp = base + (size_t)(row0 + ai * HALF + m * 16) * 512 + col0;
#pragma unroll
                for (int bj = 0; bj < 2; ++bj) { f32x4 v0 = acc[ai][bj][m][0], v1 = acc[ai][bj][m][1];
                    if (seg < 2) {
#pragma unroll
                        for (int j = 0; j < 4; ++j) { v0[j] = gelu_tanh(v0[j]); v1[j] = gelu_tanh(v1[j]); }
                    } else if (seg == 2) { v0 = v0 * C2; v1 = v1 * C2; }
                    if (seg == 2 || seg == 3) { float s8 = ((v0[0] * v0[0] + v0[1] * v0[1]) + (v0[2] * v0[2] + v0[3] * v0[3])) + ((v1[0] * v1[0] + v1[1] * v1[1]) + (v1[2] * v1[2] + v1[3] * v1[3]));
                        { const auto r16 = __builtin_amdgcn_permlane16_swap(__float_as_uint(s8), __float_as_uint(s8), false, false); s8 = __uint_as_float(r16[0]) + __uint_as_float(r16[1]);
                          const auto r32 = __builtin_amdgcn_permlane32_swap(__float_as_uint(s8), __float_as_uint(s8), false, false); s8 = __uint_as_float(r32[0]) + __uint_as_float(r32[1]); }
                        nmx[bj] = fmaxf(nmx[bj], s8); }
                    u32x4 w; w.x = cvt_pk_bf16(v0[0], v0[1]); w.y = cvt_pk_bf16(v0[2], v0[3]); w.z = cvt_pk_bf16(v1[0], v1[1]); w.w = cvt_pk_bf16(v1[2], v1[3]);
                    *(u32x4*)(rowp + bj * HALF) = w; } }
        if (seg == 2 || seg == 3) {
#pragma unroll
            for (int bj = 0; bj < 2; ++bj) { const float wm = wave_max_nonneg(nmx[bj]); const int bh = (u.pm >> 5) * 8 + 4 * (u.pn & 1) + 2 * bj + (wc >> 1);
                if (fr == 0 && fq == 0) __hip_atomic_fetch_max(qkb + (seg == 3 ? bh * 16 + (u.pm & 15) : 512 + bh * 32 + (u.pm & 31)), __float_as_uint(wm), __ATOMIC_RELAXED, __HIP_MEMORY_SCOPE_AGENT); } }
    }
};
struct EpiMix {
    static constexpr bool PERM = true, AFTER_DRAIN = false, MID = true; struct State { float rs[2][4]; };
    bf16_t* O; const PG8_LAS float* rsr;
    __device__ __forceinline__ void mid(f32x4 (&acc)[2][2][4][2], State& st, const Unit& u, int wr, int fr) const {
#pragma unroll
        for (int ai = 0; ai < 2; ++ai)
#pragma unroll
            for (int m = 0; m < 4; ++m) { const int rl = ai * HALF + wr * 64 + m * 16 + fr; const float rs = rsr[(u.ord * BM + rl) * 2], ratio = rsr[(u.ord * BM + rl) * 2 + 1]; st.rs[ai][m] = rs;
#pragma unroll
                for (int bj = 0; bj < 2; ++bj)
#pragma unroll
                    for (int n = 0; n < 2; ++n) acc[ai][bj][m][n] = acc[ai][bj][m][n] * ratio; }
    }
    __device__ __forceinline__ void operator()(const f32x4 (&acc)[2][2][4][2], const State& st, const Unit& u, int wr, int wc, int fr, int fq) const {
        const int row0 = u.pm * BM + wr * 64 + fr; const int col0 = u.pn * BM + wc * 32 + 8 * fq;
#pragma unroll
        for (int ai = 0; ai < 2; ++ai)
#pragma unroll
            for (int m = 0; m < 4; ++m) { bf16_t* rowp = O + (size_t)(row0 + ai * HALF + m * 16) * D + col0; const float rs = st.rs[ai][m];
#pragma unroll
                for (int bj = 0; bj < 2; ++bj) { const f32x4 v0 = acc[ai][bj][m][0] * rs, v1 = acc[ai][bj][m][1] * rs;
                    u32x4 w; w.x = cvt_pk_bf16(v0[0], v0[1]); w.y = cvt_pk_bf16(v0[2], v0[3]); w.z = cvt_pk_bf16(v1[0], v1[1]); w.w = cvt_pk_bf16(v1[2], v1[3]);
                    *(u32x4*)(rowp + bj * HALF) = w; } }
    }
};
struct EpiUp {
    static constexpr bool PERM = true, AFTER_DRAIN = false, MID = false; typedef NoState State;
    bf16_t* ACT; const PG8_LAS unsigned* tokw;
    __device__ __forceinline__ void operator()(const f32x4 (&acc)[2][2][4][2], const State&, const Unit& u, int wr, int wc, int fr, int fq) const {
        const int s = u.aux >> 2, t = u.aux & 3; const int col0 = s * 512 + t * 128 + wc * 32 + 8 * fq;
#pragma unroll
        for (int ai = 0; ai < 2; ++ai)
#pragma unroll
            for (int m = 0; m < 4; ++m) { const int rl = ai * HALF + wr * 64 + m * 16 + fr; const int r = u.pm * BM + rl; const unsigned wp = tokw[u.ord * BM + rl];
                const float w = __uint_as_float(s ? (wp & 0xffff0000u) : (wp << 16));
                float a[8];
#pragma unroll
                for (int n = 0; n < 2; ++n)
#pragma unroll
                    for (int j = 0; j < 4; ++j) a[n * 4 + j] = silu_f(acc[ai][0][m][n][j]) * acc[ai][1][m][n][j] * w;
#if MOE_FP8
                int p0 = 0, p1 = 0;
#pragma unroll
                for (int j = 0; j < 8; ++j) a[j] = __builtin_amdgcn_fmed3f(a[j] * 4.f, -448.f, 448.f);
                p0 = __builtin_amdgcn_cvt_pk_fp8_f32(a[0], a[1], p0, false); p0 = __builtin_amdgcn_cvt_pk_fp8_f32(a[2], a[3], p0, true);
                p1 = __builtin_amdgcn_cvt_pk_fp8_f32(a[4], a[5], p1, false); p1 = __builtin_amdgcn_cvt_pk_fp8_f32(a[6], a[7], p1, true);
                typedef int v2i_t __attribute__((ext_vector_type(2)));
                *(v2i_t*)((unsigned char*)ACT + (size_t)r * D + col0) = (v2i_t){p0, p1}; }
#else
                u32x4 o; o.x = cvt_pk_bf16(a[0], a[1]); o.y = cvt_pk_bf16(a[2], a[3]); o.z = cvt_pk_bf16(a[4], a[5]); o.w = cvt_pk_bf16(a[6], a[7]);
                *(u32x4*)(ACT + (size_t)r * D + col0) = o; }
#endif
    }
};
struct EpiDown {
    static constexpr bool PERM = true, AFTER_DRAIN = false, MID = false; typedef NoState State;
    bf16_t* O; const PG8_LAS int* tokd;
    __device__ __forceinline__ void operator()(const f32x4 (&acc)[2][2][4][2], const State&, const Unit& u, int wr, int wc, int fr, int fq) const {
        const int col0 = u.aux * BM + wc * 32 + 8 * fq;
#pragma unroll
        for (int ai = 0; ai < 2; ++ai)
#pragma unroll
            for (int m = 0; m < 4; ++m) { const int rl = ai * HALF + wr * 64 + m * 16 + fr;
                const int tok = tokd[u.ord * BM + rl];
                if (tok >= 0) { bf16_t* rowp = O + (size_t)tok * D + col0;
#pragma unroll
                    for (int bj = 0; bj < 2; ++bj) { const f32x4 v0 = acc[ai][bj][m][0], v1 = acc[ai][bj][m][1];
                        u32x4 w; w.x = cvt_pk_bf16(v0[0], v0[1]); w.y = cvt_pk_bf16(v0[2], v0[3]); w.z = cvt_pk_bf16(v1[0], v1[1]); w.w = cvt_pk_bf16(v1[2], v1[3]);
                        *(u32x4*)(rowp + bj * HALF) = w; } } }
    }
};
__device__ __forceinline__ int cls_expert(int cls, int s) { const int g = cls / 6, p = cls % 6; const int a = p < 3 ? 0 : (p < 5 ? 1 : 2); const int b = p < 3 ? p + 1 : (p < 5 ? p - 1 : 3); return g * 4 + (s ? b : a); }
struct MoeUpOrder {
    static constexpr bool GATHER = true;
    int G, c, NT; const PG8_LAS unsigned char* tcls; const PG8_LAS unsigned char* tfirst; const PG8_LAS unsigned* lcnt; const PG8_LAS unsigned* toku;
    __device__ __forceinline__ bool next(int i, Unit& u) const {
        const int x = c & 7, j = (c >> 3) + (G >> 3) * i; const int pm = 8 * (j >> 3) + x; if (pm >= NT) return false;
        const int st = j & 7; const int cls = (int)tcls[pm]; u.pm = pm; u.aux = st; u.pn = cls_expert(cls, st >> 2) * 4 + (st & 3);
        u.aoff = 0; u.boff = (long)u.pn * (BM * D * MOE_ESZ); u.dboff = 0; u.cls = cls; u.rank0 = (pm - (int)tfirst[cls]) * BM; u.cnt = (int)lcnt[cls]; u.ord = i; return true;
    }
    __device__ __forceinline__ unsigned row_off(const Unit& u, int r) const { return toku[u.ord * BM + r]; }
    __device__ __forceinline__ void a_ready(const Unit&) const {}
    __device__ __forceinline__ void done(const Unit&) const {}
};
struct MoeDownOrder {
    static constexpr bool GATHER = false;
    int G, c, NT; const PG8_LAS unsigned char* tcls; const PG8_LAS unsigned char* tfirst; const PG8_LAS unsigned* lcnt;
    __device__ __forceinline__ bool next(int i, Unit& u) const {
        const int x = c & 7, j = (c >> 3) + (G >> 3) * i; const int pm = 8 * (j >> 2) + x; if (pm >= NT) return false;
        const int nt = j & 3; const int cls = (int)tcls[pm]; const int ea = cls_expert(cls, 0), eb = cls_expert(cls, 1); u.pm = pm; u.aux = nt; u.pn = 0;
        u.aoff = (long)pm * (BM * D * MOE_ESZ); u.boff = ((long)ea * D + nt * BM) * (DEXP * MOE_ESZ); u.dboff = (long)(eb - ea) * D * (DEXP * MOE_ESZ) - DEXP * MOE_ESZ;
        u.cls = cls; u.rank0 = (pm - (int)tfirst[cls]) * BM; u.cnt = (int)lcnt[cls]; u.ord = i; return true;
    }
    __device__ __forceinline__ void a_ready(const Unit&) const {}
    __device__ __forceinline__ void done(const Unit&) const {}
};

template <class Epi, class Sched, bool ALIGN_EPI = false, bool SP2 = false, bool FP8 = false>
__device__ __forceinline__ void gemm_phase(PG8_LAS unsigned char* lds, const Gemm g, const Sched& S, const Epi& E, const int tid) {
    typedef int v4i_t __attribute__((ext_vector_type(4))); typedef int v8i_t __attribute__((ext_vector_type(8)));
    const int wid = __builtin_amdgcn_readfirstlane(tid >> 6), lane = tid & 63, wr = wid >> 2, wc = wid & 3, fr = lane & 15, fq = lane >> 4;
    const int K = g.K, nt = K / BK;
    static_assert(SP2, "only the two-super-phase loop is kept");
    const int nth = nt / 2;
    unsigned voffB[2]; int RR[2], CC2[2];
    unsigned cvo[2][2];
#pragma unroll
    for (int i = 0; i < 2; ++i) { int R, C; stage_rc(tid * 16 + i * 8192, R, C); const int Rb = Epi::PERM ? ((R & ~31) + perm32(R & 31)) : R;
        RR[i] = R; CC2[i] = C * 2; voffB[i] = (unsigned)(Rb * g.ldb + C) * 2u; }
#define PG8_AOFFS(dst, u) do { _Pragma("unroll") for (int _h = 0; _h < 2; ++_h) _Pragma("unroll") for (int _i = 0; _i < 2; ++_i) { \
        if constexpr (Sched::GATHER) dst[_h][_i] = S.row_off(u, _h * HALF + RR[_i]) + (unsigned)CC2[_i]; else dst[_h][_i] = (unsigned)((_h * HALF + RR[_i]) * g.lda) * 2u + (unsigned)CC2[_i]; } } while (0)
    const size_t kstep = (size_t)(BK * 2);
    const size_t hstep = (size_t)HALF * g.ldb * 2;
    const unsigned ldsw = (unsigned)wid * 1024u;
    int aofs[2], bofs[2];
    if constexpr (FP8) { aofs[0] = lds_byte(wr * 64 + fr, 16 * (fq & 1)) + (fq >> 1) * 1024; aofs[1] = lds_byte(wr * 64 + fr, 16 * (fq & 1) + 8) + (fq >> 1) * 1024;
                         bofs[0] = lds_byte(wc * 32 + fr, 16 * (fq & 1)) + (fq >> 1) * 1024; bofs[1] = lds_byte(wc * 32 + fr, 16 * (fq & 1) + 8) + (fq >> 1) * 1024; }
    else { aofs[0] = lds_byte(wr * 64 + fr, fq * 8); aofs[1] = aofs[0] + 1024; bofs[0] = lds_byte(wc * 32 + fr, fq * 8); bofs[1] = bofs[0] + 1024; }
#define PG8_SA(b, h) (((b) * 2 + (h)) * HTB)
#define PG8_SB(b, h) ((4 + (b) * 2 + (h)) * HTB)
#define PG8_STAGE(bufoff, gbase, voff) do { _Pragma("unroll") for (int _i = 0; _i < 2; ++_i) \
        __builtin_amdgcn_global_load_lds((const unsigned*)((const char*)(gbase) + (voff)[_i]), (PG8_LAS unsigned*)(lds + (bufoff) + ldsw + _i * 8192), 16, 0, 0); } while (0)
#define PG8_LD16(off) (*(const PG8_LAS v4i_t*)(lds + (off)))
#define PG8_LDA(dst, b, h) do { if constexpr (FP8) { _Pragma("unroll") for (int m = 0; m < 4; ++m) dst##8[m] = *(const PG8_LAS v8i_t*)(lds + PG8_SA(b, h) + aofs[0] + m * 2048); }     \
        else { _Pragma("unroll") for (int m = 0; m < 4; ++m) _Pragma("unroll") for (int k = 0; k < 2; ++k) dst[m][k] = *(const PG8_LAS bf16x8*)(lds + PG8_SA(b, h) + aofs[k] + m * 2048); } } while (0)
#define PG8_LDB(dst, b, h) do { if constexpr (FP8) { _Pragma("unroll") for (int n = 0; n < 2; ++n) dst##8[n] = *(const PG8_LAS v8i_t*)(lds + PG8_SB(b, h) + bofs[0] + n * 2048); } \
        else { _Pragma("unroll") for (int n = 0; n < 2; ++n) _Pragma("unroll") for (int k = 0; k < 2; ++k) dst[n][k] = *(const PG8_LAS bf16x8*)(lds + PG8_SB(b, h) + bofs[k] + n * 2048); } } while (0)
#define PG8_PINACC(ai, bj) do { if constexpr (FP8) { _Pragma("unroll") for (int m = 0; m < 4; ++m) _Pragma("unroll") for (int n = 0; n < 2; ++n) asm volatile("" : "+v"(acc[ai][bj][m][n])); } } while (0)
#define PG8_MMA(ai, bj, At, Bt) do { PG8_PINACC(ai, bj); __builtin_amdgcn_s_setprio(1); _Pragma("unroll") for (int m = 0; m < 4; ++m) _Pragma("unroll") for (int n = 0; n < 2; ++n) { \
        if constexpr (FP8) acc[ai][bj][m][n] = __builtin_amdgcn_mfma_scale_f32_16x16x128_f8f6f4(Bt##8[n], At##8[m], acc[ai][bj][m][n], 0, 0, 0, g.scB, 0, g.scA); \
        else { _Pragma("unroll") for (int k = 0; k < 2; ++k) acc[ai][bj][m][n] = __builtin_amdgcn_mfma_f32_16x16x32_bf16(Bt[n][k], At[m][k], acc[ai][bj][m][n], 0, 0, 0); } } \
        PG8_PINACC(ai, bj); __builtin_amdgcn_s_setprio(0); } while (0)
#define PG8_WAIT_V(n) asm volatile("s_waitcnt vmcnt(" #n ")" ::: "memory")
#define PG8_WAIT_L(n) asm volatile("s_waitcnt lgkmcnt(" #n ")" ::: "memory")
#define PG8_BAR __builtin_amdgcn_s_barrier()
#define PG8_SCHED __builtin_amdgcn_sched_barrier(0)
    Unit cur, nxt; int ui = 0;
    if (!S.next(0, cur)) return;
    f32x4 acc[2][2][4][2]; typename Epi::State est;
#pragma unroll
    for (int a = 0; a < 2; ++a)
#pragma unroll
        for (int b = 0; b < 2; ++b)
#pragma unroll
            for (int m = 0; m < 4; ++m)
#pragma unroll
                for (int n = 0; n < 2; ++n) acc[a][b][m][n] = (f32x4){0.f, 0.f, 0.f, 0.f};
    bf16x8 At[4][2], B0[2][2], B1[2][2]; v8i_t At8[4], B08[2], B18[2];
    const char* cA = (const char*)g.A + cur.aoff; const char* cB = (const char*)g.Bt + cur.boff;
    S.a_ready(cur);
    PG8_AOFFS(cvo, cur);
    if constexpr (SP2) {
        PG8_STAGE(PG8_SB(0, 0), cB, voffB); PG8_STAGE(PG8_SB(0, 1), cB + hstep, voffB); PG8_STAGE(PG8_SA(0, 0), cA, cvo[0]); PG8_STAGE(PG8_SA(0, 1), cA, cvo[1]);
        if (wr == 1) PG8_BAR;
        PG8_WAIT_V(2); PG8_BAR;
        PG8_STAGE(PG8_SB(1, 0), cB + kstep, voffB); PG8_STAGE(PG8_SA(1, 0), cA + kstep, cvo[0]); PG8_STAGE(PG8_SB(1, 1), cB + hstep + kstep, voffB);
        PG8_WAIT_V(6); PG8_BAR;
    }
    for (;;) {
        const bool has_next = S.next(ui + 1, nxt);
        const char* nA = has_next ? (const char*)g.A + nxt.aoff : cA; const char* nB = has_next ? (const char*)g.Bt + nxt.boff : cB;
#pragma unroll 1
        for (int t = 0; t < nt; t += 2) {
            if constexpr (Epi::MID) { if (t == nt / 2) E.mid(acc, est, cur, wr, fr); }
            const bool last = (t == nt - 2);
            const char* a1 = cA + (size_t)(t + 1) * kstep;
            const char* a2 = last ? nA : cA + (size_t)(t + 2) * kstep; const char* b2 = last ? nB : cB + (size_t)(t + 2) * kstep + ((t + 2 >= nth) ? cur.dboff : 0);
            unsigned xo[2][2];
            if constexpr (Sched::GATHER) { if (last && has_next) { PG8_AOFFS(xo, nxt); } else { xo[0][0] = cvo[0][0]; xo[0][1] = cvo[0][1]; xo[1][0] = cvo[1][0]; xo[1][1] = cvo[1][1]; } }
            else { xo[0][0] = cvo[0][0]; xo[0][1] = cvo[0][1]; xo[1][0] = cvo[1][0]; xo[1][1] = cvo[1][1]; }
            const char* a3 = a2 + kstep; const char* b3 = b2 + kstep;
            if (last && has_next) S.a_ready(nxt);
            if constexpr (SP2) {
            PG8_LDB(B0, 0, 0); PG8_LDB(B1, 0, 1); PG8_SCHED; PG8_LDA(At, 0, 0); PG8_STAGE(PG8_SA(1, 1), a1, cvo[1]);
            PG8_WAIT_V(8); PG8_WAIT_L(0); PG8_BAR; PG8_MMA(0, 0, At, B0); PG8_MMA(0, 1, At, B1); PG8_BAR; PG8_SCHED;
            PG8_LDA(At, 0, 1); PG8_STAGE(PG8_SB(0, 0), b2, voffB); PG8_STAGE(PG8_SB(0, 1), b2 + hstep, voffB); PG8_STAGE(PG8_SA(0, 0), a2, xo[0]);
            PG8_WAIT_V(8); PG8_WAIT_L(0); PG8_BAR; PG8_MMA(1, 0, At, B0); PG8_MMA(1, 1, At, B1); PG8_BAR; PG8_SCHED;
            PG8_LDB(B0, 1, 0); PG8_LDB(B1, 1, 1); PG8_SCHED; PG8_LDA(At, 1, 0); PG8_STAGE(PG8_SA(0, 1), a2, xo[1]);
            PG8_WAIT_V(8); PG8_WAIT_L(0); PG8_BAR; PG8_MMA(0, 0, At, B0); PG8_MMA(0, 1, At, B1); PG8_BAR; PG8_SCHED;
            PG8_LDA(At, 1, 1); PG8_STAGE(PG8_SB(1, 0), b3, voffB); PG8_STAGE(PG8_SB(1, 1), b3 + hstep, voffB); PG8_STAGE(PG8_SA(1, 0), a3, xo[0]);
            if constexpr (Sched::GATHER) { if (last) { cvo[0][0] = xo[0][0]; cvo[0][1] = xo[0][1]; cvo[1][0] = xo[1][0]; cvo[1][1] = xo[1][1]; } }
            PG8_WAIT_V(8); PG8_WAIT_L(0); PG8_BAR; PG8_MMA(1, 0, At, B0); PG8_MMA(1, 1, At, B1); PG8_BAR; PG8_SCHED;
            }
        }
        if constexpr (ALIGN_EPI) { if (wr == 0) PG8_BAR; }
        if constexpr (!Epi::AFTER_DRAIN) { E(acc, est, cur, wr, wc, fr, fq); S.done(cur); }
        if (!has_next) break;
#pragma unroll
        for (int a = 0; a < 2; ++a)
#pragma unroll
            for (int b = 0; b < 2; ++b)
#pragma unroll
                for (int m = 0; m < 4; ++m)
#pragma unroll
                    for (int n = 0; n < 2; ++n) acc[a][b][m][n] = (f32x4){0.f, 0.f, 0.f, 0.f};
        cur = nxt; cA = nA; cB = nB; ++ui;
        if constexpr (ALIGN_EPI) { if (wr == 1) PG8_BAR; }
    }
    PG8_WAIT_V(0);
    if constexpr (!ALIGN_EPI) { if (wr == 0) PG8_BAR; }
    PG8_BAR;
#undef PG8_SA
#undef PG8_SB
#undef PG8_STAGE
#undef PG8_AOFFS
#undef PG8_LDA
#undef PG8_LD16
#undef PG8_LDB
#undef PG8_MMA
#undef PG8_PINACC
#undef PG8_WAIT_V
#undef PG8_WAIT_L
#undef PG8_BAR
#undef PG8_SCHED
}
}
namespace attn_body {
using bf16=__hip_bfloat16;
using bf16x8=__attribute__((ext_vector_type(8)))short;
using s16x4=__attribute__((ext_vector_type(4)))short;
using f32x16=__attribute__((ext_vector_type(16)))float;
using u32x4=__attribute__((ext_vector_type(4)))unsigned;
constexpr int BATCH=4,NHEAD=8,SEQ=8192,D=64,DM=NHEAD*D,OPITCH=1024;
constexpr int NW=8,QBLK=32,QB=QBLK*NW,KVBLK=64,NQB=SEQ/QB;
constexpr int ATTN_PITCH=DM, ATTN_UNIT_ROWS=QB;
__device__ __forceinline__ int crow(int r,int hi){return (r&3)+8*(r>>2)+4*hi;}
#define SBAR() __builtin_amdgcn_sched_barrier(0)
__device__ __forceinline__ void cmask(f32x16&p0,f32x16&p1,int jb,int qrel,int hi){
  const float NEG=-INFINITY; int kb=64*jb+4*hi-qrel; asm volatile("":"+v"(kb));
  #pragma unroll
  for(int r=0;r<16;++r){const int c=(r&3)+8*(r>>2); if(kb>-c)p0[r]=NEG; if(kb>-c-32)p1[r]=NEG;}
}

constexpr int NSLOT=3, SLOTB=8192;
constexpr float TCUT=45.f;
constexpr int LDS_K=0, LDS_V=NSLOT*SLOTB, LDS_WS=2*NSLOT*SLOTB, LDS_OST=LDS_WS+NW*64*4, LDS_TAB=LDS_OST+NW*4096, LDS_BYTES=LDS_TAB+SEQ*8;
__device__ __forceinline__ void glds16(const void*gsrc,unsigned lds_dst){unsigned keep;
  asm volatile("s_mov_b32 %0, m0\n\ts_mov_b32 m0, %2\n\ts_nop 0\n\tglobal_load_lds_dwordx4 %1, off\n\ts_mov_b32 m0, %0":"=&s"(keep):"v"(gsrc),"s"(lds_dst):"memory");}
__device__ __forceinline__ void glds16s(const void*sbase,unsigned voff,unsigned lds_dst){unsigned keep;
  asm volatile("s_nop 4\n\ts_mov_b32 %0, m0\n\ts_mov_b32 m0, %3\n\ts_nop 0\n\tglobal_load_lds_dwordx4 %1, %2\n\ts_mov_b32 m0, %0":"=&s"(keep):"v"(voff),"s"(sbase),"s"(lds_dst):"memory");}
__device__ __forceinline__ float max3f(float a,float b,float c){float r;asm("v_max3_f32 %0, %1, %2, %3":"=v"(r):"v"(a),"v"(b),"v"(c));return r;}
__device__ __forceinline__ float max2f(float a,float b){float r;asm("v_max_f32_e32 %0, %1, %2":"=v"(r):"v"(a),"v"(b));return r;}
__device__ __forceinline__ float fadd_s(float a,float b){float r;asm("v_add_f32_e32 %0, %1, %2":"=v"(r):"v"(a),"v"(b));return r;}
__device__ __forceinline__ float fsub_s(float a,float b){float r;asm("v_sub_f32_e32 %0, %1, %2":"=v"(r):"v"(a),"v"(b));return r;}
typedef float f32x2_t __attribute__((ext_vector_type(2))); typedef __bf16 bf16x2_t __attribute__((ext_vector_type(2)));
__device__ __forceinline__ unsigned cvtpk_s(float lo,float hi){f32x2_t v={lo,hi};bf16x2_t b=__builtin_convertvector(v,bf16x2_t);return __builtin_bit_cast(unsigned,b);}
#define WAIT_BAR(N) asm volatile("s_waitcnt vmcnt(" #N ") lgkmcnt(0)\n\ts_barrier":::"memory")

__device__ __forceinline__ void qkt(f32x16&p0,f32x16&p1,const char*Kslot,const bf16x8*qr,const bf16x8 qx,const bf16x8 kx0,const bf16x8 kx1,int r32,int hi){
  const f32x16 negm=f32x16{};
  const char*kb=Kslot+hi*1024+r32*16;
  #pragma unroll
  for(int d0=0;d0<4;++d0){
    const bf16x8 b0=*reinterpret_cast<const bf16x8*>(kb+d0*2048);
    const bf16x8 b1=*reinterpret_cast<const bf16x8*>(kb+d0*2048+512);
    if(d0==0){p0=__builtin_amdgcn_mfma_f32_32x32x16_bf16(b0,qr[0],negm,0,0,0);p1=__builtin_amdgcn_mfma_f32_32x32x16_bf16(b1,qr[0],negm,0,0,0);}
    else{p0=__builtin_amdgcn_mfma_f32_32x32x16_bf16(b0,qr[d0],p0,0,0,0);p1=__builtin_amdgcn_mfma_f32_32x32x16_bf16(b1,qr[d0],p1,0,0,0);}}
  p0=__builtin_amdgcn_mfma_f32_32x32x16_bf16(kx0,qx,p0,0,0,0);p1=__builtin_amdgcn_mfma_f32_32x32x16_bf16(kx1,qx,p1,0,0,0);
}
typedef __attribute__((address_space(3))) const char* lds_cptr;
typedef short v4i16_t __attribute__((ext_vector_type(4)));
__device__ __forceinline__ void kload8(bf16x8*kf,lds_cptr kp){
  kf[0]=*(const __attribute__((address_space(3))) bf16x8*)(kp);      kf[1]=*(const __attribute__((address_space(3))) bf16x8*)(kp+512);
  kf[2]=*(const __attribute__((address_space(3))) bf16x8*)(kp+2048); kf[3]=*(const __attribute__((address_space(3))) bf16x8*)(kp+2560);
  kf[4]=*(const __attribute__((address_space(3))) bf16x8*)(kp+4096); kf[5]=*(const __attribute__((address_space(3))) bf16x8*)(kp+4608);
  kf[6]=*(const __attribute__((address_space(3))) bf16x8*)(kp+6144); kf[7]=*(const __attribute__((address_space(3))) bf16x8*)(kp+6656);
}
__device__ __forceinline__ void kload2(bf16x8*kf,lds_cptr kp,int j){ kf[2*j]=*(const __attribute__((address_space(3))) bf16x8*)(kp+j*2048); kf[2*j+1]=*(const __attribute__((address_space(3))) bf16x8*)(kp+j*2048+512); }
__device__ __forceinline__ s16x4 vtr(lds_cptr p){ return __builtin_bit_cast(s16x4,__builtin_amdgcn_ds_read_tr16_b64_v4i16((__attribute__((address_space(3))) v4i16_t*)p)); }
typedef unsigned u32x2_t __attribute__((ext_vector_type(2)));
__device__ __forceinline__ u32x2_t ldkx_raw(lds_cptr p){ return *(const __attribute__((address_space(3))) u32x2_t*)p; }
__device__ __forceinline__ bf16x8 mkkx(u32x2_t w){ const u32x4 v={w.x,w.y,0x3F803F80u,0u}; return __builtin_bit_cast(bf16x8,v); }
__device__ __forceinline__ bf16x8 ldkx(lds_cptr p){ const u32x2_t w=*(const __attribute__((address_space(3))) u32x2_t*)p; const u32x4 v={w.x,w.y,0x3F803F80u,0u}; return __builtin_bit_cast(bf16x8,v); }
__device__ __forceinline__ bf16x8 make_qx(float a,int hi){
  const unsigned ah=cvtpk_s(a,0.f)&0xffffu; const float r1=a-__uint_as_float(ah<<16);
  const unsigned am=cvtpk_s(r1,0.f)&0xffffu; const float r2=r1-__uint_as_float(am<<16);
  u32x4 v={0x3F803F80u,0x3F80u|(ah<<16),cvtpk_s(r1,r2),0u};
  if(hi){v=(u32x4){0u,0u,0u,0u};}
  return __builtin_bit_cast(bf16x8,v);
}
__device__ __forceinline__ float rowmax(const f32x16&p0,const f32x16&p1){
  float a=max3f(p0[0],p0[1],p1[0]),b=max3f(p0[2],p0[3],p1[1]);a=max3f(a,p1[2],p1[3]);
  #pragma unroll
  for(int r=4;r<16;r+=4){a=max3f(a,p0[r],p0[r+1]);b=max3f(b,p0[r+2],p0[r+3]);a=max3f(a,p1[r],p1[r+1]);b=max3f(b,p1[r+2],p1[r+3]);}
  const float m=max2f(a,b);
  auto rr=__builtin_amdgcn_permlane32_swap(__float_as_uint(m),__float_as_uint(m),false,false);
  return max2f(__uint_as_float(rr[0]),__uint_as_float(rr[1]));
}
__device__ __forceinline__ void pv(f32x16*o,int vb,bf16x8 pa0,bf16x8 pa1,bf16x8 pa2,bf16x8 pa3){
  #pragma unroll
  for(int d0=0;d0<2;++d0){s16x4 lo[4],hi[4];
    #pragma unroll
    for(int ks=0;ks<4;++ks){
      asm volatile("ds_read_b64_tr_b16 %0,%1 offset:%c2":"=&v"(lo[ks]):"v"(vb),"i"(d0*4096+ks*1024):"memory");
      asm volatile("ds_read_b64_tr_b16 %0,%1 offset:%c2":"=&v"(hi[ks]):"v"(vb),"i"(d0*4096+ks*1024+512):"memory");}
    asm volatile("s_waitcnt lgkmcnt(0)":::"memory");SBAR();
    #define PK(k) (bf16x8){lo[k][0],lo[k][1],lo[k][2],lo[k][3],hi[k][0],hi[k][1],hi[k][2],hi[k][3]}
    o[d0]=__builtin_amdgcn_mfma_f32_32x32x16_bf16(pa0,PK(0),o[d0],0,0,0);
    o[d0]=__builtin_amdgcn_mfma_f32_32x32x16_bf16(pa1,PK(1),o[d0],0,0,0);
    o[d0]=__builtin_amdgcn_mfma_f32_32x32x16_bf16(pa2,PK(2),o[d0],0,0,0);
    o[d0]=__builtin_amdgcn_mfma_f32_32x32x16_bf16(pa3,PK(3),o[d0],0,0,0);
    #undef PK
  }
}

#ifndef ATTN_STORE16
#define ATTN_STORE16(p,v) (*(u32x4*)(p)=(v))
#endif
template<int THRL> __device__ __forceinline__ void attn_unit(int b,int h,int qb,const bf16*Q,const bf16*__restrict__ K,const bf16*__restrict__ V,bf16*O,const unsigned long long*KX8,const float*GF,const float*QKB,float*SSQ,char*shm,const int tid){
  const int lane=tid&63,r32=lane&31,hi=lane>>5; const int wid=__builtin_amdgcn_readfirstlane(tid>>6);
  const long rowbase=(long)b*SEQ; const int q0=qb*QB;
  const bf16*Qw=Q+(rowbase+q0+wid*QBLK)*DM+h*D;
  const bf16*Kh=K+rowbase*DM+h*D,*Vh=V+rowbase*DM+h*D;
  const unsigned lds0=(unsigned)(uintptr_t)shm;
  float*wsf=(float*)(shm+LDS_WS)+wid*64;
  const bf16*ksrc=Kh+wid*8;
  const bf16*vsrc=Vh+(long)(16*(wid&3))*DM+(wid>>2)*32;
  const unsigned kvoff=(unsigned)lane*(DM*2), vvoff=(unsigned)((lane>>2)*DM+(lane&3)*8)*2u;
  const unsigned kdst=lds0+LDS_K+wid*1024, vdst=lds0+LDS_V+wid*1024;
  #define DMA_K(t,slot) glds16s(ksrc+(long)(NT-1-(t))*KVBLK*DM,kvoff,(unsigned)__builtin_amdgcn_readfirstlane(kdst+(slot)))
  #define DMA_V(t,slot) glds16s(vsrc+(long)(NT-1-(t))*KVBLK*DM,vvoff,(unsigned)__builtin_amdgcn_readfirstlane(vdst+(slot)))
  const int vb0=(int)(lds0+LDS_V)+((lane>>4)&1)*32+(lane&3)*8+(4*hi+((lane&15)>>2))*64;
  const char*Kbase=shm+LDS_K; bf16x8 kf[8];
  const lds_cptr shm3=(lds_cptr)shm; const lds_cptr kp0=shm3+LDS_K+hi*1024+r32*16; const lds_cptr vp0=shm3+LDS_V+((lane>>4)&1)*32+(lane&3)*8+(4*hi+((lane&15)>>2))*64;
  const int NT=(q0+QB)/KVBLK;
  const lds_cptr tp0=shm3+LDS_TAB+r32*8;
  const float nGi=-GF[(long)(b*NHEAD+h)*SEQ+q0+wid*QBLK+r32];
  float gl0,gl1,gthr,bqk;
  { const float*gfh=GF+(long)(b*NHEAD+h)*SEQ; gl0=(lane<NT)?gfh[64*lane+63]:3.0e38f; gl1=(lane+64<NT)?gfh[64*(lane+64)+63]:3.0e38f;
    float kp=QKB[(b*NHEAD+h)*16+(lane&15)];
    #define DPPMAX_(v,c) fmaxf((v),__builtin_bit_cast(float,__builtin_amdgcn_update_dpp(0,__builtin_bit_cast(int,(v)),(c),0xf,0xf,false)))
    kp=DPPMAX_(kp,0xB1);kp=DPPMAX_(kp,0x4E);kp=DPPMAX_(kp,0x141);kp=DPPMAX_(kp,0x140);
    #undef DPPMAX_
    const float bq=2.04f*sqrtf(QKB[512+(b*NHEAD+h)*32+qb]*kp);
    gthr=gfh[q0]-(TCUT+2.f*bq); bqk=bq; }
  DMA_K(0,0);DMA_V(0,0);DMA_K(1,SLOTB);
  bf16x8 qr[4];
  #pragma unroll
  for(int d0=0;d0<4;++d0)qr[d0]=*reinterpret_cast<const bf16x8*>(&Qw[(long)r32*DM+d0*16+hi*8]);
  { float dd=0.f; const bf16*Kd=Kh+(long)(q0+wid*QBLK+r32)*DM+hi*8;
    #pragma unroll
    for(int d0=0;d0<4;++d0){ const bf16x8 kk=*reinterpret_cast<const bf16x8*>(Kd+d0*16);
      #pragma unroll
      for(int j=0;j<8;++j)dd+=__uint_as_float((unsigned)(unsigned short)qr[d0][j]<<16)*__uint_as_float((unsigned)(unsigned short)kk[j]<<16); }
    { const auto rr=__builtin_amdgcn_permlane32_swap(__float_as_uint(dd),__float_as_uint(dd),false,false); dd=__uint_as_float(rr[0])+__uint_as_float(rr[1]); }
    float vm=dd-nGi;
    #define DPPMIN_(v,c) fminf((v),__builtin_bit_cast(float,__builtin_amdgcn_update_dpp(0,__builtin_bit_cast(int,(v)),(c),0xf,0xf,false)))
    vm=DPPMIN_(vm,0xB1);vm=DPPMIN_(vm,0x4E);vm=DPPMIN_(vm,0x141);vm=DPPMIN_(vm,0x140);
    #undef DPPMIN_
    { const auto rr=__builtin_amdgcn_permlane16_swap(__float_as_uint(vm),__float_as_uint(vm),false,false); vm=fminf(__uint_as_float(rr[0]),__uint_as_float(rr[1])); }
    if(lane==0)wsf[0]=vm; }
  int NS=NT;
  { const int cnt=__builtin_popcountll(__ballot(gl0<gthr))+__builtin_popcountll(__ballot(gl1<gthr)); int tlo=cnt&~1; if(tlo>NT-4)tlo=NT-4; NS=__builtin_amdgcn_readfirstlane(NT-tlo); }
  { const char*tsrc=(const char*)(KX8+(long)(b*NHEAD+h)*SEQ); const int npc=2*(qb+1);
    for(int pc=((NT-NS)>>1)+wid;pc<npc;pc+=NW)glds16s(tsrc+(long)pc*1024,(unsigned)lane*16u,(unsigned)__builtin_amdgcn_readfirstlane(lds0+LDS_TAB+pc*1024)); }
  float mhat=0.f,l_reg=0.f;f32x16 o[2];o[0]=f32x16{};o[1]=f32x16{};bf16x8 qx=make_qx(nGi,hi);const f32x16 zc=f32x16{};
  if(hi==0)wsf[32+r32]=nGi;
  const int qrel=wid*QBLK+r32;
  #define CMASK(P0,P1,t) do{int jb_=3-(t); if(jb_>=0)cmask(P0,P1,jb_,qrel,hi);}while(0)
  bool resc=false;
  #define START(P0,P1) do{ const float rm=rowmax(P0,P1); resc=false; \
    { const float dl=(rm<-1e30f)?0.f:rm; mhat=fadd_s(mhat,dl); \
      _Pragma("unroll") for(int r=0;r<16;++r){P0[r]=fsub_s(P0[r],dl);P1[r]=fsub_s(P1[r],dl);} \
      qx=make_qx(nGi-mhat,hi); } \
    _Pragma("unroll") for(int r=0;r<16;++r)P0[r]=__builtin_amdgcn_exp2f(P0[r]); }while(0)
  #define RESC() do{ if(resc){ asm volatile("s_waitcnt lgkmcnt(0)":::"memory"); \
      _Pragma("unroll") for(int d_=0;d_<2;++d_) _Pragma("unroll") for(int r=0;r<16;++r)o[d_][r]*=wsf[crow(r,hi)]; } }while(0)
  f32x16 pA0,pA1,pB0,pB1;
  int sl_prev=0,sl_cur=0,sl_next=SLOTB;
  #define ROT() do{sl_prev=sl_cur;sl_cur=sl_next;sl_next=(sl_next==(NSLOT-1)*SLOTB)?0:sl_next+SLOTB;}while(0)
  DMA_K(2,2*SLOTB);
  WAIT_BAR(1);
  { float bm=((const float*)(shm+LDS_WS))[0];
    #pragma unroll
    for(int w_=1;w_<NW;++w_)bm=fminf(bm,((const float*)(shm+LDS_WS))[w_*64]);
    const float gthr2=bm-bqk-TCUT-0.05f;
    const int cnt=__builtin_popcountll(__ballot(gl0<gthr2))+__builtin_popcountll(__ballot(gl1<gthr2)); int tlo=cnt&~1; if(tlo>NT-4)tlo=NT-4; const int ns2=__builtin_amdgcn_readfirstlane(NT-tlo); if(ns2<NS)NS=ns2; }
  qkt(pA0,pA1,Kbase,qr,qx,ldkx(tp0+(NT-1)*512),ldkx(tp0+(NT-1)*512+256),r32,hi);asm volatile("s_nop 15\n\ts_nop 7":"+v"(pA0),"+v"(pA1));CMASK(pA0,pA1,0);
  START(pA0,pA1);
  _Pragma("unroll") for(int r=0;r<16;++r)pA1[r]=__builtin_amdgcn_exp2f(pA1[r]);
  WAIT_BAR(0);
  DMA_K(3,0);DMA_V(1,SLOTB);
  ROT();
  kload8(kf,kp0+sl_cur);
  WAIT_BAR(2);
  s16x4 vlo[8],vhi[8]; u32x4 pw0,pw1,pw2,pw3;
  #define PKW(P,B) cvtpk_s(P[B],P[B+1])
  #define PAF(k) __builtin_bit_cast(bf16x8,pw##k)
  #define VFR(i) (bf16x8){vlo[i][0],vlo[i][1],vlo[i][2],vlo[i][3],vhi[i][0],vhi[i][1],vhi[i][2],vhi[i][3]}
  #define PIN(x) asm volatile("":"+v"(x))
  #define MX3(a,b,c) __builtin_fmaxf(__builtin_fmaxf((a),(b)),(c))
  #define GAPA(MF,A0,A1,A2,A3,W0,W1,PW) do{ MF; sacc+=A0; sacc+=A1; sacc+=A2; sacc+=A3; PIN(sacc); W0; W1; PIN(PW); SBAR(); }while(0)
  #define EX(v) __builtin_amdgcn_exp2f(v)
  #define GAPB(MF,X,B) do{ MF; X[B]=EX(X[B]); X[B+1]=EX(X[B+1]); X[B+2]=EX(X[B+2]); X[B+3]=EX(X[B+3]); PIN(X); SBAR(); }while(0)
  #define VRD(i) do{ vlo[i]=vtr(vp_+(((i)>>2)*4096+((i)&3)*1024)); vhi[i]=vtr(vp_+(((i)>>2)*4096+((i)&3)*1024+512)); }while(0)
  #define KRD(G,j) do{ if(G){ kload2(kf,kp0+sl_next,j); SBAR(); } }while(0)
  #define STEP(C0,C1,P0,P1,t,GK,GV,GL) do{ SBAR(); \
    const lds_cptr vp_=vp0+sl_prev; \
    const u32x2_t kq0_=ldkx_raw(tp0+(NT-1-(t))*512), kq1_=ldkx_raw(tp0+(NT-1-(t))*512+256); \
    VRD(0); SBAR(); float sacc=(P0[0]+P0[1]); \
    GAPA(C0=__builtin_amdgcn_mfma_f32_32x32x16_bf16(kf[0],qr[0],zc,0,0,0), P0[2],P0[3],P0[4],P0[5],     pw0[0]=PKW(P0,0), pw0[1]=PKW(P0,2), pw0); \
    VRD(4); SBAR(); GAPA(C1=__builtin_amdgcn_mfma_f32_32x32x16_bf16(kf[1],qr[0],zc,0,0,0), P0[6],P0[7],P0[8],P0[9],     pw0[2]=PKW(P0,4), pw0[3]=PKW(P0,6), pw0); \
    C0=__builtin_amdgcn_mfma_f32_32x32x16_bf16(mkkx(kq0_),qx,C0,0,0,0); SBAR(); C1=__builtin_amdgcn_mfma_f32_32x32x16_bf16(mkkx(kq1_),qx,C1,0,0,0); SBAR(); \
    VRD(1); SBAR(); GAPA(C0=__builtin_amdgcn_mfma_f32_32x32x16_bf16(kf[2],qr[1],C0,0,0,0),   P0[10],P0[11],P0[12],P0[13], pw1[0]=PKW(P0,8), pw1[1]=PKW(P0,10), pw1); \
    VRD(5); SBAR(); GAPA(C1=__builtin_amdgcn_mfma_f32_32x32x16_bf16(kf[3],qr[1],C1,0,0,0),   P0[14],P0[15],P1[0],P1[1],   pw1[2]=PKW(P0,12),pw1[3]=PKW(P0,14), pw1); \
    VRD(2); SBAR(); GAPA(C0=__builtin_amdgcn_mfma_f32_32x32x16_bf16(kf[4],qr[2],C0,0,0,0),   P1[2],P1[3],P1[4],P1[5],     pw2[0]=PKW(P1,0), pw2[1]=PKW(P1,2), pw2); \
    VRD(6); SBAR(); GAPA(C1=__builtin_amdgcn_mfma_f32_32x32x16_bf16(kf[5],qr[2],C1,0,0,0),   P1[6],P1[7],P1[8],P1[9],     pw2[2]=PKW(P1,4), pw2[3]=PKW(P1,6), pw2); \
    VRD(3); SBAR(); GAPA(C0=__builtin_amdgcn_mfma_f32_32x32x16_bf16(kf[6],qr[3],C0,0,0,0),   P1[10],P1[11],P1[12],P1[13], pw3[0]=PKW(P1,8), pw3[1]=PKW(P1,10), pw3); \
    VRD(7); SBAR(); GAPA(C1=__builtin_amdgcn_mfma_f32_32x32x16_bf16(kf[7],qr[3],C1,0,0,0),   P1[14],P1[15],0.f,0.f,       pw3[2]=PKW(P1,12),pw3[3]=PKW(P1,14), pw3); \
    l_reg+=sacc; \
    if(GK){DMA_K((t)+3,sl_cur);} if(GV){DMA_V((t)+1,sl_next);} \
    CMASK(C0,C1,t); \
    { float a=MX3(C0[0],C0[1],C1[0]),b=MX3(C0[2],C0[3],C1[1]); a=MX3(a,C1[2],C1[3]); \
      _Pragma("unroll") for(int r=4;r<16;r+=4){a=MX3(a,C0[r],C0[r+1]);b=MX3(b,C0[r+2],C0[r+3]);a=MX3(a,C1[r],C1[r+1]);b=MX3(b,C1[r+2],C1[r+3]);} \
      float rm=__builtin_fmaxf(a,b); { auto rr=__builtin_amdgcn_permlane32_swap(__float_as_uint(rm),__float_as_uint(rm),false,false); rm=__builtin_fmaxf(__uint_as_float(rr[0]),__uint_as_float(rr[1])); } \
      resc=false; \
      if(__builtin_expect(__any(rm>(float)THRL),0)){ const float dl=__builtin_fmaxf(rm,0.f); mhat+=dl; \
        _Pragma("unroll") for(int r=0;r<16;++r){C0[r]-=dl;C1[r]-=dl;} \
        qx=make_qx(wsf[32+r32]-mhat,hi); \
        const float f=__builtin_amdgcn_exp2f(-dl); l_reg*=f; if(hi==0)wsf[r32]=f; resc=true; } } \
    SBAR(); \
    GAPB(o[0]=__builtin_amdgcn_mfma_f32_32x32x16_bf16(PAF(0),VFR(0),o[0],0,0,0), C0,0); \
    GAPB(o[1]=__builtin_amdgcn_mfma_f32_32x32x16_bf16(PAF(0),VFR(4),o[1],0,0,0), C0,4); \
    KRD(GL,0); GAPB(o[0]=__builtin_amdgcn_mfma_f32_32x32x16_bf16(PAF(1),VFR(1),o[0],0,0,0), C0,8); \
    KRD(GL,1); GAPB(o[1]=__builtin_amdgcn_mfma_f32_32x32x16_bf16(PAF(1),VFR(5),o[1],0,0,0), C0,12); \
    KRD(GL,2); GAPB(o[0]=__builtin_amdgcn_mfma_f32_32x32x16_bf16(PAF(2),VFR(2),o[0],0,0,0), C1,0); \
    KRD(GL,3); GAPB(o[1]=__builtin_amdgcn_mfma_f32_32x32x16_bf16(PAF(2),VFR(6),o[1],0,0,0), C1,4); \
    GAPB(o[0]=__builtin_amdgcn_mfma_f32_32x32x16_bf16(PAF(3),VFR(3),o[0],0,0,0), C1,8); \
    GAPB(o[1]=__builtin_amdgcn_mfma_f32_32x32x16_bf16(PAF(3),VFR(7),o[1],0,0,0), C1,12); \
    }while(0)
  int t=1;
  #define ENDW(tt) do{ if((tt)+3<NS){WAIT_BAR(2);} else if((tt)+2<NS){WAIT_BAR(1);} else {WAIT_BAR(0);} }while(0)
  for(;t<5&&t+1<NS;t+=2){
    STEP(pB0,pB1,pA0,pA1,t,(t+3<NS),(t+1<NS),(t+1<NS));       ENDW(t);   RESC(); ROT();
    STEP(pA0,pA1,pB0,pB1,t+1,(t+4<NS),(t+2<NS),(t+2<NS));     ENDW(t+1); RESC(); ROT();
  }
  #undef CMASK
  #define CMASK(P0,P1,t) do{}while(0)
  for(;t+5<NS;t+=2){
    STEP(pB0,pB1,pA0,pA1,t,true,true,true);     WAIT_BAR(2); RESC(); ROT();
    STEP(pA0,pA1,pB0,pB1,t+1,true,true,true);   WAIT_BAR(2); RESC(); ROT();
  }
  #undef CMASK
  #define CMASK(P0,P1,t) do{int jb_=3-(t); if(jb_>=0)cmask(P0,P1,jb_,qrel,hi);}while(0)
  for(;t+1<NS;t+=2){
    STEP(pB0,pB1,pA0,pA1,t,(t+3<NS),(t+1<NS),(t+1<NS));       ENDW(t);   RESC(); ROT();
    STEP(pA0,pA1,pB0,pB1,t+1,(t+4<NS),(t+2<NS),(t+2<NS));     ENDW(t+1); RESC(); ROT();
  }
  STEP(pB0,pB1,pA0,pA1,NS-1,false,false,false); RESC();
  { float sacc=pB0[0]+pB0[1]; _Pragma("unroll") for(int r=2;r<16;++r)sacc+=pB0[r]; _Pragma("unroll") for(int r=0;r<16;++r)sacc+=pB1[r]; l_reg+=sacc;
    pw0=(u32x4){PKW(pB0,0),PKW(pB0,2),PKW(pB0,4),PKW(pB0,6)};pw1=(u32x4){PKW(pB0,8),PKW(pB0,10),PKW(pB0,12),PKW(pB0,14)};pw2=(u32x4){PKW(pB1,0),PKW(pB1,2),PKW(pB1,4),PKW(pB1,6)};pw3=(u32x4){PKW(pB1,8),PKW(pB1,10),PKW(pB1,12),PKW(pB1,14)};
    SBAR(); pv(o,vb0+sl_cur,PAF(0),PAF(1),PAF(2),PAF(3)); }
  #undef PKW
  #undef PAF
  #undef VFR
  #undef PIN
  #undef MX3
  #undef GAPA
  #undef GAPB
  #undef EX
  #undef VRD
  #undef KRD
  #undef STEP
  #undef ENDW
  {auto rr=__builtin_amdgcn_permlane32_swap(__float_as_uint(l_reg),__float_as_uint(l_reg),false,false);l_reg=__uint_as_float(rr[0])+__uint_as_float(rr[1]);}
  if(hi==0)wsf[32+r32]=l_reg;asm volatile("s_waitcnt lgkmcnt(0)":::"memory");
  float rli[16];
  #pragma unroll
  for(int r=0;r<16;++r)rli[r]=__builtin_amdgcn_rcpf(wsf[32+crow(r,hi)]);
  bf16*Ow=O+(rowbase+q0+wid*QBLK)*OPITCH+h*D;
  { bf16*stg=(bf16*)(shm+LDS_OST)+wid*2048;
    #pragma unroll
    for(int r=0;r<16;++r){const int orow=crow(r,hi);
      #pragma unroll
      for(int d0=0;d0<2;++d0)stg[orow*64+d0*32+r32]=__float2bfloat16(o[d0][r]*rli[r]);}
    asm volatile("s_waitcnt lgkmcnt(0)":::"memory");
    #pragma unroll
    for(int i=0;i<4;++i){const int row=i*8+(lane>>3),ch=lane&7; const u32x4 v=*(const u32x4*)(stg+row*64+ch*8); ATTN_STORE16(Ow+(long)row*OPITCH+ch*8,v);
      float q=0.f;
      #pragma unroll
      for(int e=0;e<4;++e){const float lo=__uint_as_float(v[e]<<16),hh=__uint_as_float(v[e]&0xffff0000u);q+=lo*lo+hh*hh;}
      q+=__shfl_xor(q,1);q+=__shfl_xor(q,2);q+=__shfl_xor(q,4);
      if(ch==0)SSQ[(rowbase+q0+wid*QBLK+row)*16+8+h]=q;} }
  asm volatile("s_waitcnt lgkmcnt(0)\n\ts_barrier":::"memory");
  #undef DMA_K
  #undef DMA_V
  #undef CMASK
  #undef START
  #undef RESC
  #undef ROT
}
constexpr int ATTN_LDS_BYTES=LDS_BYTES;
struct AttnTensors { const bf16* Q; const bf16* K; const bf16* V; bf16* O; const unsigned long long* KX8; const float* GF; const float* QKB; float* SSQ; };
struct AttnUnit { int bh; int qb; };
struct StaticOrder {
  int vcu;
  __device__ __forceinline__ explicit StaticOrder(int grid,int block):vcu((block%8)*(grid/8)+block/8){}
  __device__ __forceinline__ bool next(int i,AttnUnit&u)const{ if(i>=4)return false; const int s=vcu&7; u.bh=((vcu>>3)+8*i)&31;     u.qb=(i==0)?s:(i==1)?15-s:(i==2)?16+s:31-s; return true; }
  __device__ __forceinline__ void a_ready(const AttnUnit&)const{}
  __device__ __forceinline__ void done(const AttnUnit&)const{}
};
template<class Sched,int THRL=8> __device__ __forceinline__ void attn_phase(char*lds,const AttnTensors&T,const Sched&S,const int tid){
  AttnUnit u;
  for(int i=0;S.next(i,u);++i){ S.a_ready(u); attn_unit<THRL>(u.bh/NHEAD,u.bh%NHEAD,u.qb,T.Q,T.K,T.V,T.O,T.KX8,T.GF,T.QKB,T.SSQ,lds,tid); S.done(u); }
}
#undef SBAR
#undef WAIT_BAR
}

constexpr int NWAVES = 8;
constexpr int N_PHASES = 11;
constexpr int N_LAUNCHES = MK_N_LAUNCHES;

constexpr size_t MiB = 1u << 20;
constexpr size_t WS_CTL = 0, CTL_ZERO_BYTES = 64 * 1024;
constexpr size_t WS_ADAP = 14 * MiB;
constexpr size_t WS_ADA = 2 * MiB;
constexpr size_t WS_WSM = WS_ADA + 128 * 1024;
constexpr size_t WS_LC = 3 * MiB;
constexpr size_t WS_CT = 4 * MiB;
constexpr size_t WS_TOKC = WS_CT + 64 * 1024;
constexpr size_t WS_TW = WS_TOKC + 256 * 1024;
constexpr size_t WS_SSQY = 5 * MiB;
constexpr size_t WS_SSQ1 = 7 * MiB;
constexpr size_t WS_SSQ2 = 9 * MiB;
constexpr size_t WS_INV = 11 * MiB;
constexpr size_t WS_TOK = 14 * MiB;
constexpr size_t WS_SW = WS_TOK + 256 * 1024;
constexpr size_t WS_WIN = 16 * MiB;
constexpr size_t WS_WOUT = 22 * MiB;
constexpr size_t WS_WGU = 24 * MiB;
constexpr size_t WS_WD = 56 * MiB;
constexpr size_t WS_XN = 104 * MiB;
constexpr size_t WS_U = 168 * MiB;
constexpr size_t WS_Y = 328 * MiB;
constexpr size_t WS_H2 = WS_XN;
constexpr size_t WS_H2S = 168 * MiB;
constexpr size_t WS_ACT = 244 * MiB;
constexpr size_t WS_KX8 = 392 * MiB;
constexpr size_t WS_GF = 394 * MiB;
constexpr size_t WS_MIX = 396 * MiB;
constexpr size_t WS_MOE = WS_XN;
constexpr size_t WS_X1 = WS_Y;
constexpr size_t WS_END = 460 * MiB;
static_assert(WS_ACT + (size_t)MAXTILES * 256 * 1024 * 2 <= WS_Y && WS_H2S + (size_t)MAXTILES * 256 * 1024 * 2 <= WS_ACT, "d_ws map");
constexpr int CW_TMO = 0, CW_CODE = 1;
constexpr int CW_CNT = 64, CNT_STRIDE = 64;
constexpr int CW_QKB = 2048;
constexpr int CW_BAR = 4096;
constexpr int RING_OFF = 0, RING_BYTES = 151552;
constexpr int LDSCTL_OFF = RING_BYTES, MISC_OFF = LDSCTL_OFF + 320;
constexpr int TCLS_OFF = LDSCTL_OFF + 512;
constexpr int TFIRST_OFF = LDSCTL_OFF + 704;
constexpr int LCNT_OFF = LDSCTL_OFF + 768;
constexpr int TOKU_OFF = LDSCTL_OFF + 1024;
constexpr int TOKW_OFF = TOKU_OFF + 5120;
static_assert(TOKW_OFF + 5120 <= 163840, "LDS control region");
constexpr int LDS_BYTES = 163840;

#define GAS __attribute__((address_space(1)))
#define LAS __attribute__((address_space(3)))
typedef unsigned short bf16;
typedef unsigned v4u __attribute__((ext_vector_type(4)));
typedef float f32x4 __attribute__((ext_vector_type(4)));
typedef short bf16x8 __attribute__((ext_vector_type(8)));
typedef GAS unsigned gu32;
typedef GAS unsigned long long gu64;
#define RLX_AGENT __ATOMIC_RELAXED, __HIP_MEMORY_SCOPE_AGENT
#define LDS_WAIT() asm volatile("s_waitcnt lgkmcnt(0)" ::: "memory")
#define VM_WAIT() asm volatile("s_waitcnt vmcnt(0)" ::: "memory")
__device__ __forceinline__ unsigned long long rt() { return __builtin_amdgcn_s_memrealtime(); }
__device__ __forceinline__ unsigned f2bf(float f) { unsigned u = __builtin_bit_cast(unsigned, f); return (u + 0x7fffu + ((u >> 16) & 1u)) >> 16; }
typedef float f32x2_hw __attribute__((ext_vector_type(2))); typedef __bf16 bf16x2_hw __attribute__((ext_vector_type(2)));
__device__ __forceinline__ unsigned pk2(float lo, float hi) { const f32x2_hw v = {lo, hi}; const bf16x2_hw b = __builtin_convertvector(v, bf16x2_hw); return __builtin_bit_cast(unsigned, b); }

#define XB_TMO      128
#define XB_XCNT(j)  (256  + 64 * (j))
#define XB_XSUB(j)  (1280 + 64 * (j))
#define XB_XGEN(j)  (2304 + 64 * (j))
#define XB_TOP      3328
#define XB_TOPGEN   3392
#define XCD_BAR_WORDS 3456
#define XB_SPIN_CAP (1u << 18)

__device__ __forceinline__ unsigned xb_ld(unsigned* p)              { return __hip_atomic_load(p, __ATOMIC_RELAXED, __HIP_MEMORY_SCOPE_AGENT); }
__device__ __forceinline__ unsigned xb_add(unsigned* p, unsigned v) { return __hip_atomic_fetch_add(p, v, __ATOMIC_RELAXED, __HIP_MEMORY_SCOPE_AGENT); }
__device__ __forceinline__ unsigned xb_xcc_id() { return (unsigned)__builtin_amdgcn_s_getreg((3 << 11) | 20) & 0xFu; }
#define XB_SPIN(cond, bar) do { unsigned _sp = 0; while (cond) { __builtin_amdgcn_s_sleep(1); \
    if ((++_sp & 255u) == 0u) { if (xb_ld(&(bar)[XB_TMO])) break; if (_sp > XB_SPIN_CAP) { atomicAdd(&(bar)[XB_TMO], 1u); break; } } } } while (0)

struct XcdBarrier {
    unsigned* bar; unsigned x;
    volatile LAS unsigned* st;
};

__device__ __forceinline__ XcdBarrier xcd_barrier_post(unsigned* bar, volatile LAS unsigned* st) {
    XcdBarrier b; b.bar = bar; b.x = xb_xcc_id(); b.st = st;
    if (threadIdx.x == 0) (void)xb_add(&bar[XB_XCNT(b.x)], 1u);
    return b;
}
__device__ __forceinline__ void xcd_barrier_complete(unsigned* bar, unsigned x, unsigned& nloc, unsigned& nx) {
    const unsigned G = gridDim.x * gridDim.y * gridDim.z;
    unsigned sum, cnt, mine, sp = 0u;
    for (;;) {
        sum = 0u; cnt = 0u; mine = 0u;
#pragma unroll
        for (unsigned j = 0; j < 16; ++j) { const unsigned c = xb_ld(&bar[XB_XCNT(j)]); sum += c; cnt += (c > 0u) ? 1u : 0u; mine = (j == x) ? c : mine; }
        if (sum == G) break;
        __builtin_amdgcn_s_sleep(1);
        if ((++sp & 255u) == 0u) { if (xb_ld(&bar[XB_TMO])) break; if (sp > XB_SPIN_CAP) { atomicAdd(&bar[XB_TMO], 1u); break; } }
    }
    nloc = mine > 0u ? mine : 1u; nx = cnt > 0u ? cnt : 1u;
}

__device__ __forceinline__ void xcd_barrier(const XcdBarrier& b) {
    asm volatile("s_waitcnt vmcnt(0)" ::: "memory");
    __syncthreads();
    if (threadIdx.x == 0) {
        unsigned* bar = b.bar;
        __builtin_amdgcn_s_waitcnt(0);
        unsigned nloc = b.st[0], nx = b.st[1];
        if (nloc == 0u) { xcd_barrier_complete(bar, b.x, nloc, nx); b.st[0] = nloc; b.st[1] = nx; }
        const unsigned old = xb_add(&bar[XB_XSUB(b.x)], 1u);
        const unsigned gen = old / nloc;
        if (old + 1u == (gen + 1u) * nloc) {
            __builtin_amdgcn_fence(__ATOMIC_RELEASE, "agent");
            asm volatile("s_waitcnt vmcnt(0)" ::: "memory");
            const unsigned og = xb_add(&bar[XB_TOP], 1u);
            const unsigned tg = og / nx;
            if (og + 1u == (tg + 1u) * nx) xb_add(&bar[XB_TOPGEN], 1u);
            else XB_SPIN(xb_ld(&bar[XB_TOPGEN]) == tg, bar);
            __builtin_amdgcn_fence(__ATOMIC_ACQUIRE, "agent");
            xb_add(&bar[XB_XGEN(b.x)], 1u);
            asm volatile("s_waitcnt vmcnt(0)" ::: "memory");
        } else {
            XB_SPIN(xb_ld(&bar[XB_XGEN(b.x)]) == gen, bar);
            __builtin_amdgcn_fence(__ATOMIC_ACQUIRE, "agent");
            asm volatile("s_waitcnt vmcnt(0)" ::: "memory");
        }
    }
    __syncthreads();
}

struct Frame {
    LAS unsigned char* lds;
    volatile LAS unsigned* MISC;
    gu32* ctl;
    int tid, lane, wave;
    int vcu, G;
    unsigned char* ws;
    const float *x, *c, *w_ada, *b_ada, *g_mix, *w_in, *g_sgu, *w_sp, *b_sp, *b_fg, *g_osgu, *g_ofox, *w_out, *g_ffn, *w_rg, *b_rg, *w_re, *b_re, *w_gate, *w_up, *w_down, *g_fin;
    float* out;
};
#define DPP_ADD(v, ctrl) ((v) + __builtin_bit_cast(float, __builtin_amdgcn_update_dpp(0, __builtin_bit_cast(int, (v)), (ctrl), 0xf, 0xf, false)))
__device__ __forceinline__ float wave_sum(float v) {
    v = DPP_ADD(v, 0xB1); v = DPP_ADD(v, 0x4E); v = DPP_ADD(v, 0x141); v = DPP_ADD(v, 0x140);
    const int iv = __builtin_bit_cast(int, v);
    const float a = __builtin_bit_cast(float, __builtin_amdgcn_readlane(iv, 0)), b = __builtin_bit_cast(float, __builtin_amdgcn_readlane(iv, 16)), c = __builtin_bit_cast(float, __builtin_amdgcn_readlane(iv, 32)), e = __builtin_bit_cast(float, __builtin_amdgcn_readlane(iv, 48));
    return (a + b) + (c + e);
}
#define DPP_MOV(v, ctrl) __builtin_bit_cast(float, __builtin_amdgcn_update_dpp(0, __builtin_bit_cast(int, (v)), (ctrl), 0xf, 0xf, false))
#define SWZ_ADD(v, pat) ((v) + __builtin_bit_cast(float, __builtin_amdgcn_ds_swizzle(__builtin_bit_cast(int, (v)), (pat))))
__device__ __forceinline__ float sum_b2_b5(float v) { v = SWZ_ADD(v, 0x101F); v = SWZ_ADD(v, 0x201F); v = SWZ_ADD(v, 0x401F);
    const auto rr = __builtin_amdgcn_permlane32_swap(__float_as_uint(v), __float_as_uint(v), false, false); return __uint_as_float(rr[0]) + __uint_as_float(rr[1]); }
__device__ __forceinline__ void wave_sum8_t(const float (&v)[8], int lane, float& r0, float& r1) {
    const bool b0 = (lane & 1) != 0, b1 = (lane & 2) != 0; float a[4], c[2];
#pragma unroll
    for (int i = 0; i < 4; ++i) { const float keep = b0 ? v[i + 4] : v[i], send = b0 ? v[i] : v[i + 4]; a[i] = keep + DPP_MOV(send, 0xB1); }
#pragma unroll
    for (int i = 0; i < 2; ++i) { const float keep = b1 ? a[i + 2] : a[i], send = b1 ? a[i] : a[i + 2]; c[i] = keep + DPP_MOV(send, 0x4E); }
    r0 = sum_b2_b5(c[0]); r1 = sum_b2_b5(c[1]);
}
__device__ __forceinline__ void wave_sum4_all(float (&v)[4], int lane) {
    const bool b0 = (lane & 1) != 0, b1 = (lane & 2) != 0; float a[2];
#pragma unroll
    for (int i = 0; i < 2; ++i) { const float keep = b0 ? v[i + 2] : v[i], send = b0 ? v[i] : v[i + 2]; a[i] = keep + DPP_MOV(send, 0xB1); }
    const float keep = b1 ? a[1] : a[0], send = b1 ? a[0] : a[1]; float c = keep + DPP_MOV(send, 0x4E);
    c = sum_b2_b5(c); const int ic = __builtin_bit_cast(int, c);
    v[0] = __builtin_bit_cast(float, __builtin_amdgcn_readlane(ic, 0)); v[1] = __builtin_bit_cast(float, __builtin_amdgcn_readlane(ic, 2)); v[2] = __builtin_bit_cast(float, __builtin_amdgcn_readlane(ic, 1)); v[3] = __builtin_bit_cast(float, __builtin_amdgcn_readlane(ic, 3));
}
__device__ __forceinline__ float wave_max(float v) {
#pragma unroll
    for (int o = 1; o < 64; o <<= 1) v = fmaxf(v, __shfl_xor(v, o));
    return v;
}
__device__ __forceinline__ int lane_id_fresh() { int t, l; asm volatile("v_mbcnt_lo_u32_b32 %0, -1, 0" : "=v"(t)); asm volatile("v_mbcnt_hi_u32_b32 %0, -1, %1" : "=v"(l) : "v"(t)); return l; }
__device__ __forceinline__ float bf2f(unsigned short h) { return __uint_as_float((unsigned)h << 16); }

__device__ __forceinline__ void p0_tr_item(const float* W, int ldw, int k0, int n0, bf16* dst, int ldt, const float* kscale, LAS float* scr, int lane) {
    typedef float f32x2_t __attribute__((ext_vector_type(2)));
    f32x2_t tv[32];
#pragma unroll
    for (int i = 0; i < 32; ++i) { const int kk = 2 * i + (lane >> 5); tv[i] = *(const f32x2_t*)(W + (size_t)(k0 + kk) * ldw + n0 + 2 * (lane & 31)); }
    if (kscale) {
#pragma unroll
        for (int i = 0; i < 32; ++i) tv[i] = tv[i] * kscale[k0 + 2 * i + (lane >> 5)]; }
#pragma unroll
    for (int i = 0; i < 32; ++i) { LAS float* p = scr + (2 * i + (lane >> 5)) * 65 + 2 * (lane & 31); p[0] = tv[i].x; p[1] = tv[i].y; }
    LDS_WAIT(); asm volatile("" ::: "memory");
    const int c = lane & 7;
#pragma unroll
    for (int j = 0; j < 8; ++j) { const int n = (lane >> 3) + 8 * j; const LAS float* s = scr + (8 * c) * 65 + n;
        v4u o; o.x = pk2(s[0 * 65], s[1 * 65]); o.y = pk2(s[2 * 65], s[3 * 65]); o.z = pk2(s[4 * 65], s[5 * 65]); o.w = pk2(s[6 * 65], s[7 * 65]);
        *(GAS v4u*)(dst + (size_t)n * ldt + 8 * c) = o; }
    LDS_WAIT(); asm volatile("" ::: "memory");
}
__device__ __forceinline__ void p0_tr_item8(const float* W, int ldw, int k0, int n0, unsigned char* dst, int ldt, float scale, LAS float* scr, int lane) {
    typedef float f32x2_t __attribute__((ext_vector_type(2))); typedef int v2i_t __attribute__((ext_vector_type(2)));
    f32x2_t tv[32];
#pragma unroll
    for (int i = 0; i < 32; ++i) { const int kk = 2 * i + (lane >> 5); tv[i] = *(const f32x2_t*)(W + (size_t)(k0 + kk) * ldw + n0 + 2 * (lane & 31)); }
#pragma unroll
    for (int i = 0; i < 32; ++i) { LAS float* p = scr + (2 * i + (lane >> 5)) * 65 + 2 * (lane & 31); p[0] = __builtin_amdgcn_fmed3f(tv[i].x * scale, -448.f, 448.f); p[1] = __builtin_amdgcn_fmed3f(tv[i].y * scale, -448.f, 448.f); }
    LDS_WAIT(); asm volatile("" ::: "memory");
    const int c = lane & 7;
#pragma unroll
    for (int j = 0; j < 8; ++j) { const int n = (lane >> 3) + 8 * j; const LAS float* s = scr + (8 * c) * 65 + n; int p0 = 0, p1 = 0;
        p0 = __builtin_amdgcn_cvt_pk_fp8_f32(s[0 * 65], s[1 * 65], p0, false); p0 = __builtin_amdgcn_cvt_pk_fp8_f32(s[2 * 65], s[3 * 65], p0, true);
        p1 = __builtin_amdgcn_cvt_pk_fp8_f32(s[4 * 65], s[5 * 65], p1, false); p1 = __builtin_amdgcn_cvt_pk_fp8_f32(s[6 * 65], s[7 * 65], p1, true);
        *(v2i_t*)(dst + (size_t)n * ldt + 8 * c) = (v2i_t){p0, p1}; }
    LDS_WAIT(); asm volatile("" ::: "memory");
}
__device__ __forceinline__ void p0_prologue(Frame& F) {
    LAS float* scr = (LAS float*)(F.lds + RING_OFF + F.wave * 16896);
    const int gw = F.vcu * NWAVES + F.wave, NGW = F.G * NWAVES;
    bf16* WIN = (bf16*)(F.ws + WS_WIN); bf16* WOUT = (bf16*)(F.ws + WS_WOUT); bf16* WGU = (bf16*)(F.ws + WS_WGU); bf16* WD = (bf16*)(F.ws + WS_WD);
    constexpr int I_ADA = 16 * 24;
    constexpr int I_IN = (D / 64) * (NPROJ / 64);
    constexpr int I_OUT = (D / 64) * (D / 64);
    constexpr int I_GU1 = (D / 64) * (DEXP / 64);
    constexpr int I_GU = NEXP * 2 * I_GU1;
    constexpr int I_DC1 = (DEXP / 64) * (D / 64);
    constexpr int I_DC = NEXP * I_DC1;
    constexpr int I_SM = 8 * 128 * 128 / 512;
    constexpr int NITEMS = I_ADA + I_IN + I_OUT + I_SM;
    for (int it = gw; it < NITEMS; it += NGW) {
        int r = it;
        if (r < I_ADA) {
            const int kp = r / 24, cg = r % 24; const int n = cg * 256 + F.lane * 4;
            f32x4 a0 = {0.f, 0.f, 0.f, 0.f}, a1 = a0, a2 = a0, a3 = a0;
#pragma unroll
            for (int q = 0; q < 4; ++q) { const int idx = q * 64 + F.lane; const float cv = F.c[(idx >> 6) * D + kp * 64 + (idx & 63)]; scr[idx] = cv / (1.f + __expf(-cv)); }
            LDS_WAIT(); asm volatile("" ::: "memory");
#pragma unroll 2
            for (int k0 = 0; k0 < 64; k0 += 32) { f32x4 w[32];
#pragma unroll
                for (int kk = 0; kk < 32; ++kk) w[kk] = *(const f32x4*)(F.w_ada + (size_t)(kp * 64 + k0 + kk) * NADA + n);
#pragma unroll
                for (int kk = 0; kk < 32; ++kk) { a0 += w[kk] * scr[k0 + kk]; a1 += w[kk] * scr[64 + k0 + kk]; a2 += w[kk] * scr[128 + k0 + kk]; a3 += w[kk] * scr[192 + k0 + kk]; } }
            LDS_WAIT(); asm volatile("" ::: "memory");
            float* P = (float*)(F.ws + WS_ADAP) + (size_t)kp * 4 * NADA + n;
            *(f32x4*)(P) = a0; *(f32x4*)(P + NADA) = a1; *(f32x4*)(P + 2 * NADA) = a2; *(f32x4*)(P + 3 * NADA) = a3;
            continue; }
        r -= I_ADA;
        if (r < I_IN) { const int kb = r / (NPROJ / 64), nb = r % (NPROJ / 64); p0_tr_item(F.w_in, LDW_IN, 64 * kb, 64 * nb, WIN + (size_t)(64 * nb) * D + 64 * kb, D, nullptr, scr, F.lane); continue; }
        r -= I_IN;
        if (r < I_OUT) { const int kb = r / (D / 64), nb = r % (D / 64); const int k0 = 64 * kb;
            p0_tr_item(F.w_out, D, k0, 64 * nb, WOUT + (size_t)(64 * nb) * D + (k0 < DH ? k0 + DH : k0 - DH), D, k0 < DH ? F.g_osgu : F.g_ofox - DH, scr, F.lane); continue; }
        r -= I_OUT;
        { bf16* WSM = (bf16*)(F.ws + WS_WSM);
#pragma unroll
          for (int j = 0; j < 8; ++j) { const int idx = r * 512 + j * 64 + F.lane; const int tt = (idx >> 7) & 127, ss = idx & 127; const float v = F.w_sp[idx]; WSM[idx] = (bf16)f2bf(ss <= tt ? v : 0.f); } }
    }
}

__device__ __forceinline__ void p3_convert(Frame& F) {
    int lane = lane_id_fresh();
    LAS float* scr = (LAS float*)(F.lds + RING_OFF + F.wave * 16896);
    bf16* WGU = (bf16*)(F.ws + WS_WGU); bf16* WD = (bf16*)(F.ws + WS_WD);
    constexpr int I_GU1 = (D / 64) * (DEXP / 64), I_GU = NEXP * 2 * I_GU1, I_DC1 = (DEXP / 64) * (D / 64), I_DC = NEXP * I_DC1, NIT = I_GU + I_DC;
    const int s = F.vcu & 7; const int cnt8 = s == 0 ? 50 : s == 1 ? 35 : s == 2 ? 28 : s == 7 ? 15 : 16; const int pre8 = s == 0 ? 0 : s == 1 ? 50 : s == 2 ? 85 : 113 + 16 * (s - 3);
    static_assert(NIT == 32 * 192, "item split");
    const int lo = (F.vcu >> 3) * 192 + pre8;
    __syncthreads();
    for (int it = lo + F.wave; it < lo + cnt8; it += NWAVES) {
        int r = it;
        if (r < I_GU) { const int e = r / (2 * I_GU1), r2 = r % (2 * I_GU1), isup = r2 / I_GU1, r3 = r2 % I_GU1; const int kb = r3 / (DEXP / 64), nb = r3 % (DEXP / 64); const int n0 = 64 * nb;
            const float* W = (isup ? F.w_up : F.w_gate) + (size_t)e * D * DEXP; const int drow = (n0 >> 7) * 256 + isup * 128 + (n0 & 127);
#if MOE_FP8
            p0_tr_item8(W, DEXP, 64 * kb, n0, (unsigned char*)WGU + ((size_t)e * 1024 + drow) * D + 64 * kb, D, 64.f, scr, lane); continue; }
#else
            p0_tr_item(W, DEXP, 64 * kb, n0, WGU + ((size_t)e * 1024 + drow) * D + 64 * kb, D, nullptr, scr, lane); continue; }
#endif
        r -= I_GU;
        if (r < I_DC) { const int e = r / I_DC1, r3 = r % I_DC1; const int kb = r3 / (D / 64), nb = r3 % (D / 64);
#if MOE_FP8
            p0_tr_item8(F.w_down + (size_t)e * DEXP * D, D, 64 * kb, 64 * nb, (unsigned char*)WD + ((size_t)e * D + 64 * nb) * DEXP + 64 * kb, DEXP, 64.f, scr, lane); continue; }
#else
            p0_tr_item(F.w_down + (size_t)e * DEXP * D, D, 64 * kb, 64 * nb, WD + ((size_t)e * D + 64 * nb) * DEXP + 64 * kb, DEXP, nullptr, scr, lane); continue; }
#endif
    }
    __syncthreads();
}
__device__ __forceinline__ void p1_load(Frame& F, f32x4 (&v)[2][4], int ch, int rl) {
#pragma unroll
    for (int rr = 0; rr < 2; ++rr) { const f32x4* xr = (const f32x4*)(F.x + (size_t)(ch * 128 + rl + 8 * rr) * D) + F.lane;
#pragma unroll
        for (int j = 0; j < 4; ++j) v[rr][j] = xr[64 * j]; }
}
__device__ __forceinline__ void p1_rows(Frame& F, f32x4 (&v)[2][4], int ch, int rl, const LAS float* modA, const LAS float* modB, const LAS float* wf, LAS float* gi, bf16* XN) {
            float s[2] = {0.f, 0.f};
#pragma unroll
            for (int rr = 0; rr < 2; ++rr)
#pragma unroll
                for (int j = 0; j < 4; ++j) s[rr] += (v[rr][j].x * v[rr][j].x + v[rr][j].y * v[rr][j].y) + (v[rr][j].z * v[rr][j].z + v[rr][j].w * v[rr][j].w);
#pragma unroll
            for (int rr = 0; rr < 2; ++rr) { const int m = ch * 128 + rl + 8 * rr;
                const float rstd = 1.f / sqrtf(wave_sum(s[rr]) * (1.f / D) + EPS);
                float fl[8];
#pragma unroll
                for (int q = 0; q < 8; ++q) fl[q] = 0.f;
                unsigned long long* o8 = (unsigned long long*)(XN + (size_t)m * D) + F.lane;
#pragma unroll
                for (int j = 0; j < 4; ++j) { const int k0 = 4 * F.lane + 256 * j; float h[4];
#pragma unroll
                    for (int e = 0; e < 4; ++e) { h[e] = v[rr][j][e] * rstd * modA[k0 + e] + modB[k0 + e];
#pragma unroll
                        for (int q = 0; q < 8; ++q) fl[q] += h[e] * wf[q * D + k0 + e]; }
                    o8[64 * j] = (unsigned long long)pk2(h[0], h[1]) | ((unsigned long long)pk2(h[2], h[3]) << 32); }
                float r0, r1; wave_sum8_t(fl, F.lane, r0, r1);
                if (F.lane < 4) { const int q0 = 4 * (F.lane & 1) + 2 * (F.lane >> 1);
#pragma unroll
                    for (int e = 0; e < 2; ++e) { const float z = (e ? r1 : r0) + F.b_fg[q0 + e];
                        const float sp = fmaxf(-z, 0.f) + log1pf(expf(-fabsf(z)));
                        gi[(rl + 8 * rr) * 8 + q0 + e] = sp * LOG2E; } } }
}
__device__ __forceinline__ void p1_prenorm(Frame& F) {
    const float* ADAP = (const float*)(F.ws + WS_ADAP); float* ADA = (float*)(F.ws + WS_ADA);
    for (int i = blockIdx.x * (NWAVES * 64) + F.tid; i < BATCH * NADA; i += F.G * NWAVES * 64) { float s = F.b_ada[i % NADA];
#pragma unroll
        for (int p = 0; p < 16; ++p) s += ADAP[(size_t)p * BATCH * NADA + i];
        ADA[i] = s; }
    LAS float* modA = (LAS float*)(F.lds);
    LAS float* modB = modA + 1024;
    LAS float* wf = modB + 1024;
    LAS float* gi = wf + 8192;
    bf16* XN = (bf16*)(F.ws + WS_XN); float* LC = (float*)(F.ws + WS_LC); float* CT = (float*)(F.ws + WS_CT);
    for (int ch = blockIdx.x; ch < M / 128; ch += F.G) {
        const int b = ch / (T / 128);
        __syncthreads();
        for (int k = F.tid; k < D; k += NWAVES * 64) { float sh = F.b_ada[k], sc = F.b_ada[D + k];
#pragma unroll
            for (int p = 0; p < 16; ++p) { sh += ADAP[((size_t)p * BATCH + b) * NADA + k]; sc += ADAP[((size_t)p * BATCH + b) * NADA + D + k]; }
            modA[k] = F.g_mix[k] * (1.f + sc); modB[k] = sh; }
        for (int i = F.tid; i < D * 8; i += NWAVES * 64) wf[(i & 7) * D + (i >> 3)] = F.w_in[(size_t)(i >> 3) * LDW_IN + NPROJ + (i & 7)];
        __syncthreads();
        { f32x4 va[2][4], vb[2][4];
            p1_load(F, va, ch, F.wave);
#pragma unroll 1
            for (int it = 0; it < 4; ++it) {
                p1_load(F, vb, ch, F.wave + 16 * (2 * it + 1));
                p1_rows(F, va, ch, F.wave + 16 * (2 * it), modA, modB, wf, gi, XN);
                if (it < 3) p1_load(F, va, ch, F.wave + 16 * (2 * it + 2));
                p1_rows(F, vb, ch, F.wave + 16 * (2 * it + 1), modA, modB, wf, gi, XN);
            } }
        __syncthreads();
        { const int h = F.wave; float* lc = LC + ((size_t)b * NH + h) * T + (ch % (T / 128)) * 128;
            const float a0 = gi[(2 * F.lane) * 8 + h], a1 = gi[(2 * F.lane + 1) * 8 + h]; float sc = a0 + a1;
#pragma unroll
            for (int o = 1; o < 64; o <<= 1) { const float t = __shfl_up(sc, o); if (F.lane >= o) sc += t; }
            lc[2 * F.lane] = sc - a1; lc[2 * F.lane + 1] = sc;
            if (F.lane == 63) CT[((size_t)b * NH + h) * (T / 128) + (ch % (T / 128))] = sc; }
    }
    __syncthreads();
}

__device__ __forceinline__ void p3_sgu_naive(Frame& F) {
    const bf16* U = (const bf16*)(F.ws + WS_U); const bf16* VS = U + (size_t)M * DH; const bf16* WSM = (const bf16*)(F.ws + WS_WSM);
    bf16* Y = (bf16*)(F.ws + WS_Y); float* SSQY = (float*)(F.ws + WS_SSQY);
    LAS bf16* vn = (LAS bf16*)(F.lds);
    const int h = F.wave, c = F.tid;
    for (int ch = blockIdx.x; ch < M / 128; ch += F.G) {
        __syncthreads();
        const float gs = F.g_sgu[h * 64 + F.lane];
        for (int s = 0; s < 128; ++s) { const size_t m = (size_t)ch * 128 + s; const float val = bf2f(VS[m * DH + c]); const float q = wave_sum(val * val);
            vn[s * DH + c] = (bf16)f2bf(val * (1.f / sqrtf(q * (1.f / 64.f) + EPS)) * gs); }
        __syncthreads();
        for (int t = 0; t < 128; ++t) { float z = F.b_sp[h * 128 + t]; const bf16* wrow = WSM + ((size_t)h * 128 + t) * 128;
            for (int s = 0; s <= t; ++s) z += bf2f(wrow[s]) * bf2f(vn[s * DH + c]);
            const size_t m = (size_t)ch * 128 + t; const float y = bf2f(U[m * DH + c]) * z;
            Y[m * D + DH + c] = (bf16)f2bf(y); const float q = wave_sum(y * y); if (F.lane == 0) SSQY[m * 16 + h] = q; }
    }
    __syncthreads();
}
__device__ __forceinline__ void p3_sgu(Frame& F) {
    typedef short s16x4_t __attribute__((ext_vector_type(4))); typedef float f32x16_t __attribute__((ext_vector_type(16)));
    const bf16* U = (const bf16*)(F.ws + WS_U); const bf16* VS = U + (size_t)M * DH; const bf16* WSM = (const bf16*)(F.ws + WS_WSM);
    bf16* Y = (bf16*)(F.ws + WS_Y); float* SSQY = (float*)(F.ws + WS_SSQY);
    constexpr int RS = 144;
    const int h = F.wave, lane = F.lane, c8 = lane & 7, kg = lane >> 5, t32 = lane & 31;
    LAS unsigned char* vreg = F.lds + h * (128 * RS);
    LAS float* bsl = (LAS float*)(F.lds + 8 * 128 * RS) + h * 128;
    float gsc[8];
#pragma unroll
    for (int e = 0; e < 8; ++e) gsc[e] = F.g_sgu[h * 64 + c8 * 8 + e];
    const int trb = (8 * (lane >> 5) + ((lane & 15) >> 2)) * RS + (16 * ((lane >> 4) & 1) + 4 * (lane & 3)) * 2;
    for (int ch = blockIdx.x; ch < M / 128; ch += F.G) {
        const size_t row0 = (size_t)ch * 128;
        asm volatile("s_waitcnt lgkmcnt(0)" ::: "memory");
        uint4 pre[16];
#pragma unroll
        for (int it = 0; it < 16; ++it) pre[it] = *(const uint4*)(VS + (row0 + it * 8 + (lane >> 3)) * DH + h * 64 + c8 * 8);
#pragma unroll
        for (int it = 0; it < 16; ++it) { const int r = it * 8 + (lane >> 3); const uint4 w = pre[it]; const unsigned ww[4] = {w.x, w.y, w.z, w.w};
            float v[8]; float q = 0.f;
#pragma unroll
            for (int e = 0; e < 4; ++e) { v[2 * e] = __uint_as_float(ww[e] << 16); v[2 * e + 1] = __uint_as_float(ww[e] & 0xffff0000u); q += v[2 * e] * v[2 * e] + v[2 * e + 1] * v[2 * e + 1]; }
            q = DPP_ADD(q, 0xB1); q = DPP_ADD(q, 0x4E); q = DPP_ADD(q, 0x141);
            const float rstd = 1.f / sqrtf(q * (1.f / 64.f) + EPS);
            v4u o; o.x = pk2(v[0] * rstd * gsc[0], v[1] * rstd * gsc[1]); o.y = pk2(v[2] * rstd * gsc[2], v[3] * rstd * gsc[3]); o.z = pk2(v[4] * rstd * gsc[4], v[5] * rstd * gsc[5]); o.w = pk2(v[6] * rstd * gsc[6], v[7] * rstd * gsc[7]);
            *(LAS v4u*)(vreg + r * RS + c8 * 16) = o; }
        bsl[lane] = F.b_sp[h * 128 + lane]; bsl[lane + 64] = F.b_sp[h * 128 + 64 + lane];
        asm volatile("s_waitcnt lgkmcnt(0)" ::: "memory");
        f32x16_t acc[4][2];
#pragma unroll
        for (int tb = 0; tb < 4; ++tb) { acc[tb][0] = f32x16_t{}; acc[tb][1] = f32x16_t{}; }
#pragma unroll
        for (int tb = 0; tb < 4; ++tb)
#pragma unroll
            for (int ks = 0; ks < 2 * tb + 2; ++ks) {
                const bf16x8 a = *(const bf16x8*)(WSM + ((size_t)(h * 128 + 32 * tb + t32)) * 128 + 16 * ks + 8 * kg);
#pragma unroll
                for (int db = 0; db < 2; ++db) {
                    const s16x4_t lo = __builtin_bit_cast(s16x4_t, __builtin_amdgcn_ds_read_tr16_b64_v4i16((LAS s16x4_t*)(vreg + trb + (16 * ks) * RS + db * 64)));
                    const s16x4_t hi = __builtin_bit_cast(s16x4_t, __builtin_amdgcn_ds_read_tr16_b64_v4i16((LAS s16x4_t*)(vreg + trb + (16 * ks + 4) * RS + db * 64)));
                    const bf16x8 bfr = {lo[0], lo[1], lo[2], lo[3], hi[0], hi[1], hi[2], hi[3]};
                    acc[tb][db] = __builtin_amdgcn_mfma_f32_32x32x16_bf16(a, bfr, acc[tb][db], 0, 0, 0); } }
        asm volatile("s_waitcnt lgkmcnt(0)" ::: "memory");
#pragma unroll
        for (int tb = 0; tb < 4; ++tb)
#pragma unroll
            for (int db = 0; db < 2; ++db)
#pragma unroll
                for (int r = 0; r < 16; ++r) { const int t = 32 * tb + (r & 3) + 8 * (r >> 2) + 4 * kg;
                    *(LAS unsigned short*)(vreg + t * RS + (32 * db + t32) * 2) = (unsigned short)f2bf(acc[tb][db][r] + bsl[t]); }
        asm volatile("s_waitcnt lgkmcnt(0)" ::: "memory");
#pragma unroll
        for (int it = 0; it < 16; ++it) pre[it] = *(const uint4*)(U + (row0 + it * 8 + (lane >> 3)) * DH + h * 64 + c8 * 8);
#pragma unroll
        for (int it = 0; it < 16; ++it) { const int r = it * 8 + (lane >> 3); const v4u zz = *(const LAS v4u*)(vreg + r * RS + c8 * 16); const uint4 uu = pre[it];
            const unsigned zw[4] = {zz.x, zz.y, zz.z, zz.w}, uw[4] = {uu.x, uu.y, uu.z, uu.w}; unsigned ow[4]; float q = 0.f;
#pragma unroll
            for (int e = 0; e < 4; ++e) { const float y0 = __uint_as_float(zw[e] << 16) * __uint_as_float(uw[e] << 16), y1 = __uint_as_float(zw[e] & 0xffff0000u) * __uint_as_float(uw[e] & 0xffff0000u);
                q += y0 * y0 + y1 * y1; ow[e] = pk2(y0, y1); }
            q = DPP_ADD(q, 0xB1); q = DPP_ADD(q, 0x4E); q = DPP_ADD(q, 0x141);
            v4u o; o.x = ow[0]; o.y = ow[1]; o.z = ow[2]; o.w = ow[3];
            *(v4u*)(Y + (row0 + r) * D + DH + h * 64 + c8 * 8) = o;
            if (c8 == 0) SSQY[(row0 + r) * 16 + h] = q; }
    }
    asm volatile("s_waitcnt lgkmcnt(0)" ::: "memory");
    __syncthreads();
}
__device__ __forceinline__ void p3_attn_naive(Frame& F) {
    const bf16* Q = (const bf16*)(F.ws + WS_U) + (size_t)2 * M * DH; const bf16* K = Q + (size_t)M * DH; const bf16* V = K + (size_t)M * DH;
    const float* LC = (const float*)(F.ws + WS_LC); const float* CT = (const float*)(F.ws + WS_CT);
    bf16* Y = (bf16*)(F.ws + WS_Y); float* SSQY = (float*)(F.ws + WS_SSQY);
    LAS float* Gabs = (LAS float*)(F.lds);
    LAS float* pre = Gabs + T;
    for (int item = blockIdx.x; item < BATCH * NH * 8; item += F.G) {
        const int bh = item >> 3, r = item & 7, b = bh / NH, h = bh % NH;
        __syncthreads();
        if (F.tid < 64) { float a = 0.f; for (int c2 = 0; c2 < F.tid; ++c2) a += CT[bh * 64 + c2]; pre[F.tid] = a; }
        __syncthreads();
        for (int t = F.tid; t < T; t += NWAVES * 64) Gabs[t] = pre[t >> 7] + LC[(size_t)bh * T + t];
        __syncthreads();
        for (int n = F.wave; n < T / 8; n += NWAVES) {
            const int i = 8 * n + r; const size_t rowi = (size_t)b * T + i;
            float qf[64];
            { const uint4* q4 = (const uint4*)(Q + rowi * DH + h * HD);
#pragma unroll
              for (int c4 = 0; c4 < 8; ++c4) { const uint4 w = q4[c4]; const unsigned ww[4] = {w.x, w.y, w.z, w.w};
#pragma unroll
                  for (int e = 0; e < 4; ++e) { qf[c4 * 8 + 2 * e] = __uint_as_float(ww[e] << 16); qf[c4 * 8 + 2 * e + 1] = __uint_as_float(ww[e] & 0xffff0000u); } } }
            const float Gi = Gabs[i];
            float mx = -1e30f, l = 0.f; float o[64];
#pragma unroll
            for (int d = 0; d < 64; ++d) o[d] = 0.f;
            for (int j = F.lane; j <= i; j += 64) {
                const size_t rowj = (size_t)b * T + j; const uint4* k4 = (const uint4*)(K + rowj * DH + h * HD); const uint4* v4 = (const uint4*)(V + rowj * DH + h * HD);
                float s = 0.f;
#pragma unroll
                for (int c4 = 0; c4 < 8; ++c4) { const uint4 w = k4[c4]; const unsigned ww[4] = {w.x, w.y, w.z, w.w};
#pragma unroll
                    for (int e = 0; e < 4; ++e) { s += qf[c4 * 8 + 2 * e] * __uint_as_float(ww[e] << 16); s += qf[c4 * 8 + 2 * e + 1] * __uint_as_float(ww[e] & 0xffff0000u); } }
                s += Gabs[j] - Gi;
                if (s > mx) { const float f = __builtin_amdgcn_exp2f(mx - s); l *= f;
#pragma unroll
                    for (int d = 0; d < 64; ++d) o[d] *= f;
                    mx = s; }
                const float p = __builtin_amdgcn_exp2f(s - mx); l += p;
#pragma unroll
                for (int c4 = 0; c4 < 8; ++c4) { const uint4 w = v4[c4]; const unsigned ww[4] = {w.x, w.y, w.z, w.w};
#pragma unroll
                    for (int e = 0; e < 4; ++e) { o[c4 * 8 + 2 * e] += p * __uint_as_float(ww[e] << 16); o[c4 * 8 + 2 * e + 1] += p * __uint_as_float(ww[e] & 0xffff0000u); } }
            }
            const float Mx = wave_max(mx); const float f = __builtin_amdgcn_exp2f(mx - Mx); l *= f; const float L = wave_sum(l);
            float y = 0.f;
#pragma unroll
            for (int d = 0; d < 64; ++d) { const float od = wave_sum(o[d] * f); y = (F.lane == d) ? od : y; }
            y = y / L;
            Y[rowi * D + h * HD + F.lane] = (bf16)f2bf(y);
            const float q = wave_sum(y * y); if (F.lane == 0) SSQY[rowi * 16 + 8 + h] = q;
        }
    }
    __syncthreads();
}
__device__ __forceinline__ void p2_kx(Frame& F) {
    const float* LC = (const float*)(F.ws + WS_LC); const float* CT = (const float*)(F.ws + WS_CT);
    unsigned long long* KX8 = (unsigned long long*)(F.ws + WS_KX8); float* GF = (float*)(F.ws + WS_GF);
    const int gw = F.vcu * NWAVES + F.wave, NGW = F.G * NWAVES;
    for (int pr = gw; pr < BATCH * NH * (T / 128); pr += NGW) { const int bh = pr >> 6, ch = pr & 63;
        const float base = wave_sum(F.lane < ch ? CT[bh * 64 + F.lane] : 0.f);
#pragma unroll
        for (int e = 0; e < 2; ++e) { const size_t t = (size_t)bh * T + ch * 128 + e * 64 + F.lane; const float G = base + LC[t];
            const unsigned gh = f2bf(G); const float r1 = G - __uint_as_float(gh << 16); const unsigned gm = f2bf(r1); const float r2 = r1 - __uint_as_float(gm << 16); const unsigned gl = f2bf(r2);
            KX8[t] = (unsigned long long)(gh | (gm << 16)) | ((unsigned long long)(gl | (0x3F80u << 16)) << 32); GF[t] = G; } }
}
__device__ __forceinline__ void p6_load(Frame& F, f32x4 (&xv)[2][4], uint2 (&mv)[2][4], const bf16* MIX, int mrow) {
#pragma unroll
    for (int rr = 0; rr < 2; ++rr) { const size_t m = (size_t)mrow + rr; const f32x4* xr = (const f32x4*)(F.x + m * D) + F.lane; const uint2* mr = (const uint2*)(MIX + m * D) + F.lane;
#pragma unroll
        for (int j = 0; j < 4; ++j) { xv[rr][j] = xr[64 * j]; mv[rr][j] = mr[64 * j]; } }
}
__device__ __forceinline__ void p6_rows(Frame& F, f32x4 (&xv)[2][4], uint2 (&mv)[2][4], int m0, int r0, int RPW, const f32x4 (&cg1)[4], const f32x4 (&cA)[4], const f32x4 (&cB)[4],
                                        const LAS float* wrg, const LAS float* wre, LAS unsigned* lcnt, LAS unsigned* rinfo, bf16* H2, bf16* X1, float* TW) {
#pragma unroll
        for (int rr = 0; rr < 2; ++rr) { const int m = m0 + r0 + rr; float s = 0.f;
#pragma unroll
            for (int j = 0; j < 4; ++j) { f32x4 mx; mx[0] = __uint_as_float(mv[rr][j].x << 16); mx[1] = __uint_as_float(mv[rr][j].x & 0xffff0000u); mx[2] = __uint_as_float(mv[rr][j].y << 16); mx[3] = __uint_as_float(mv[rr][j].y & 0xffff0000u);
                xv[rr][j] = xv[rr][j] + cg1[j] * mx;
                ((unsigned long long*)(X1 + (size_t)m * D) + F.lane)[64 * j] = (unsigned long long)pk2(xv[rr][j].x, xv[rr][j].y) | ((unsigned long long)pk2(xv[rr][j].z, xv[rr][j].w) << 32);
                s += (xv[rr][j].x * xv[rr][j].x + xv[rr][j].y * xv[rr][j].y) + (xv[rr][j].z * xv[rr][j].z + xv[rr][j].w * xv[rr][j].w); }
            const float rstd = 1.f / sqrtf(wave_sum(s) * (1.f / D) + EPS);
            float lg[4] = {0.f, 0.f, 0.f, 0.f};
#if MOE_FP8
            int* o4 = (int*)((unsigned char*)H2 + (size_t)m * D) + F.lane;
#else
            unsigned long long* o8 = (unsigned long long*)(H2 + (size_t)m * D) + F.lane;
#endif
#pragma unroll
            for (int j = 0; j < 4; ++j) { const int k0 = 4 * F.lane + 256 * j; xv[rr][j] = xv[rr][j] * rstd * cA[j] + cB[j];
#if MOE_FP8
                { int p = 0; p = __builtin_amdgcn_cvt_pk_fp8_f32(__builtin_amdgcn_fmed3f(xv[rr][j].x, -448.f, 448.f), __builtin_amdgcn_fmed3f(xv[rr][j].y, -448.f, 448.f), p, false);
                  p = __builtin_amdgcn_cvt_pk_fp8_f32(__builtin_amdgcn_fmed3f(xv[rr][j].z, -448.f, 448.f), __builtin_amdgcn_fmed3f(xv[rr][j].w, -448.f, 448.f), p, true); o4[64 * j] = p; }
#else
                o8[64 * j] = (unsigned long long)pk2(xv[rr][j].x, xv[rr][j].y) | ((unsigned long long)pk2(xv[rr][j].z, xv[rr][j].w) << 32);
#endif
#pragma unroll
                for (int q = 0; q < 4; ++q) { const f32x4 w = *(const LAS f32x4*)(wrg + q * D + k0); lg[q] += (xv[rr][j].x * w.x + xv[rr][j].y * w.y) + (xv[rr][j].z * w.z + xv[rr][j].w * w.w); } }
            wave_sum4_all(lg, F.lane);
#pragma unroll
            for (int q = 0; q < 4; ++q) lg[q] += F.b_rg[q];
            int gs = 0; float best = lg[0];
#pragma unroll
            for (int q = 1; q < 4; ++q) if (lg[q] > best) { best = lg[q]; gs = q; }
            float den = 0.f;
#pragma unroll
            for (int q = 0; q < 4; ++q) den += expf(lg[q] - best);
            const float psel = 1.f / den;
            gs = __builtin_amdgcn_readfirstlane(gs);
            float le[4] = {0.f, 0.f, 0.f, 0.f}; const LAS float* wg = wre + gs * 4 * D;
#pragma unroll
            for (int j = 0; j < 4; ++j) { const int k0 = 4 * F.lane + 256 * j;
#pragma unroll
                for (int q = 0; q < 4; ++q) { const f32x4 w = *(const LAS f32x4*)(wg + q * D + k0); le[q] += (xv[rr][j].x * w.x + xv[rr][j].y * w.y) + (xv[rr][j].z * w.z + xv[rr][j].w * w.w); } }
            wave_sum4_all(le, F.lane);
#pragma unroll
            for (int q = 0; q < 4; ++q) le[q] += F.b_re[gs * 4 + q];
            int i0 = 0; float v0 = le[0];
#pragma unroll
            for (int q = 1; q < 4; ++q) if (le[q] > v0) { v0 = le[q]; i0 = q; }
            int i1 = -1; float v1 = -INFINITY;
#pragma unroll
            for (int q = 0; q < 4; ++q) if (q != i0 && le[q] > v1) { v1 = le[q]; i1 = q; }
            const float e1 = expf(v1 - v0); const float w0 = psel / (1.f + e1), w1 = psel * e1 / (1.f + e1);
            const int ea = i0 < i1 ? i0 : i1, eb = i0 < i1 ? i1 : i0; const float wa = i0 < i1 ? w0 : w1, wb = i0 < i1 ? w1 : w0;
            const int pair = ea == 0 ? eb - 1 : (ea == 1 ? eb + 1 : 5); const int cls = gs * 6 + pair;
            if (F.lane == 0) { TW[(size_t)m * 2] = wa; TW[(size_t)m * 2 + 1] = wb;
                const unsigned lr = __hip_atomic_fetch_add(lcnt + cls, 1u, __ATOMIC_RELAXED, __HIP_MEMORY_SCOPE_WORKGROUP);
                rinfo[F.wave * RPW + r0 + rr] = (unsigned)cls | (lr << 8); }
        }
}
__device__ __forceinline__ void p6_route(Frame& F) {
    const float* ADA = (const float*)(F.ws + WS_ADA); const bf16* MIX = (const bf16*)(F.ws + WS_MIX);
    bf16* H2 = (bf16*)(F.ws + WS_H2); bf16* X1 = (bf16*)(F.ws + WS_X1); int* INV = (int*)(F.ws + WS_INV); float* TW = (float*)(F.ws + WS_TW);
    LAS float* wrg = (LAS float*)(F.lds);
    LAS float* wre = wrg + 4 * D;
    LAS unsigned* lcnt = (LAS unsigned*)(wre + 16 * D);
    LAS unsigned* rinfo = lcnt + 32;
    __syncthreads();
    if (F.tid < 32) lcnt[F.tid] = 0u;
    for (int i = F.tid; i < 4 * D; i += NWAVES * 64) wrg[(i & 3) * D + (i >> 2)] = F.w_rg[i];
    for (int i = F.tid; i < 16 * D; i += NWAVES * 64) { const int g = i / (4 * D), r = i % (4 * D); wre[g * 4 * D + (r & 3) * D + (r >> 2)] = F.w_re[i]; }
    __syncthreads();
    const int gw = F.vcu * NWAVES + F.wave, NGW = F.G * NWAVES; const int RPW = M / NGW;
    const int m0 = gw * RPW; const int b = m0 / T;
    f32x4 cg1[4], cA[4], cB[4];
#pragma unroll
    for (int j = 0; j < 4; ++j) { const int k0 = 4 * F.lane + 256 * j; cg1[j] = *(const f32x4*)(ADA + (size_t)b * NADA + 2 * D + k0);
        const f32x4 g = *(const f32x4*)(F.g_ffn + k0), sc = *(const f32x4*)(ADA + (size_t)b * NADA + 4 * D + k0); cA[j] = g * (1.f + sc); cB[j] = *(const f32x4*)(ADA + (size_t)b * NADA + 3 * D + k0); }
    { f32x4 xa[2][4], xb[2][4]; uint2 ma[2][4], mb[2][4];
        p6_load(F, xa, ma, MIX, m0);
#pragma unroll 1
        for (int r0 = 0; r0 < RPW; r0 += 4) {
            p6_load(F, xb, mb, MIX, m0 + r0 + 2);
            p6_rows(F, xa, ma, m0, r0, RPW, cg1, cA, cB, wrg, wre, lcnt, rinfo, H2, X1, TW);
            if (r0 + 4 < RPW) p6_load(F, xa, ma, MIX, m0 + r0 + 4);
            p6_rows(F, xb, mb, m0, r0 + 2, RPW, cg1, cA, cB, wrg, wre, lcnt, rinfo, H2, X1, TW);
        } }
    __syncthreads();
    if (F.tid < NCLS) { const unsigned n = lcnt[F.tid]; lcnt[F.tid] = n ? __hip_atomic_fetch_add((unsigned*)(F.ctl + CW_CNT + F.tid * CNT_STRIDE), n, __ATOMIC_RELAXED, __HIP_MEMORY_SCOPE_AGENT) : 0u; }
    __syncthreads();
    for (int i = F.tid; i < NWAVES * RPW; i += NWAVES * 64) { const unsigned ri = rinfo[i]; const int cls = (int)(ri & 255u);
        INV[(size_t)cls * M + lcnt[cls] + (ri >> 8)] = (F.vcu * NWAVES + i / RPW) * RPW + i % RPW; }
    __syncthreads();
}
__device__ __forceinline__ void moe_tables(Frame& F) {
    LAS unsigned* lcnt = (LAS unsigned*)(F.lds + LCNT_OFF);
    __syncthreads();
    if (F.tid < NCLS) lcnt[F.tid] = __hip_atomic_load(F.ctl + CW_CNT + F.tid * CNT_STRIDE, RLX_AGENT);
    __syncthreads();
    if (F.tid == 0) { LAS unsigned char* tcls = F.lds + TCLS_OFF; LAS unsigned char* tfirst = F.lds + TFIRST_OFF; int nt = 0;
        for (int c = 0; c < NCLS; ++c) { const int n = ((int)lcnt[c] + 255) >> 8; tfirst[c] = (unsigned char)nt; for (int k = 0; k < n && nt < MAXTILES; ++k) tcls[nt++] = (unsigned char)c; }
        F.MISC[16] = (unsigned)nt; }
    __syncthreads();
}
template <class Order> __device__ __forceinline__ void moe_fill_up(Frame& F, const Order& S) {
    const int* INV = (const int*)(F.ws + WS_INV); const float* TW = (const float*)(F.ws + WS_TW); LAS unsigned* toku = (LAS unsigned*)(F.lds + TOKU_OFF); LAS unsigned* tokw = (LAS unsigned*)(F.lds + TOKW_OFF);
    for (int i = 0; i < 5; ++i) { pg8::Unit u; if (!S.next(i, u)) break;
        if (F.tid < 256) { const int rank = u.rank0 + F.tid; int tok = 0; unsigned wp = 0u;
            if (rank < u.cnt) { tok = INV[(size_t)u.cls * M + rank]; wp = pk2(TW[(size_t)tok * 2], TW[(size_t)tok * 2 + 1]); }
            toku[i * 256 + F.tid] = (unsigned)tok * (unsigned)(D * MOE_ESZ); tokw[i * 256 + F.tid] = wp; } }
    __syncthreads();
}
template <class Order> __device__ __forceinline__ void moe_fill_down(Frame& F, const Order& S) {
    const int* INV = (const int*)(F.ws + WS_INV); LAS int* tokd = (LAS int*)(F.lds + TOKU_OFF);
    for (int i = 0; i < 5; ++i) { pg8::Unit u; if (!S.next(i, u)) break;
        if (F.tid < 256) { const int rank = u.rank0 + F.tid; tokd[i * 256 + F.tid] = rank < u.cnt ? INV[(size_t)u.cls * M + rank] : -1; } }
    __syncthreads();
}
__device__ __forceinline__ void p10_final(Frame& F) {
    const float* ADA = (const float*)(F.ws + WS_ADA); const bf16* X1 = (const bf16*)(F.ws + WS_X1); const bf16* MOE = (const bf16*)(F.ws + WS_MOE);
    const int gw = F.vcu * NWAVES + F.wave, NGW = F.G * NWAVES; const int RPW = M / NGW; const int m0 = gw * RPW; const int b = m0 / T;
    f32x4 cg2[4], cgf[4];
#pragma unroll
    for (int j = 0; j < 4; ++j) { const int k0 = 4 * F.lane + 256 * j; cg2[j] = *(const f32x4*)(ADA + (size_t)b * NADA + 5 * D + k0); cgf[j] = *(const f32x4*)(F.g_fin + k0); }
    for (int r0 = 0; r0 < RPW; r0 += 4) {
        uint2 mv[4][4], ev[4][4];
#pragma unroll
        for (int rr = 0; rr < 4; ++rr) { const size_t m = (size_t)m0 + r0 + rr; const uint2* mr = (const uint2*)(X1 + m * D) + F.lane; const uint2* er = (const uint2*)(MOE + m * D) + F.lane;
#pragma unroll
            for (int j = 0; j < 4; ++j) { mv[rr][j] = mr[64 * j]; ev[rr][j] = er[64 * j]; } }
#pragma unroll
        for (int rr = 0; rr < 4; ++rr) { const size_t m = (size_t)m0 + r0 + rr; float s = 0.f; f32x4 xv[4];
#pragma unroll
            for (int j = 0; j < 4; ++j) { f32x4 mx, ex; mx[0] = __uint_as_float(mv[rr][j].x << 16); mx[1] = __uint_as_float(mv[rr][j].x & 0xffff0000u); mx[2] = __uint_as_float(mv[rr][j].y << 16); mx[3] = __uint_as_float(mv[rr][j].y & 0xffff0000u);
                ex[0] = __uint_as_float(ev[rr][j].x << 16); ex[1] = __uint_as_float(ev[rr][j].x & 0xffff0000u); ex[2] = __uint_as_float(ev[rr][j].y << 16); ex[3] = __uint_as_float(ev[rr][j].y & 0xffff0000u);
                xv[j] = mx + cg2[j] * ex; s += (xv[j].x * xv[j].x + xv[j].y * xv[j].y) + (xv[j].z * xv[j].z + xv[j].w * xv[j].w); }
            const float rstd = 1.f / sqrtf(wave_sum(s) * (1.f / D) + EPS);
            f32x4* orow = (f32x4*)(F.out + m * D) + F.lane;
#pragma unroll
            for (int j = 0; j < 4; ++j) orow[64 * j] = xv[j] * rstd * cgf[j]; }
    }
}

#define REFRESH() do { F.lane = lane_id_fresh(); F.tid = F.wave * 64 + F.lane; } while (0)
struct Args { const float* in[22]; float* out; unsigned char* ws; int ph_lo, ph_hi; };
__global__ void __launch_bounds__(NWAVES * 64, 2) mk_fwd(Args args) {
    extern __shared__ __attribute__((aligned(16))) unsigned char lds[];
    Frame F;
    F.lds = (LAS unsigned char*)lds;
    F.MISC = (volatile LAS unsigned*)(F.lds + MISC_OFF);
    F.tid = threadIdx.x; F.lane = F.tid & 63; F.wave = __builtin_amdgcn_readfirstlane(F.tid >> 6);
    F.G = gridDim.x; { const int bx = blockIdx.x; F.vcu = (F.G % 8 == 0) ? (bx % 8) * (F.G / 8) + bx / 8 : bx; }
    F.ws = args.ws; F.ctl = (gu32*)(args.ws + WS_CTL); F.out = args.out;
    F.x = args.in[0]; F.c = args.in[1]; F.w_ada = args.in[2]; F.b_ada = args.in[3]; F.g_mix = args.in[4]; F.w_in = args.in[5]; F.g_sgu = args.in[6]; F.w_sp = args.in[7]; F.b_sp = args.in[8]; F.b_fg = args.in[9];
    F.g_osgu = args.in[10]; F.g_ofox = args.in[11]; F.w_out = args.in[12]; F.g_ffn = args.in[13]; F.w_rg = args.in[14]; F.b_rg = args.in[15]; F.w_re = args.in[16]; F.b_re = args.in[17];
    F.w_gate = args.in[18]; F.w_up = args.in[19]; F.w_down = args.in[20]; F.g_fin = args.in[21];
    for (int u = F.tid; u < (LDS_BYTES - LDSCTL_OFF) / 4; u += NWAVES * 64) ((LAS unsigned*)(F.lds + LDSCTL_OFF))[u] = 0u;
    __syncthreads();
    XcdBarrier bar; bar.bar = (unsigned*)(F.ctl + CW_BAR); bar.x = 0; bar.st = nullptr;
    if (N_LAUNCHES == 1) bar = xcd_barrier_post((unsigned*)(F.ctl + CW_BAR), F.MISC + 8);
#define GRID_BAR() do { if (N_LAUNCHES == 1) xcd_barrier(bar); } while (0)
#if PROBE_MASK
#define PROBE_BEGIN(k) do { if (((PROBE_MASK) >> (k)) & 1) { if (blockIdx.x == 0 && F.tid == 0) F.MISC[22] = (unsigned)rt(); } } while (0)
#define PROBE_END(k) do { if (((PROBE_MASK) >> (k)) & 1) { if (blockIdx.x == 0 && F.tid == 0) F.MISC[20] = F.MISC[20] + ((unsigned)rt() - F.MISC[22]); } } while (0)
#else
#define PROBE_BEGIN(k) do {} while (0)
#define PROBE_END(k) do {} while (0)
#endif
    const int lo = args.ph_lo, hi = args.ph_hi;
#define IN(k) (lo <= (k) && (k) < hi)
#define BOTH(k) (IN(k) && IN((k) + 1))
    bf16* const XN = (bf16*)(F.ws + WS_XN); bf16* const U = (bf16*)(F.ws + WS_U); bf16* const Y = (bf16*)(F.ws + WS_Y);
    float* const ADA = (float*)(F.ws + WS_ADA);

    if (IN(0)) { PROBE_BEGIN(0); p0_prologue(F); if (BOTH(0)) GRID_BAR(); PROBE_END(0); }
    if (IN(1)) { REFRESH(); PROBE_BEGIN(1); p1_prenorm(F); if (BOTH(1)) GRID_BAR(); PROBE_END(1); }
    if (IN(2)) { REFRESH(); PROBE_BEGIN(2);
        p2_kx(F);
        pg8::Gemm g{XN, (const bf16*)(F.ws + WS_WIN), D, D, D, 127, 127}; pg8::StaticOrder S; S.init(M, NPROJ, D, D, F.G, (int)blockIdx.x);
        pg8::EpiProj E{U, (unsigned*)(F.ctl + CW_QKB)};
        pg8::gemm_phase<pg8::EpiProj, pg8::StaticOrder, true, true>(F.lds + RING_OFF, g, S, E, F.tid);
        if (BOTH(2)) GRID_BAR(); PROBE_END(2);
    }
    if (IN(3)) { REFRESH(); PROBE_BEGIN(3);
        PROBE_BEGIN(4);
#if NAIVE_SGU
        p3_sgu_naive(F);
#else
        p3_sgu(F);
#endif
        PROBE_END(4);
#if NAIVE_ATTN
        p3_attn_naive(F);
#else
        static_assert(attn_body::LDS_BYTES <= RING_BYTES, "attention LDS map");
        { const attn_body::bf16* Qp = (const attn_body::bf16*)(F.ws + WS_U) + (size_t)2 * M * DH;
          const attn_body::AttnTensors AT{Qp, Qp + (size_t)M * DH, Qp + (size_t)2 * M * DH, (attn_body::bf16*)(F.ws + WS_Y), (const unsigned long long*)(F.ws + WS_KX8), (const float*)(F.ws + WS_GF), (const float*)(F.ctl + CW_QKB), (float*)(F.ws + WS_SSQY)};
          const attn_body::StaticOrder S((int)F.G, (int)blockIdx.x);
          attn_body::AttnUnit u;
          for (int i = 0; S.next(i, u); ++i) {
              if (i == ((F.vcu >> 1) & 3)) p3_convert(F);
              attn_body::attn_unit<8>(u.bh / attn_body::NHEAD, u.bh % attn_body::NHEAD, u.qb, AT.Q, AT.K, AT.V, AT.O, AT.KX8, AT.GF, AT.QKB, AT.SSQ, (char*)lds + RING_OFF, F.tid); } }
#endif
        if (IN(3) && IN(5)) GRID_BAR(); PROBE_END(3); }
    if (IN(5)) { REFRESH(); PROBE_BEGIN(5);
        pg8::Gemm g{Y, (const bf16*)(F.ws + WS_WOUT), D, D, D, 127, 127}; pg8::StaticOrder S; S.init(M, D, D, D, F.G, (int)blockIdx.x);
        { const float* SSQY = (const float*)(F.ws + WS_SSQY); LAS float* rsr = (LAS float*)(F.lds + TOKU_OFF);
          __syncthreads();
          for (int i = 0; i < 4; ++i) { pg8::Unit u; if (!S.next(i, u)) break;
              if (F.tid < 256) { const f32x4* p = (const f32x4*)(SSQY + (size_t)(u.pm * 256 + F.tid) * 16); const f32x4 s0 = p[0], s1 = p[1], f0 = p[2], f1 = p[3];
                  const float a = ((s0[0] + s0[1]) + (s0[2] + s0[3])) + ((s1[0] + s1[1]) + (s1[2] + s1[3])), c = ((f0[0] + f0[1]) + (f0[2] + f0[3])) + ((f1[0] + f1[1]) + (f1[2] + f1[3]));
                  const float rs = 1.f / sqrtf(a * (1.f / 512.f) + EPS), rf = 1.f / sqrtf(c * (1.f / 512.f) + EPS); rsr[(i * 256 + F.tid) * 2] = rs; rsr[(i * 256 + F.tid) * 2 + 1] = rf / rs; } }
          __syncthreads(); }
        pg8::EpiMix E{(bf16*)(F.ws + WS_MIX), (const LAS float*)(F.lds + TOKU_OFF)};
        pg8::gemm_phase<pg8::EpiMix, pg8::StaticOrder, true, true>(F.lds + RING_OFF, g, S, E, F.tid);
        if (BOTH(5)) GRID_BAR(); PROBE_END(5);
    }
    if (IN(6)) { REFRESH(); PROBE_BEGIN(6); p6_route(F); if (IN(6) && IN(8)) GRID_BAR(); PROBE_END(6); }
    if (IN(8)) { REFRESH(); PROBE_BEGIN(8);
        moe_tables(F);
        pg8::Gemm g{(const bf16*)(F.ws + WS_H2), (const bf16*)(F.ws + WS_WGU), D * MOE_ESZ / 2, D * MOE_ESZ / 2, D * MOE_ESZ / 2, 127, 121};
        pg8::MoeUpOrder S{F.G, (int)blockIdx.x, (int)F.MISC[16], F.lds + TCLS_OFF, F.lds + TFIRST_OFF, (const LAS unsigned*)(F.lds + LCNT_OFF), (const LAS unsigned*)(F.lds + TOKU_OFF)};
        moe_fill_up(F, S);
        pg8::EpiUp E{(bf16*)(F.ws + WS_ACT), (const LAS unsigned*)(F.lds + TOKW_OFF)};
        pg8::gemm_phase<pg8::EpiUp, pg8::MoeUpOrder, true, true, MOE_FP8 != 0>(F.lds + RING_OFF, g, S, E, F.tid);
        if (BOTH(8)) GRID_BAR(); PROBE_END(8);
    }
    if (IN(9)) { REFRESH(); PROBE_BEGIN(9);
        if (!IN(8)) moe_tables(F);
        pg8::Gemm g{(const bf16*)(F.ws + WS_ACT), (const bf16*)(F.ws + WS_WD), D * MOE_ESZ / 2, DEXP * MOE_ESZ / 2, D * MOE_ESZ / 2, 125, 121};
        pg8::MoeDownOrder S{F.G, (int)blockIdx.x, (int)F.MISC[16], F.lds + TCLS_OFF, F.lds + TFIRST_OFF, (const LAS unsigned*)(F.lds + LCNT_OFF)};
        moe_fill_down(F, S);
        pg8::EpiDown E{(bf16*)(F.ws + WS_MOE), (const LAS int*)(F.lds + TOKU_OFF)};
        pg8::gemm_phase<pg8::EpiDown, pg8::MoeDownOrder, true, true, MOE_FP8 != 0>(F.lds + RING_OFF, g, S, E, F.tid);
        if (BOTH(9)) GRID_BAR(); PROBE_END(9);
    }
    if (IN(10)) { REFRESH(); PROBE_BEGIN(10); p10_final(F); PROBE_END(10); }
#if PROBE_MASK
    if (blockIdx.x == 0 && F.tid == 0) { const unsigned long long t0 = rt(); const unsigned long long w = (unsigned long long)F.MISC[20] * (PROBE_MULT); while (rt() - t0 < w) __builtin_amdgcn_s_sleep(32); }
#endif
#undef IN
#undef BOTH
}

extern "C" void kernel_launch(void* const* d_in, const int* in_sizes, int n_in, void* d_out, int out_size, void* d_ws, size_t ws_size, hipStream_t stream) {
    static int grid = 0;
    if (grid == 0) {
        if (n_in != 22 || in_sizes[0] != M * D || out_size != M * D || ws_size < WS_END) { fprintf(stderr, "kernel_launch: unexpected shapes (n_in %d, in0 %d, out %d, ws %zu); nothing launched\n", n_in, n_in > 0 ? in_sizes[0] : -1, out_size, ws_size); grid = -1; return; }
        int dev = 0, cus = 0, per_cu = 0;
        if (hipGetDevice(&dev) != hipSuccess || hipDeviceGetAttribute(&cus, hipDeviceAttributeMultiprocessorCount, dev) != hipSuccess) { fprintf(stderr, "kernel_launch: device query failed\n"); grid = -1; return; }
        if (hipFuncSetAttribute((const void*)mk_fwd, hipFuncAttributeMaxDynamicSharedMemorySize, LDS_BYTES) != hipSuccess) { fprintf(stderr, "kernel_launch: hipFuncSetAttribute failed\n"); grid = -1; return; }
        if (hipOccupancyMaxActiveBlocksPerMultiprocessor(&per_cu, (const void*)mk_fwd, NWAVES * 64, LDS_BYTES) != hipSuccess || per_cu < 1) { fprintf(stderr, "kernel_launch: occupancy query reports %d workgroups per CU\n", per_cu); (void)hipGetLastError(); grid = -1; return; }
        grid = cus;
        if (grid != 256) { fprintf(stderr, "kernel_launch: built for a 256-CU device (static unit orders), found %d CUs; nothing launched\n", cus); grid = -1; return; }
    }
    if (grid < 0) return;
    if (hipMemsetAsync((char*)d_ws + WS_CTL, 0, CTL_ZERO_BYTES, stream) != hipSuccess) { fprintf(stderr, "kernel_launch: hipMemsetAsync failed\n"); return; }
    Args a{};
    for (int i = 0; i < 22; ++i) a.in[i] = (const float*)d_in[i];
    a.out = (float*)d_out; a.ws = (unsigned char*)d_ws;
    if (N_LAUNCHES == 1) {
        a.ph_lo = 0; a.ph_hi = N_PHASES;
        void* kargs[] = {&a};
        const hipError_t le = hipLaunchCooperativeKernel((const void*)mk_fwd, dim3(grid), dim3(NWAVES * 64), kargs, LDS_BYTES, stream);
        if (le != hipSuccess) fprintf(stderr, "kernel_launch: cooperative launch failed: %s (grid %d)\n", hipGetErrorName(le), grid);
    } else {
        for (int li = 0; li < N_PHASES; ++li) { a.ph_lo = li; a.ph_hi = li + 1;
            hipLaunchKernelGGL(mk_fwd, dim3(grid), dim3(NWAVES * 64), LDS_BYTES, stream, a);
            const hipError_t le = hipPeekAtLastError();
            if (le != hipSuccess) { fprintf(stderr, "kernel_launch: launch %d failed: %s\n", li, hipGetErrorName(le)); break; } }
    }
}
```

```cpp
#include <hip/hip_runtime.h>
#include <hip/hip_bf16.h>
#include <cstdio>
#include <cstdint>
#include <cmath>

#ifndef MK_N_LAUNCHES
#define MK_N_LAUNCHES 1
#endif
#ifndef PROBE_MASK
#define PROBE_MASK 0
#endif
#ifndef PROBE_MULT
#define PROBE_MULT 4
#endif
#ifndef MOE_FP8
#define MOE_FP8 1
#endif
#define MOE_ESZ (MOE_FP8 ? 1 : 2)
#ifndef NAIVE_SGU
#define NAIVE_SGU 0
#endif
#ifndef NAIVE_ATTN
#define NAIVE_ATTN 0
#endif

constexpr int BATCH = 4, T = 8192, D = 1024, NH = 8, HD = 64, DH = 512;
constexpr int M = BATCH * T;
constexpr int NPROJ = 2560;
constexpr int LDW_IN = 2568;
constexpr int NADA = 6 * D;
constexpr int NEXP = 16, DEXP = 512, NCLS = 24;
constexpr int MAXTILES = 152;
constexpr float EPS = 1e-6f;
constexpr float C2 = 0.125f * 1.4426950408889634f;
constexpr float LOG2E = 1.4426950408889634f;

namespace pg8 {
#define PG8_LAS __attribute__((address_space(3)))
typedef unsigned short bf16_t;
typedef short bf16x8 __attribute__((ext_vector_type(8)));
typedef float f32x4 __attribute__((ext_vector_type(4)));
typedef unsigned u32x4 __attribute__((ext_vector_type(4)));
constexpr int BM = 256, BK = 64, HALF = 128, HTB = HALF * BK * 2  , STAGE_BYTES = 8 * HTB, NXCD = 8, WGM = 8;

__host__ __device__ __forceinline__ int lds_byte(int r, int c) { const int st = (r >> 4) * 2 + (c >> 5), rr = r & 15, cc = c & 31, ob = rr * 64 + cc * 2; return st * 1024 + (ob ^ (((ob >> 9) & 1) << 5)); }
__host__ __device__ __forceinline__ void stage_rc(int b, int& R, int& C) { const int st = b / 1024, sb = b % 1024, swz = sb ^ (((sb >> 9) & 1) << 5); R = (st >> 1) * 16 + swz / 64; C = (st & 1) * 32 + (swz % 64) / 2; }
__host__ __device__ __forceinline__ int perm32(int rho) { const int n = rho >> 4, i = rho & 15; return 8 * (i >> 2) + 4 * n + (i & 3); }

struct Unit { int pm, pn, aux; long aoff, boff, dboff; int cls, rank0, cnt, ord; };
struct Gemm { const bf16_t* A; const bf16_t* Bt; int lda, ldb, K; int scA, scB; };

struct StaticOrder {
    static constexpr bool GATHER = false;
    int nM, nN, nwg, G, c; long ta, tb;
    __host__ __device__ void init(int M, int N, int lda, int ldb, int G_, int c_) { nM = M / BM; nN = N / BM; nwg = nM * nN; G = G_; c = c_; ta = (long)BM * lda * 2; tb = (long)BM * ldb * 2; }
    __host__ __device__ bool next(int i, Unit& u) const {
        const long L = (long)i * G + c; if (L >= nwg) return false;
        int wgid = (int)L; { const int q = nwg / NXCD, r = nwg % NXCD, xcd = wgid % NXCD, off = wgid / NXCD; wgid = (xcd < r ? xcd * (q + 1) : r * (q + 1) + (xcd - r) * q) + off; }
        const int nig = WGM * nN, gid = wgid / nig, fm = gid * WGM, gsz = (nM - fm) < WGM ? (nM - fm) : WGM;
        u.pm = fm + ((wgid % nig) % gsz); u.pn = (wgid % nig) / gsz; u.aux = 0; u.aoff = u.pm * ta; u.boff = u.pn * tb; u.dboff = 0; u.cls = 0; u.rank0 = 0; u.cnt = 0; u.ord = i; return true;
    }
    __device__ __forceinline__ void a_ready(const Unit&) const {}
    __device__ __forceinline__ void done(const Unit&) const {}
};


__device__ __forceinline__ unsigned cvt_pk_bf16(float lo, float hi) { unsigned r; asm volatile("v_cvt_pk_bf16_f32 %0, %1, %2" : "=v"(r) : "v"(lo), "v"(hi)); return r; }
__device__ __forceinline__ float gelu_tanh(float v) {
    const float u = v * (1.5957691216057308f + 0.0713548162726f * v * v);
    return v * __builtin_amdgcn_rcpf(1.0f + __builtin_amdgcn_exp2f(-1.4426950408889634f * u));
}
__device__ __forceinline__ float silu_f(float v) { return v * __builtin_amdgcn_rcpf(1.0f + __builtin_amdgcn_exp2f(-1.4426950408889634f * v)); }

struct NoState {};
#define PG8_DPP_MAX(v, ctrl) fmaxf((v), __builtin_bit_cast(float, __builtin_amdgcn_update_dpp(0, __builtin_bit_cast(int, (v)), (ctrl), 0xf, 0xf, false)))
__device__ __forceinline__ float wave_max_nonneg(float v) {
    v = PG8_DPP_MAX(v, 0xB1); v = PG8_DPP_MAX(v, 0x4E); v = PG8_DPP_MAX(v, 0x141); v = PG8_DPP_MAX(v, 0x140);
    const int iv = __builtin_bit_cast(int, v);
    return fmaxf(fmaxf(__builtin_bit_cast(float, __builtin_amdgcn_readlane(iv, 0)), __builtin_bit_cast(float, __builtin_amdgcn_readlane(iv, 16))), fmaxf(__builtin_bit_cast(float, __builtin_amdgcn_readlane(iv, 32)), __builtin_bit_cast(float, __builtin_amdgcn_readlane(iv, 48))));
}
struct EpiProj {
    static constexpr bool PERM = true, AFTER_DRAIN = false, MID = false; typedef NoState State;
    bf16_t* O; unsigned* qkb;
    __device__ __forceinline__ void operator()(const f32x4 (&acc)[2][2][4][2], const State&, const Unit& u, int wr, int wc, int fr, int fq) const {
        const int row0 = u.pm * BM + wr * 64 + fr; const int seg = u.pn >> 1; float nmx[2] = {0.f, 0.f};
        bf16_t* base = O + (size_t)seg * ((size_t)M * 512);
        const int col0 = (u.pn & 1) * 256 + wc * 32 + 8 * fq;
#pragma unroll
        for (int ai = 0; ai < 2; ++ai)
#pragma unroll
            for (int m = 0; m < 4; ++m) { bf16_t* rowp = base + (size_t)(row0 + ai * HALF + m * 16) * 512 + col0;
#pragma unroll
                for (int bj = 0; bj < 2; ++bj) { f32x4 v0 = acc[ai][bj][m][0], v1 = acc[ai][bj][m][1];
                    if (seg < 2) {
#pragma unroll
                        for (int j = 0; j < 4; ++j) { v0[j] = gelu_tanh(v0[j]); v1[j] = gelu_tanh(v1[j]); }
                    } else if (seg == 2) { v0 = v0 * C2; v1 = v1 * C2; }
                    if (seg == 2 || seg == 3) { float s8 = ((v0[0] * v0[0] + v0[1] * v0[1]) + (v0[2] * v0[2] + v0[3] * v0[3])) + ((v1[0] * v1[0] + v1[1] * v1[1]) + (v1[2] * v1[2] + v1[3] * v1[3]));
                        { const auto r16 = __builtin_amdgcn_permlane16_swap(__float_as_uint(s8), __float_as_uint(s8), false, false); s8 = __uint_as_float(r16[0]) + __uint_as_float(r16[1]);
                          const auto r32 = __builtin_amdgcn_permlane32_swap(__float_as_uint(s8), __float_as_uint(s8), false, false); s8 = __uint_as_float(r32[0]) + __uint_as_float(r32[1]); }
                        nmx[bj] = fmaxf(nmx[bj], s8); }
                    u32x4 w; w.x = cvt_pk_bf16(v0[0], v0[1]); w.y = cvt_pk_bf16(v0[2], v0[3]); w.z = cvt_pk_bf16(v1[0], v1[1]); w.w = cvt_pk_bf16(v1[2], v1[3]);
                    *(u32x4*)(rowp + bj * HALF) = w; } }
        if (seg == 2 || seg == 3) {
#pragma unroll
            for (int bj = 0; bj < 2; ++bj) { const float wm = wave_max_nonneg(nmx[bj]); const int bh = (u.pm >> 5) * 8 + 4 * (u.pn & 1) + 2 * bj + (wc >> 1);
                if (fr == 0 && fq == 0) __hip_atomic_fetch_max(qkb + (seg == 3 ? bh * 16 + (u.pm & 15) : 512 + bh * 32 + (u.pm & 31)), __float_as_uint(wm), __ATOMIC_RELAXED, __HIP_MEMORY_SCOPE_AGENT); } }
    }
};
struct EpiMix {
    static constexpr bool PERM = true, AFTER_DRAIN = false, MID = true; struct State { float rs[2][4]; };
    bf16_t* O; const PG8_LAS float* rsr;
    __device__ __forceinline__ void mid(f32x4 (&acc)[2][2][4][2], State& st, const Unit& u, int wr, int fr) const {
#pragma unroll
        for (int ai = 0; ai < 2; ++ai)
#pragma unroll
            for (int m = 0; m < 4; ++m) { const int rl = ai * HALF + wr * 64 + m * 16 + fr; const float rs = rsr[(u.ord * BM + rl) * 2], ratio = rsr[(u.ord * BM + rl) * 2 + 1]; st.rs[ai][m] = rs;
#pragma unroll
                for (int bj = 0; bj < 2; ++bj)
#pragma unroll
                    for (int n = 0; n < 2; ++n) acc[ai][bj][m][n] = acc[ai][bj][m][n] * ratio; }
    }
    __device__ __forceinline__ void operator()(const f32x4 (&acc)[2][2][4][2], const State& st, const Unit& u, int wr, int wc, int fr, int fq) const {
        const int row0 = u.pm * BM + wr * 64 + fr; const int col0 = u.pn * BM + wc * 32 + 8 * fq;
#pragma unroll
        for (int ai = 0; ai < 2; ++ai)
#pragma unroll
            for (int m = 0; m < 4; ++m) { bf16_t* rowp = O + (size_t)(row0 + ai * HALF + m * 16) * D + col0; const float rs = st.rs[ai][m];
#pragma unroll
                for (int bj = 0; bj < 2; ++bj) { const f32x4 v0 = acc[ai][bj][m][0] * rs, v1 = acc[ai][bj][m][1] * rs;
                    u32x4 w; w.x = cvt_pk_bf16(v0[0], v0[1]); w.y = cvt_pk_bf16(v0[2], v0[3]); w.z = cvt_pk_bf16(v1[0], v1[1]); w.w = cvt_pk_bf16(v1[2], v1[3]);
                    *(u32x4*)(rowp + bj * HALF) = w; } }
    }
};
struct EpiUp {
    static constexpr bool PERM = true, AFTER_DRAIN = false, MID = false; typedef NoState State;
    bf16_t* ACT; const PG8_LAS unsigned* tokw;
    __device__ __forceinline__ void operator()(const f32x4 (&acc)[2][2][4][2], const State&, const Unit& u, int wr, int wc, int fr, int fq) const {
        const int s = u.aux >> 2, t = u.aux & 3; const int col0 = s * 512 + t * 128 + wc * 32 + 8 * fq;
#pragma unroll
        for (int ai = 0; ai < 2; ++ai)
#pragma unroll
            for (int m = 0; m < 4; ++m) { const int rl = ai * HALF + wr * 64 + m * 16 + fr; const int r = u.pm * BM + rl; const unsigned wp = tokw[u.ord * BM + rl];
                const float w = __uint_as_float(s ? (wp & 0xffff0000u) : (wp << 16));
                float a[8];
#pragma unroll
                for (int n = 0; n < 2; ++n)
#pragma unroll
                    for (int j = 0; j < 4; ++j) a[n * 4 + j] = silu_f(acc[ai][0][m][n][j]) * acc[ai][1][m][n][j] * w;
#if MOE_FP8
                int p0 = 0, p1 = 0;
#pragma unroll
                for (int j = 0; j < 8; ++j) a[j] = __builtin_amdgcn_fmed3f(a[j] * 4.f, -448.f, 448.f);
                p0 = __builtin_amdgcn_cvt_pk_fp8_f32(a[0], a[1], p0, false); p0 = __builtin_amdgcn_cvt_pk_fp8_f32(a[2], a[3], p0, true);
                p1 = __builtin_amdgcn_cvt_pk_fp8_f32(a[4], a[5], p1, false); p1 = __builtin_amdgcn_cvt_pk_fp8_f32(a[6], a[7], p1, true);
                typedef int v2i_t __attribute__((ext_vector_type(2)));
                *(v2i_t*)((unsigned char*)ACT + (size_t)r * D + col0) = (v2i_t){p0, p1}; }
#else
                u32x4 o; o.x = cvt_pk_bf16(a[0], a[1]); o.y = cvt_pk_bf16(a[2], a[3]); o.z = cvt_pk_bf16(a[4], a[5]); o.w = cvt_pk_bf16(a[6], a[7]);
                *(u32x4*)(ACT + (size_t)r * D + col0) = o; }
#endif
    }
};
struct EpiDown {
    static constexpr bool PERM = true, AFTER_DRAIN = false, MID = false; typedef NoState State;
    bf16_t* O; const PG8_LAS int* tokd;
    __device__ __forceinline__ void operator()(const f32x4 (&acc)[2][2][4][2], const State&, const Unit& u, int wr, int wc, int fr, int fq) const {
        const int col0 = u.aux * BM + wc * 32 + 8 * fq;
#pragma unroll
        for (int ai = 0; ai < 2; ++ai)
#pragma unroll
            for (int m = 0; m < 4; ++m) { const int rl = ai * HALF + wr * 64 + m * 16 + fr;
                const int tok = tokd[u.ord * BM + rl];
                if (tok >= 0) { bf16_t* rowp = O + (size_t)tok * D + col0;
#pragma unroll
                    for (int bj = 0; bj < 2; ++bj) { const f32x4 v0 = acc[ai][bj][m][0], v1 = acc[ai][bj][m][1];
                        u32x4 w; w.x = cvt_pk_bf16(v0[0], v0[1]); w.y = cvt_pk_bf16(v0[2], v0[3]); w.z = cvt_pk_bf16(v1[0], v1[1]); w.w = cvt_pk_bf16(v1[2], v1[3]);
                        *(u32x4*)(rowp + bj * HALF) = w; } } }
    }
};
__device__ __forceinline__ int cls_expert(int cls, int s) { const int g = cls / 6, p = cls % 6; const int a = p < 3 ? 0 : (p < 5 ? 1 : 2); const int b = p < 3 ? p + 1 : (p < 5 ? p - 1 : 3); return g * 4 + (s ? b : a); }
struct MoeUpOrder {
    static constexpr bool GATHER = true;
    int G, c, NT; const PG8_LAS unsigned char* tcls; const PG8_LAS unsigned char* tfirst; const PG8_LAS unsigned* lcnt; const PG8_LAS unsigned* toku;
    __device__ __forceinline__ bool next(int i, Unit& u) const {
        const int x = c & 7, j = (c >> 3) + (G >> 3) * i; const int pm = 8 * (j >> 3) + x; if (pm >= NT) return false;
        const int st = j & 7; const int cls = (int)tcls[pm]; u.pm = pm; u.aux = st; u.pn = cls_expert(cls, st >> 2) * 4 + (st & 3);
        u.aoff = 0; u.boff = (long)u.pn * (BM * D * MOE_ESZ); u.dboff = 0; u.cls = cls; u.rank0 = (pm - (int)tfirst[cls]) * BM; u.cnt = (int)lcnt[cls]; u.ord = i; return true;
    }
    __device__ __forceinline__ unsigned row_off(const Unit& u, int r) const { return toku[u.ord * BM + r]; }
    __device__ __forceinline__ void a_ready(const Unit&) const {}
    __device__ __forceinline__ void done(const Unit&) const {}
};
struct MoeDownOrder {
    static constexpr bool GATHER = false;
    int G, c, NT; const PG8_LAS unsigned char* tcls; const PG8_LAS unsigned char* tfirst; const PG8_LAS unsigned* lcnt;
    __device__ __forceinline__ bool next(int i, Unit& u) const {
        const int x = c & 7, j = (c >> 3) + (G >> 3) * i; const int pm = 8 * (j >> 2) + x; if (pm >= NT) return false;
        const int nt = j & 3; const int cls = (int)tcls[pm]; const int ea = cls_expert(cls, 0), eb = cls_expert(cls, 1); u.pm = pm; u.aux = nt; u.pn = 0;
        u.aoff = (long)pm * (BM * D * MOE_ESZ); u.boff = ((long)ea * D + nt * BM) * (DEXP * MOE_ESZ); u.dboff = (long)(eb - ea) * D * (DEXP * MOE_ESZ) - DEXP * MOE_ESZ;
        u.cls = cls; u.rank0 = (pm - (int)tfirst[cls]) * BM; u.cnt = (int)lcnt[cls]; u.ord = i; return true;
    }
    __device__ __forceinline__ void a_ready(const Unit&) const {}
    __device__ __forceinline__ void done(const Unit&) const {}
};

template <class Epi, class Sched, bool ALIGN_EPI = false, bool SP2 = false, bool FP8 = false>
__device__ __forceinline__ void gemm_phase(PG8_LAS unsigned char* lds, const Gemm g, const Sched& S, const Epi& E, const int tid) {
    typedef int v4i_t __attribute__((ext_vector_type(4))); typedef int v8i_t __attribute__((ext_vector_type(8)));
    const int wid = __builtin_amdgcn_readfirstlane(tid >> 6), lane = tid & 63, wr = wid >> 2, wc = wid & 3, fr = lane & 15, fq = lane >> 4;
    const int K = g.K, nt = K / BK;
    static_assert(SP2, "only the two-super-phase loop is kept");
    const int nth = nt / 2;
    unsigned voffB[2]; int RR[2], CC2[2];
    unsigned cvo[2][2];
#pragma unroll
    for (int i = 0; i < 2; ++i) { int R, C; stage_rc(tid * 16 + i * 8192, R, C); const int Rb = Epi::PERM ? ((R & ~31) + perm32(R & 31)) : R;
        RR[i] = R; CC2[i] = C * 2; voffB[i] = (unsigned)(Rb * g.ldb + C) * 2u; }
#define PG8_AOFFS(dst, u) do { _Pragma("unroll") for (int _h = 0; _h < 2; ++_h) _Pragma("unroll") for (int _i = 0; _i < 2; ++_i) { \
        if constexpr (Sched::GATHER) dst[_h][_i] = S.row_off(u, _h * HALF + RR[_i]) + (unsigned)CC2[_i]; else dst[_h][_i] = (unsigned)((_h * HALF + RR[_i]) * g.lda) * 2u + (unsigned)CC2[_i]; } } while (0)
    const size_t kstep = (size_t)(BK * 2);
    const size_t hstep = (size_t)HALF * g.ldb * 2;
    const unsigned ldsw = (unsigned)wid * 1024u;
    int aofs[2], bofs[2];
    if constexpr (FP8) { aofs[0] = lds_byte(wr * 64 + fr, 16 * (fq & 1)) + (fq >> 1) * 1024; aofs[1] = lds_byte(wr * 64 + fr, 16 * (fq & 1) + 8) + (fq >> 1) * 1024;
                         bofs[0] = lds_byte(wc * 32 + fr, 16 * (fq & 1)) + (fq >> 1) * 1024; bofs[1] = lds_byte(wc * 32 + fr, 16 * (fq & 1) + 8) + (fq >> 1) * 1024; }
    else { aofs[0] = lds_byte(wr * 64 + fr, fq * 8); aofs[1] = aofs[0] + 1024; bofs[0] = lds_byte(wc * 32 + fr, fq * 8); bofs[1] = bofs[0] + 1024; }
#define PG8_SA(b, h) (((b) * 2 + (h)) * HTB)
#define PG8_SB(b, h) ((4 + (b) * 2 + (h)) * HTB)
#define PG8_STAGE(bufoff, gbase, voff) do { _Pragma("unroll") for (int _i = 0; _i < 2; ++_i) \
        __builtin_amdgcn_global_load_lds((const unsigned*)((const char*)(gbase) + (voff)[_i]), (PG8_LAS unsigned*)(lds + (bufoff) + ldsw + _i * 8192), 16, 0, 0); } while (0)
#define PG8_LD16(off) (*(const PG8_LAS v4i_t*)(lds + (off)))
#define PG8_LDA(dst, b, h) do { if constexpr (FP8) { _Pragma("unroll") for (int m = 0; m < 4; ++m) dst##8[m] = *(const PG8_LAS v8i_t*)(lds + PG8_SA(b, h) + aofs[0] + m * 2048); }     \
        else { _Pragma("unroll") for (int m = 0; m < 4; ++m) _Pragma("unroll") for (int k = 0; k < 2; ++k) dst[m][k] = *(const PG8_LAS bf16x8*)(lds + PG8_SA(b, h) + aofs[k] + m * 2048); } } while (0)
#define PG8_LDB(dst, b, h) do { if constexpr (FP8) { _Pragma("unroll") for (int n = 0; n < 2; ++n) dst##8[n] = *(const PG8_LAS v8i_t*)(lds + PG8_SB(b, h) + bofs[0] + n * 2048); } \
        else { _Pragma("unroll") for (int n = 0; n < 2; ++n) _Pragma("unroll") for (int k = 0; k < 2; ++k) dst[n][k] = *(const PG8_LAS bf16x8*)(lds + PG8_SB(b, h) + bofs[k] + n * 2048); } } while (0)
#define PG8_PINACC(ai, bj) do { if constexpr (FP8) { _Pragma("unroll") for (int m = 0; m < 4; ++m) _Pragma("unroll") for (int n = 0; n < 2; ++n) asm volatile("" : "+v"(acc[ai][bj][m][n])); } } while (0)
#define PG8_MMA(ai, bj, At, Bt) do { PG8_PINACC(ai, bj); __builtin_amdgcn_s_setprio(1); _Pragma("unroll") for (int m = 0; m < 4; ++m) _Pragma("unroll") for (int n = 0; n < 2; ++n) { \
        if constexpr (FP8) acc[ai][bj][m][n] = __builtin_amdgcn_mfma_scale_f32_16x16x128_f8f6f4(Bt##8[n], At##8[m], acc[ai][bj][m][n], 0, 0, 0, g.scB, 0, g.scA); \
        else { _Pragma("unroll") for (int k = 0; k < 2; ++k) acc[ai][bj][m][n] = __builtin_amdgcn_mfma_f32_16x16x32_bf16(Bt[n][k], At[m][k], acc[ai][bj][m][n], 0, 0, 0); } } \
        PG8_PINACC(ai, bj); __builtin_amdgcn_s_setprio(0); } while (0)
#define PG8_WAIT_V(n) asm volatile("s_waitcnt vmcnt(" #n ")" ::: "memory")
#define PG8_WAIT_L(n) asm volatile("s_waitcnt lgkmcnt(" #n ")" ::: "memory")
#define PG8_BAR __builtin_amdgcn_s_barrier()
#define PG8_SCHED __builtin_amdgcn_sched_barrier(0)
    Unit cur, nxt; int ui = 0;
    if (!S.next(0, cur)) return;
    f32x4 acc[2][2][4][2]; typename Epi::State est;
#pragma unroll
    for (int a = 0; a < 2; ++a)
#pragma unroll
        for (int b = 0; b < 2; ++b)
#pragma unroll
            for (int m = 0; m < 4; ++m)
#pragma unroll
                for (int n = 0; n < 2; ++n) acc[a][b][m][n] = (f32x4){0.f, 0.f, 0.f, 0.f};
    bf16x8 At[4][2], B0[2][2], B1[2][2]; v8i_t At8[4], B08[2], B18[2];
    const char* cA = (const char*)g.A + cur.aoff; const char* cB = (const char*)g.Bt + cur.boff;
    S.a_ready(cur);
    PG8_AOFFS(cvo, cur);
    if constexpr (SP2) {
        PG8_STAGE(PG8_SB(0, 0), cB, voffB); PG8_STAGE(PG8_SB(0, 1), cB + hstep, voffB); PG8_STAGE(PG8_SA(0, 0), cA, cvo[0]); PG8_STAGE(PG8_SA(0, 1), cA, cvo[1]);
        if (wr == 1) PG8_BAR;
        PG8_WAIT_V(2); PG8_BAR;
        PG8_STAGE(PG8_SB(1, 0), cB + kstep, voffB); PG8_STAGE(PG8_SA(1, 0), cA + kstep, cvo[0]); PG8_STAGE(PG8_SB(1, 1), cB + hstep + kstep, voffB);
        PG8_WAIT_V(6); PG8_BAR;
    }
    for (;;) {
        const bool has_next = S.next(ui + 1, nxt);
        const char* nA = has_next ? (const char*)g.A + nxt.aoff : cA; const char* nB = has_next ? (const char*)g.Bt + nxt.boff : cB;
#pragma unroll 1
        for (int t = 0; t < nt; t += 2) {
            if constexpr (Epi::MID) { if (t == nt / 2) E.mid(acc, est, cur, wr, fr); }
            const bool last = (t == nt - 2);
            const char* a1 = cA + (size_t)(t + 1) * kstep;
            const char* a2 = last ? nA : cA + (size_t)(t + 2) * kstep; const char* b2 = last ? nB : cB + (size_t)(t + 2) * kstep + ((t + 2 >= nth) ? cur.dboff : 0);
            unsigned xo[2][2];
            if constexpr (Sched::GATHER) { if (last && has_next) { PG8_AOFFS(xo, nxt); } else { xo[0][0] = cvo[0][0]; xo[0][1] = cvo[0][1]; xo[1][0] = cvo[1][0]; xo[1][1] = cvo[1][1]; } }
            else { xo[0][0] = cvo[0][0]; xo[0][1] = cvo[0][1]; xo[1][0] = cvo[1][0]; xo[1][1] = cvo[1][1]; }
            const char* a3 = a2 + kstep; const char* b3 = b2 + kstep;
            if (last && has_next) S.a_ready(nxt);
            if constexpr (SP2) {
            PG8_LDB(B0, 0, 0); PG8_LDB(B1, 0, 1); PG8_SCHED; PG8_LDA(At, 0, 0); PG8_STAGE(PG8_SA(1, 1), a1, cvo[1]);
            PG8_WAIT_V(8); PG8_WAIT_L(0); PG8_BAR; PG8_MMA(0, 0, At, B0); PG8_MMA(0, 1, At, B1); PG8_BAR; PG8_SCHED;
            PG8_LDA(At, 0, 1); PG8_STAGE(PG8_SB(0, 0), b2, voffB); PG8_STAGE(PG8_SB(0, 1), b2 + hstep, voffB); PG8_STAGE(PG8_SA(0, 0), a2, xo[0]);
            PG8_WAIT_V(8); PG8_WAIT_L(0); PG8_BAR; PG8_MMA(1, 0, At, B0); PG8_MMA(1, 1, At, B1); PG8_BAR; PG8_SCHED;
            PG8_LDB(B0, 1, 0); PG8_LDB(B1, 1, 1); PG8_SCHED; PG8_LDA(At, 1, 0); PG8_STAGE(PG8_SA(0, 1), a2, xo[1]);
            PG8_WAIT_V(8); PG8_WAIT_L(0); PG8_BAR; PG8_MMA(0, 0, At, B0); PG8_MMA(0, 1, At, B1); PG8_BAR; PG8_SCHED;
            PG8_LDA(At, 1, 1); PG8_STAGE(PG8_SB(1, 0), b3, voffB); PG8_STAGE(PG8_SB(1, 1), b3 + hstep, voffB); PG8_STAGE(PG8_SA(1, 0), a3, xo[0]);
            if constexpr (Sched::GATHER) { if (last) { cvo[0][0] = xo[0][0]; cvo[0][1] = xo[0][1]; cvo[1][0] = xo[1][0]; cvo[1][1] = xo[1][1]; } }
            PG8_WAIT_V(8); PG8_WAIT_L(0); PG8_BAR; PG8_MMA(1, 0, At, B0); PG8_MMA(1, 1, At, B1); PG8_BAR; PG8_SCHED;
            }
        }
        if constexpr (ALIGN_EPI) { if (wr == 0) PG8_BAR; }
        if constexpr (!Epi::AFTER_DRAIN) { E(acc, est, cur, wr, wc, fr, fq); S.done(cur); }
        if (!has_next) break;
#pragma unroll
        for (int a = 0; a < 2; ++a)
#pragma unroll
            for (int b = 0; b < 2; ++b)
#pragma unroll
                for (int m = 0; m < 4; ++m)
#pragma unroll
                    for (int n = 0; n < 2; ++n) acc[a][b][m][n] = (f32x4){0.f, 0.f, 0.f, 0.f};
        cur = nxt; cA = nA; cB = nB; ++ui;
        if constexpr (ALIGN_EPI) { if (wr == 1) PG8_BAR; }
    }
    PG8_WAIT_V(0);
    if constexpr (!ALIGN_EPI) { if (wr == 0) PG8_BAR; }
    PG8_BAR;
#undef PG8_SA
#undef PG8_SB
#undef PG8_STAGE
#undef PG8_AOFFS
#undef PG8_LDA
#undef PG8_LD16
#undef PG8_LDB
#undef PG8_MMA
#undef PG8_PINACC
#undef PG8_WAIT_V
#undef PG8_WAIT_L
#undef PG8_BAR
#undef PG8_SCHED
}
}
namespace attn_body {
using bf16=__hip_bfloat16;
using bf16x8=__attribute__((ext_vector_type(8)))short;
using s16x4=__attribute__((ext_vector_type(4)))short;
using f32x16=__attribute__((ext_vector_type(16)))float;
using u32x4=__attribute__((ext_vector_type(4)))unsigned;
constexpr int BATCH=4,NHEAD=8,SEQ=8192,D=64,DM=NHEAD*D,OPITCH=1024;
constexpr int NW=8,QBLK=32,QB=QBLK*NW,KVBLK=64,NQB=SEQ/QB;
constexpr int ATTN_PITCH=DM, ATTN_UNIT_ROWS=QB;
__device__ __forceinline__ int crow(int r,int hi){return (r&3)+8*(r>>2)+4*hi;}
#define SBAR() __builtin_amdgcn_sched_barrier(0)
__device__ __forceinline__ void cmask(f32x16&p0,f32x16&p1,int jb,int qrel,int hi){
  const float NEG=-INFINITY; int kb=64*jb+4*hi-qrel; asm volatile("":"+v"(kb));
  #pragma unroll
  for(int r=0;r<16;++r){const int c=(r&3)+8*(r>>2); if(kb>-c)p0[r]=NEG; if(kb>-c-32)p1[r]=NEG;}
}

constexpr int NSLOT=3, SLOTB=8192;
constexpr float TCUT=45.f;
constexpr int LDS_K=0, LDS_V=NSLOT*SLOTB, LDS_WS=2*NSLOT*SLOTB, LDS_OST=LDS_WS+NW*64*4, LDS_TAB=LDS_OST+NW*4096, LDS_BYTES=LDS_TAB+SEQ*8;
__device__ __forceinline__ void glds16(const void*gsrc,unsigned lds_dst){unsigned keep;
  asm volatile("s_mov_b32 %0, m0\n\ts_mov_b32 m0, %2\n\ts_nop 0\n\tglobal_load_lds_dwordx4 %1, off\n\ts_mov_b32 m0, %0":"=&s"(keep):"v"(gsrc),"s"(lds_dst):"memory");}
__device__ __forceinline__ void glds16s(const void*sbase,unsigned voff,unsigned lds_dst){unsigned keep;
  asm volatile("s_nop 4\n\ts_mov_b32 %0, m0\n\ts_mov_b32 m0, %3\n\ts_nop 0\n\tglobal_load_lds_dwordx4 %1, %2\n\ts_mov_b32 m0, %0":"=&s"(keep):"v"(voff),"s"(sbase),"s"(lds_dst):"memory");}
__device__ __forceinline__ float max3f(float a,float b,float c){float r;asm("v_max3_f32 %0, %1, %2, %3":"=v"(r):"v"(a),"v"(b),"v"(c));return r;}
__device__ __forceinline__ float max2f(float a,float b){float r;asm("v_max_f32_e32 %0, %1, %2":"=v"(r):"v"(a),"v"(b));return r;}
__device__ __forceinline__ float fadd_s(float a,float b){float r;asm("v_add_f32_e32 %0, %1, %2":"=v"(r):"v"(a),"v"(b));return r;}
__device__ __forceinline__ float fsub_s(float a,float b){float r;asm("v_sub_f32_e32 %0, %1, %2":"=v"(r):"v"(a),"v"(b));return r;}
typedef float f32x2_t __attribute__((ext_vector_type(2))); typedef __bf16 bf16x2_t __attribute__((ext_vector_type(2)));
__device__ __forceinline__ unsigned cvtpk_s(float lo,float hi){f32x2_t v={lo,hi};bf16x2_t b=__builtin_convertvector(v,bf16x2_t);return __builtin_bit_cast(unsigned,b);}
#define WAIT_BAR(N) asm volatile("s_waitcnt vmcnt(" #N ") lgkmcnt(0)\n\ts_barrier":::"memory")

__device__ __forceinline__ void qkt(f32x16&p0,f32x16&p1,const char*Kslot,const bf16x8*qr,const bf16x8 qx,const bf16x8 kx0,const bf16x8 kx1,int r32,int hi){
  const f32x16 negm=f32x16{};
  const char*kb=Kslot+hi*1024+r32*16;
  #pragma unroll
  for(int d0=0;d0<4;++d0){
    const bf16x8 b0=*reinterpret_cast<const bf16x8*>(kb+d0*2048);
    const bf16x8 b1=*reinterpret_cast<const bf16x8*>(kb+d0*2048+512);
    if(d0==0){p0=__builtin_amdgcn_mfma_f32_32x32x16_bf16(b0,qr[0],negm,0,0,0);p1=__builtin_amdgcn_mfma_f32_32x32x16_bf16(b1,qr[0],negm,0,0,0);}
    else{p0=__builtin_amdgcn_mfma_f32_32x32x16_bf16(b0,qr[d0],p0,0,0,0);p1=__builtin_amdgcn_mfma_f32_32x32x16_bf16(b1,qr[d0],p1,0,0,0);}}
  p0=__builtin_amdgcn_mfma_f32_32x32x16_bf16(kx0,qx,p0,0,0,0);p1=__builtin_amdgcn_mfma_f32_32x32x16_bf16(kx1,qx,p1,0,0,0);
}
typedef __attribute__((address_space(3))) const char* lds_cptr;
typedef short v4i16_t __attribute__((ext_vector_type(4)));
__device__ __forceinline__ void kload8(bf16x8*kf,lds_cptr kp){
  kf[0]=*(const __attribute__((address_space(3))) bf16x8*)(kp);      kf[1]=*(const __attribute__((address_space(3))) bf16x8*)(kp+512);
  kf[2]=*(const __attribute__((address_space(3))) bf16x8*)(kp+2048); kf[3]=*(const __attribute__((address_space(3))) bf16x8*)(kp+2560);
  kf[4]=*(const __attribute__((address_space(3))) bf16x8*)(kp+4096); kf[5]=*(const __attribute__((address_space(3))) bf16x8*)(kp+4608);
  kf[6]=*(const __attribute__((address_space(3))) bf16x8*)(kp+6144); kf[7]=*(const __attribute__((address_space(3))) bf16x8*)(kp+6656);
}
__device__ __forceinline__ void kload2(bf16x8*kf,lds_cptr kp,int j){ kf[2*j]=*(const __attribute__((address_space(3))) bf16x8*)(kp+j*2048); kf[2*j+1]=*(const __attribute__((address_space(3))) bf16x8*)(kp+j*2048+512); }
__device__ __forceinline__ s16x4 vtr(lds_cptr p){ return __builtin_bit_cast(s16x4,__builtin_amdgcn_ds_read_tr16_b64_v4i16((__attribute__((address_space(3))) v4i16_t*)p)); }
typedef unsigned u32x2_t __attribute__((ext_vector_type(2)));
__device__ __forceinline__ u32x2_t ldkx_raw(lds_cptr p){ return *(const __attribute__((address_space(3))) u32x2_t*)p; }
__device__ __forceinline__ bf16x8 mkkx(u32x2_t w){ const u32x4 v={w.x,w.y,0x3F803F80u,0u}; return __builtin_bit_cast(bf16x8,v); }
__device__ __forceinline__ bf16x8 ldkx(lds_cptr p){ const u32x2_t w=*(const __attribute__((address_space(3))) u32x2_t*)p; const u32x4 v={w.x,w.y,0x3F803F80u,0u}; return __builtin_bit_cast(bf16x8,v); }
__device__ __forceinline__ bf16x8 make_qx(float a,int hi){
  const unsigned ah=cvtpk_s(a,0.f)&0xffffu; const float r1=a-__uint_as_float(ah<<16);
  const unsigned am=cvtpk_s(r1,0.f)&0xffffu; const float r2=r1-__uint_as_float(am<<16);
  u32x4 v={0x3F803F80u,0x3F80u|(ah<<16),cvtpk_s(r1,r2),0u};
  if(hi){v=(u32x4){0u,0u,0u,0u};}
  return __builtin_bit_cast(bf16x8,v);
}
__device__ __forceinline__ float rowmax(const f32x16&p0,const f32x16&p1){
  float a=max3f(p0[0],p0[1],p1[0]),b=max3f(p0[2],p0[3],p1[1]);a=max3f(a,p1[2],p1[3]);
  #pragma unroll
  for(int r=4;r<16;r+=4){a=max3f(a,p0[r],p0[r+1]);b=max3f(b,p0[r+2],p0[r+3]);a=max3f(a,p1[r],p1[r+1]);b=max3f(b,p1[r+2],p1[r+3]);}
  const float m=max2f(a,b);
  auto rr=__builtin_amdgcn_permlane32_swap(__float_as_uint(m),__float_as_uint(m),false,false);
  return max2f(__uint_as_float(rr[0]),__uint_as_float(rr[1]));
}
__device__ __forceinline__ void pv(f32x16*o,int vb,bf16x8 pa0,bf16x8 pa1,bf16x8 pa2,bf16x8 pa3){
  #pragma unroll
  for(int d0=0;d0<2;++d0){s16x4 lo[4],hi[4];
    #pragma unroll
    for(int ks=0;ks<4;++ks){
      asm volatile("ds_read_b64_tr_b16 %0,%1 offset:%c2":"=&v"(lo[ks]):"v"(vb),"i"(d0*4096+ks*1024):"memory");
      asm volatile("ds_read_b64_tr_b16 %0,%1 offset:%c2":"=&v"(hi[ks]):"v"(vb),"i"(d0*4096+ks*1024+512):"memory");}
    asm volatile("s_waitcnt lgkmcnt(0)":::"memory");SBAR();
    #define PK(k) (bf16x8){lo[k][0],lo[k][1],lo[k][2],lo[k][3],hi[k][0],hi[k][1],hi[k][2],hi[k][3]}
    o[d0]=__builtin_amdgcn_mfma_f32_32x32x16_bf16(pa0,PK(0),o[d0],0,0,0);
    o[d0]=__builtin_amdgcn_mfma_f32_32x32x16_bf16(pa1,PK(1),o[d0],0,0,0);
    o[d0]=__builtin_amdgcn_mfma_f32_32x32x16_bf16(pa2,PK(2),o[d0],0,0,0);
    o[d0]=__builtin_amdgcn_mfma_f32_32x32x16_bf16(pa3,PK(3),o[d0],0,0,0);
    #undef PK
  }
}

#ifndef ATTN_STORE16
#define ATTN_STORE16(p,v) (*(u32x4*)(p)=(v))
#endif
template<int THRL> __device__ __forceinline__ void attn_unit(int b,int h,int qb,const bf16*Q,const bf16*__restrict__ K,const bf16*__restrict__ V,bf16*O,const unsigned long long*KX8,const float*GF,const float*QKB,float*SSQ,char*shm,const int tid){
  const int lane=tid&63,r32=lane&31,hi=lane>>5; const int wid=__builtin_amdgcn_readfirstlane(tid>>6);
  const long rowbase=(long)b*SEQ; const int q0=qb*QB;
  const bf16*Qw=Q+(rowbase+q0+wid*QBLK)*DM+h*D;
  const bf16*Kh=K+rowbase*DM+h*D,*Vh=V+rowbase*DM+h*D;
  const unsigned lds0=(unsigned)(uintptr_t)shm;
  float*wsf=(float*)(shm+LDS_WS)+wid*64;
  const bf16*ksrc=Kh+wid*8;
  const bf16*vsrc=Vh+(long)(16*(wid&3))*DM+(wid>>2)*32;
  const unsigned kvoff=(unsigned)lane*(DM*2), vvoff=(unsigned)((lane>>2)*DM+(lane&3)*8)*2u;
  const unsigned kdst=lds0+LDS_K+wid*1024, vdst=lds0+LDS_V+wid*1024;
  #define DMA_K(t,slot) glds16s(ksrc+(long)(NT-1-(t))*KVBLK*DM,kvoff,(unsigned)__builtin_amdgcn_readfirstlane(kdst+(slot)))
  #define DMA_V(t,slot) glds16s(vsrc+(long)(NT-1-(t))*KVBLK*DM,vvoff,(unsigned)__builtin_amdgcn_readfirstlane(vdst+(slot)))
  const int vb0=(int)(lds0+LDS_V)+((lane>>4)&1)*32+(lane&3)*8+(4*hi+((lane&15)>>2))*64;
  const char*Kbase=shm+LDS_K; bf16x8 kf[8];
  const lds_cptr shm3=(lds_cptr)shm; const lds_cptr kp0=shm3+LDS_K+hi*1024+r32*16; const lds_cptr vp0=shm3+LDS_V+((lane>>4)&1)*32+(lane&3)*8+(4*hi+((lane&15)>>2))*64;
  const int NT=(q0+QB)/KVBLK;
  const lds_cptr tp0=shm3+LDS_TAB+r32*8;
  const float nGi=-GF[(long)(b*NHEAD+h)*SEQ+q0+wid*QBLK+r32];
  float gl0,gl1,gthr,bqk;
  { const float*gfh=GF+(long)(b*NHEAD+h)*SEQ; gl0=(lane<NT)?gfh[64*lane+63]:3.0e38f; gl1=(lane+64<NT)?gfh[64*(lane+64)+63]:3.0e38f;
    float kp=QKB[(b*NHEAD+h)*16+(lane&15)];
    #define DPPMAX_(v,c) fmaxf((v),__builtin_bit_cast(float,__builtin_amdgcn_update_dpp(0,__builtin_bit_cast(int,(v)),(c),0xf,0xf,false)))
    kp=DPPMAX_(kp,0xB1);kp=DPPMAX_(kp,0x4E);kp=DPPMAX_(kp,0x141);kp=DPPMAX_(kp,0x140);
    #undef DPPMAX_
    const float bq=2.04f*sqrtf(QKB[512+(b*NHEAD+h)*32+qb]*kp);
    gthr=gfh[q0]-(TCUT+2.f*bq); bqk=bq; }
  DMA_K(0,0);DMA_V(0,0);DMA_K(1,SLOTB);
  bf16x8 qr[4];
  #pragma unroll
  for(int d0=0;d0<4;++d0)qr[d0]=*reinterpret_cast<const bf16x8*>(&Qw[(long)r32*DM+d0*16+hi*8]);
  { float dd=0.f; const bf16*Kd=Kh+(long)(q0+wid*QBLK+r32)*DM+hi*8;
    #pragma unroll
    for(int d0=0;d0<4;++d0){ const bf16x8 kk=*reinterpret_cast<const bf16x8*>(Kd+d0*16);
      #pragma unroll
      for(int j=0;j<8;++j)dd+=__uint_as_float((unsigned)(unsigned short)qr[d0][j]<<16)*__uint_as_float((unsigned)(unsigned short)kk[j]<<16); }
    { const auto rr=__builtin_amdgcn_permlane32_swap(__float_as_uint(dd),__float_as_uint(dd),false,false); dd=__uint_as_float(rr[0])+__uint_as_float(rr[1]); }
    float vm=dd-nGi;
    #define DPPMIN_(v,c) fminf((v),__builtin_bit_cast(float,__builtin_amdgcn_update_dpp(0,__builtin_bit_cast(int,(v)),(c),0xf,0xf,false)))
    vm=DPPMIN_(vm,0xB1);vm=DPPMIN_(vm,0x4E);vm=DPPMIN_(vm,0x141);vm=DPPMIN_(vm,0x140);
    #undef DPPMIN_
    { const auto rr=__builtin_amdgcn_permlane16_swap(__float_as_uint(vm),__float_as_uint(vm),false,false); vm=fminf(__uint_as_float(rr[0]),__uint_as_float(rr[1])); }
    if(lane==0)wsf[0]=vm; }
  int NS=NT;
  { const int cnt=__builtin_popcountll(__ballot(gl0<gthr))+__builtin_popcountll(__ballot(gl1<gthr)); int tlo=cnt&~1; if(tlo>NT-4)tlo=NT-4; NS=__builtin_amdgcn_readfirstlane(NT-tlo); }
  { const char*tsrc=(const char*)(KX8+(long)(b*NHEAD+h)*SEQ); const int npc=2*(qb+1);
    for(int pc=((NT-NS)>>1)+wid;pc<npc;pc+=NW)glds16s(tsrc+(long)pc*1024,(unsigned)lane*16u,(unsigned)__builtin_amdgcn_readfirstlane(lds0+LDS_TAB+pc*1024)); }
  float mhat=0.f,l_reg=0.f;f32x16 o[2];o[0]=f32x16{};o[1]=f32x16{};bf16x8 qx=make_qx(nGi,hi);const f32x16 zc=f32x16{};
  if(hi==0)wsf[32+r32]=nGi;
  const int qrel=wid*QBLK+r32;
  #define CMASK(P0,P1,t) do{int jb_=3-(t); if(jb_>=0)cmask(P0,P1,jb_,qrel,hi);}while(0)
  bool resc=false;
  #define START(P0,P1) do{ const float rm=rowmax(P0,P1); resc=false; \
    { const float dl=(rm<-1e30f)?0.f:rm; mhat=fadd_s(mhat,dl); \
      _Pragma("unroll") for(int r=0;r<16;++r){P0[r]=fsub_s(P0[r],dl);P1[r]=fsub_s(P1[r],dl);} \
      qx=make_qx(nGi-mhat,hi); } \
    _Pragma("unroll") for(int r=0;r<16;++r)P0[r]=__builtin_amdgcn_exp2f(P0[r]); }while(0)
  #define RESC() do{ if(resc){ asm volatile("s_waitcnt lgkmcnt(0)":::"memory"); \
      _Pragma("unroll") for(int d_=0;d_<2;++d_) _Pragma("unroll") for(int r=0;r<16;++r)o[d_][r]*=wsf[crow(r,hi)]; } }while(0)
  f32x16 pA0,pA1,pB0,pB1;
  int sl_prev=0,sl_cur=0,sl_next=SLOTB;
  #define ROT() do{sl_prev=sl_cur;sl_cur=sl_next;sl_next=(sl_next==(NSLOT-1)*SLOTB)?0:sl_next+SLOTB;}while(0)
  DMA_K(2,2*SLOTB);
  WAIT_BAR(1);
  { float bm=((const float*)(shm+LDS_WS))[0];
    #pragma unroll
    for(int w_=1;w_<NW;++w_)bm=fminf(bm,((const float*)(shm+LDS_WS))[w_*64]);
    const float gthr2=bm-bqk-TCUT-0.05f;
    const int cnt=__builtin_popcountll(__ballot(gl0<gthr2))+__builtin_popcountll(__ballot(gl1<gthr2)); int tlo=cnt&~1; if(tlo>NT-4)tlo=NT-4; const int ns2=__builtin_amdgcn_readfirstlane(NT-tlo); if(ns2<NS)NS=ns2; }
  qkt(pA0,pA1,Kbase,qr,qx,ldkx(tp0+(NT-1)*512),ldkx(tp0+(NT-1)*512+256),r32,hi);asm volatile("s_nop 15\n\ts_nop 7":"+v"(pA0),"+v"(pA1));CMASK(pA0,pA1,0);
  START(pA0,pA1);
  _Pragma("unroll") for(int r=0;r<16;++r)pA1[r]=__builtin_amdgcn_exp2f(pA1[r]);
  WAIT_BAR(0);
  DMA_K(3,0);DMA_V(1,SLOTB);
  ROT();
  kload8(kf,kp0+sl_cur);
  WAIT_BAR(2);
  s16x4 vlo[8],vhi[8]; u32x4 pw0,pw1,pw2,pw3;
  #define PKW(P,B) cvtpk_s(P[B],P[B+1])
  #define PAF(k) __builtin_bit_cast(bf16x8,pw##k)
  #define VFR(i) (bf16x8){vlo[i][0],vlo[i][1],vlo[i][2],vlo[i][3],vhi[i][0],vhi[i][1],vhi[i][2],vhi[i][3]}
  #define PIN(x) asm volatile("":"+v"(x))
  #define MX3(a,b,c) __builtin_fmaxf(__builtin_fmaxf((a),(b)),(c))
  #define GAPA(MF,A0,A1,A2,A3,W0,W1,PW) do{ MF; sacc+=A0; sacc+=A1; sacc+=A2; sacc+=A3; PIN(sacc); W0; W1; PIN(PW); SBAR(); }while(0)
  #define EX(v) __builtin_amdgcn_exp2f(v)
  #define GAPB(MF,X,B) do{ MF; X[B]=EX(X[B]); X[B+1]=EX(X[B+1]); X[B+2]=EX(X[B+2]); X[B+3]=EX(X[B+3]); PIN(X); SBAR(); }while(0)
  #define VRD(i) do{ vlo[i]=vtr(vp_+(((i)>>2)*4096+((i)&3)*1024)); vhi[i]=vtr(vp_+(((i)>>2)*4096+((i)&3)*1024+512)); }while(0)
  #define KRD(G,j) do{ if(G){ kload2(kf,kp0+sl_next,j); SBAR(); } }while(0)
  #define STEP(C0,C1,P0,P1,t,GK,GV,GL) do{ SBAR(); \
    const lds_cptr vp_=vp0+sl_prev; \
    const u32x2_t kq0_=ldkx_raw(tp0+(NT-1-(t))*512), kq1_=ldkx_raw(tp0+(NT-1-(t))*512+256); \
    VRD(0); SBAR(); float sacc=(P0[0]+P0[1]); \
    GAPA(C0=__builtin_amdgcn_mfma_f32_32x32x16_bf16(kf[0],qr[0],zc,0,0,0), P0[2],P0[3],P0[4],P0[5],     pw0[0]=PKW(P0,0), pw0[1]=PKW(P0,2), pw0); \
    VRD(4); SBAR(); GAPA(C1=__builtin_amdgcn_mfma_f32_32x32x16_bf16(kf[1],qr[0],zc,0,0,0), P0[6],P0[7],P0[8],P0[9],     pw0[2]=PKW(P0,4), pw0[3]=PKW(P0,6), pw0); \
    C0=__builtin_amdgcn_mfma_f32_32x32x16_bf16(mkkx(kq0_),qx,C0,0,0,0); SBAR(); C1=__builtin_amdgcn_mfma_f32_32x32x16_bf16(mkkx(kq1_),qx,C1,0,0,0); SBAR(); \
    VRD(1); SBAR(); GAPA(C0=__builtin_amdgcn_mfma_f32_32x32x16_bf16(kf[2],qr[1],C0,0,0,0),   P0[10],P0[11],P0[12],P0[13], pw1[0]=PKW(P0,8), pw1[1]=PKW(P0,10), pw1); \
    VRD(5); SBAR(); GAPA(C1=__builtin_amdgcn_mfma_f32_32x32x16_bf16(kf[3],qr[1],C1,0,0,0),   P0[14],P0[15],P1[0],P1[1],   pw1[2]=PKW(P0,12),pw1[3]=PKW(P0,14), pw1); \
    VRD(2); SBAR(); GAPA(C0=__builtin_amdgcn_mfma_f32_32x32x16_bf16(kf[4],qr[2],C0,0,0,0),   P1[2],P1[3],P1[4],P1[5],     pw2[0]=PKW(P1,0), pw2[1]=PKW(P1,2), pw2); \
    VRD(6); SBAR(); GAPA(C1=__builtin_amdgcn_mfma_f32_32x32x16_bf16(kf[5],qr[2],C1,0,0,0),   P1[6],P1[7],P1[8],P1[9],     pw2[2]=PKW(P1,4), pw2[3]=PKW(P1,6), pw2); \
    VRD(3); SBAR(); GAPA(C0=__builtin_amdgcn_mfma_f32_32x32x16_bf16(kf[6],qr[3],C0,0,0,0),   P1[10],P1[11],P1[12],P1[13], pw3[0]=PKW(P1,8), pw3[1]=PKW(P1,10), pw3); \
    VRD(7); SBAR(); GAPA(C1=__builtin_amdgcn_mfma_f32_32x32x16_bf16(kf[7],qr[3],C1,0,0,0),   P1[14],P1[15],0.f,0.f,       pw3[2]=PKW(P1,12),pw3[3]=PKW(P1,14), pw3); \
    l_reg+=sacc; \
    if(GK){DMA_K((t)+3,sl_cur);} if(GV){DMA_V((t)+1,sl_next);} \
    CMASK(C0,C1,t); \
    { float a=MX3(C0[0],C0[1],C1[0]),b=MX3(C0[2],C0[3],C1[1]); a=MX3(a,C1[2],C1[3]); \
      _Pragma("unroll") for(int r=4;r<16;r+=4){a=MX3(a,C0[r],C0[r+1]);b=MX3(b,C0[r+2],C0[r+3]);a=MX3(a,C1[r],C1[r+1]);b=MX3(b,C1[r+2],C1[r+3]);} \
      float rm=__builtin_fmaxf(a,b); { auto rr=__builtin_amdgcn_permlane32_swap(__float_as_uint(rm),__float_as_uint(rm),false,false); rm=__builtin_fmaxf(__uint_as_float(rr[0]),__uint_as_float(rr[1])); } \
      resc=false; \
      if(__builtin_expect(__any(rm>(float)THRL),0)){ const float dl=__builtin_fmaxf(rm,0.f); mhat+=dl; \
        _Pragma("unroll") for(int r=0;r<16;++r){C0[r]-=dl;C1[r]-=dl;} \
        qx=make_qx(wsf[32+r32]-mhat,hi); \
        const float f=__builtin_amdgcn_exp2f(-dl); l_reg*=f; if(hi==0)wsf[r32]=f; resc=true; } } \
    SBAR(); \
    GAPB(o[0]=__builtin_amdgcn_mfma_f32_32x32x16_bf16(PAF(0),VFR(0),o[0],0,0,0), C0,0); \
    GAPB(o[1]=__builtin_amdgcn_mfma_f32_32x32x16_bf16(PAF(0),VFR(4),o[1],0,0,0), C0,4); \
    KRD(GL,0); GAPB(o[0]=__builtin_amdgcn_mfma_f32_32x32x16_bf16(PAF(1),VFR(1),o[0],0,0,0), C0,8); \
    KRD(GL,1); GAPB(o[1]=__builtin_amdgcn_mfma_f32_32x32x16_bf16(PAF(1),VFR(5),o[1],0,0,0), C0,12); \
    KRD(GL,2); GAPB(o[0]=__builtin_amdgcn_mfma_f32_32x32x16_bf16(PAF(2),VFR(2),o[0],0,0,0), C1,0); \
    KRD(GL,3); GAPB(o[1]=__builtin_amdgcn_mfma_f32_32x32x16_bf16(PAF(2),VFR(6),o[1],0,0,0), C1,4); \
    GAPB(o[0]=__builtin_amdgcn_mfma_f32_32x32x16_bf16(PAF(3),VFR(3),o[0],0,0,0), C1,8); \
    GAPB(o[1]=__builtin_amdgcn_mfma_f32_32x32x16_bf16(PAF(3),VFR(7),o[1],0,0,0), C1,12); \
    }while(0)
  int t=1;
  #define ENDW(tt) do{ if((tt)+3<NS){WAIT_BAR(2);} else if((tt)+2<NS){WAIT_BAR(1);} else {WAIT_BAR(0);} }while(0)
  for(;t<5&&t+1<NS;t+=2){
    STEP(pB0,pB1,pA0,pA1,t,(t+3<NS),(t+1<NS),(t+1<NS));       ENDW(t);   RESC(); ROT();
    STEP(pA0,pA1,pB0,pB1,t+1,(t+4<NS),(t+2<NS),(t+2<NS));     ENDW(t+1); RESC(); ROT();
  }
  #undef CMASK
  #define CMASK(P0,P1,t) do{}while(0)
  for(;t+5<NS;t+=2){
    STEP(pB0,pB1,pA0,pA1,t,true,true,true);     WAIT_BAR(2); RESC(); ROT();
    STEP(pA0,pA1,pB0,pB1,t+1,true,true,true);   WAIT_BAR(2); RESC(); ROT();
  }
  #undef CMASK
  #define CMASK(P0,P1,t) do{int jb_=3-(t); if(jb_>=0)cmask(P0,P1,jb_,qrel,hi);}while(0)
  for(;t+1<NS;t+=2){
    STEP(pB0,pB1,pA0,pA1,t,(t+3<NS),(t+1<NS),(t+1<NS));       ENDW(t);   RESC(); ROT();
    STEP(pA0,pA1,pB0,pB1,t+1,(t+4<NS),(t+2<NS),(t+2<NS));     ENDW(t+1); RESC(); ROT();
  }
  STEP(pB0,pB1,pA0,pA1,NS-1,false,false,false); RESC();
  { float sacc=pB0[0]+pB0[1]; _Pragma("unroll") for(int r=2;r<16;++r)sacc+=pB0[r]; _Pragma("unroll") for(int r=0;r<16;++r)sacc+=pB1[r]; l_reg+=sacc;
    pw0=(u32x4){PKW(pB0,0),PKW(pB0,2),PKW(pB0,4),PKW(pB0,6)};pw1=(u32x4){PKW(pB0,8),PKW(pB0,10),PKW(pB0,12),PKW(pB0,14)};pw2=(u32x4){PKW(pB1,0),PKW(pB1,2),PKW(pB1,4),PKW(pB1,6)};pw3=(u32x4){PKW(pB1,8),PKW(pB1,10),PKW(pB1,12),PKW(pB1,14)};
    SBAR(); pv(o,vb0+sl_cur,PAF(0),PAF(1),PAF(2),PAF(3)); }
  #undef PKW
  #undef PAF
  #undef VFR
  #undef PIN
  #undef MX3
  #undef GAPA
  #undef GAPB
  #undef EX
  #undef VRD
  #undef KRD
  #undef STEP
  #undef ENDW
  {auto rr=__builtin_amdgcn_permlane32_swap(__float_as_uint(l_reg),__float_as_uint(l_reg),false,false);l_reg=__uint_as_float(rr[0])+__uint_as_float(rr[1]);}
  if(hi==0)wsf[32+r32]=l_reg;asm volatile("s_waitcnt lgkmcnt(0)":::"memory");
  float rli[16];
  #pragma unroll
  for(int r=0;r<16;++r)rli[r]=__builtin_amdgcn_rcpf(wsf[32+crow(r,hi)]);
  bf16*Ow=O+(rowbase+q0+wid*QBLK)*OPITCH+h*D;
  { bf16*stg=(bf16*)(shm+LDS_OST)+wid*2048;
    #pragma unroll
    for(int r=0;r<16;++r){const int orow=crow(r,hi);
      #pragma unroll
      for(int d0=0;d0<2;++d0)stg[orow*64+d0*32+r32]=__float2bfloat16(o[d0][r]*rli[r]);}
    asm volatile("s_waitcnt lgkmcnt(0)":::"memory");
    #pragma unroll
    for(int i=0;i<4;++i){const int row=i*8+(lane>>3),ch=lane&7; const u32x4 v=*(const u32x4*)(stg+row*64+ch*8); ATTN_STORE16(Ow+(long)row*OPITCH+ch*8,v);
      float q=0.f;
      #pragma unroll
      for(int e=0;e<4;++e){const float lo=__uint_as_float(v[e]<<16),hh=__uint_as_float(v[e]&0xffff0000u);q+=lo*lo+hh*hh;}
      q+=__shfl_xor(q,1);q+=__shfl_xor(q,2);q+=__shfl_xor(q,4);
      if(ch==0)SSQ[(rowbase+q0+wid*QBLK+row)*16+8+h]=q;} }
  asm volatile("s_waitcnt lgkmcnt(0)\n\ts_barrier":::"memory");
  #undef DMA_K
  #undef DMA_V
  #undef CMASK
  #undef START
  #undef RESC
  #undef ROT
}
constexpr int ATTN_LDS_BYTES=LDS_BYTES;
struct AttnTensors { const bf16* Q; const bf16* K; const bf16* V; bf16* O; const unsigned long long* KX8; const float* GF; const float* QKB; float* SSQ; };
struct AttnUnit { int bh; int qb; };
struct StaticOrder {
  int vcu;
  __device__ __forceinline__ explicit StaticOrder(int grid,int block):vcu((block%8)*(grid/8)+block/8){}
  __device__ __forceinline__ bool next(int i,AttnUnit&u)const{ if(i>=4)return false; const int s=vcu&7; u.bh=((vcu>>3)+8*i)&31;     u.qb=(i==0)?s:(i==1)?15-s:(i==2)?16+s:31-s; return true; }
  __device__ __forceinline__ void a_ready(const AttnUnit&)const{}
  __device__ __forceinline__ void done(const AttnUnit&)const{}
};
template<class Sched,int THRL=8> __device__ __forceinline__ void attn_phase(char*lds,const AttnTensors&T,const Sched&S,const int tid){
  AttnUnit u;
  for(int i=0;S.next(i,u);++i){ S.a_ready(u); attn_unit<THRL>(u.bh/NHEAD,u.bh%NHEAD,u.qb,T.Q,T.K,T.V,T.O,T.KX8,T.GF,T.QKB,T.SSQ,lds,tid); S.done(u); }
}
#undef SBAR
#undef WAIT_BAR
}

constexpr int NWAVES = 8;
constexpr int N_PHASES = 11;
constexpr int N_LAUNCHES = MK_N_LAUNCHES;

constexpr size_t MiB = 1u << 20;
constexpr size_t WS_CTL = 0, CTL_ZERO_BYTES = 64 * 1024;
constexpr size_t WS_ADAP = 14 * MiB;
constexpr size_t WS_ADA = 2 * MiB;
constexpr size_t WS_WSM = WS_ADA + 128 * 1024;
constexpr size_t WS_LC = 3 * MiB;
constexpr size_t WS_CT = 4 * MiB;
constexpr size_t WS_TOKC = WS_CT + 64 * 1024;
constexpr size_t WS_TW = WS_TOKC + 256 * 1024;
constexpr size_t WS_SSQY = 5 * MiB;
constexpr size_t WS_SSQ1 = 7 * MiB;
constexpr size_t WS_SSQ2 = 9 * MiB;
constexpr size_t WS_INV = 11 * MiB;
constexpr size_t WS_TOK = 14 * MiB;
constexpr size_t WS_SW = WS_TOK + 256 * 1024;
constexpr size_t WS_WIN = 16 * MiB;
constexpr size_t WS_WOUT = 22 * MiB;
constexpr size_t WS_WGU = 24 * MiB;
constexpr size_t WS_WD = 56 * MiB;
constexpr size_t WS_XN = 104 * MiB;
constexpr size_t WS_U = 168 * MiB;
constexpr size_t WS_Y = 328 * MiB;
constexpr size_t WS_H2 = WS_XN;
constexpr size_t WS_H2S = 168 * MiB;
constexpr size_t WS_ACT = 244 * MiB;
constexpr size_t WS_KX8 = 392 * MiB;
constexpr size_t WS_GF = 394 * MiB;
constexpr size_t WS_MIX = 396 * MiB;
constexpr size_t WS_MOE = WS_XN;
constexpr size_t WS_X1 = WS_Y;
constexpr size_t WS_END = 460 * MiB;
static_assert(WS_ACT + (size_t)MAXTILES * 256 * 1024 * 2 <= WS_Y && WS_H2S + (size_t)MAXTILES * 256 * 1024 * 2 <= WS_ACT, "d_ws map");
constexpr int CW_TMO = 0, CW_CODE = 1;
constexpr int CW_CNT = 64, CNT_STRIDE = 64;
constexpr int CW_QKB = 2048;
constexpr int CW_BAR = 4096;
constexpr int RING_OFF = 0, RING_BYTES = 151552;
constexpr int LDSCTL_OFF = RING_BYTES, MISC_OFF = LDSCTL_OFF + 320;
constexpr int TCLS_OFF = LDSCTL_OFF + 512;
constexpr int TFIRST_OFF = LDSCTL_OFF + 704;
constexpr int LCNT_OFF = LDSCTL_OFF + 768;
constexpr int TOKU_OFF = LDSCTL_OFF + 1024;
constexpr int TOKW_OFF = TOKU_OFF + 5120;
static_assert(TOKW_OFF + 5120 <= 163840, "LDS control region");
constexpr int LDS_BYTES = 163840;

#define GAS __attribute__((address_space(1)))
#define LAS __attribute__((address_space(3)))
typedef unsigned short bf16;
typedef unsigned v4u __attribute__((ext_vector_type(4)));
typedef float f32x4 __attribute__((ext_vector_type(4)));
typedef short bf16x8 __attribute__((ext_vector_type(8)));
typedef GAS unsigned gu32;
typedef GAS unsigned long long gu64;
#define RLX_AGENT __ATOMIC_RELAXED, __HIP_MEMORY_SCOPE_AGENT
#define LDS_WAIT() asm volatile("s_waitcnt lgkmcnt(0)" ::: "memory")
#define VM_WAIT() asm volatile("s_waitcnt vmcnt(0)" ::: "memory")
__device__ __forceinline__ unsigned long long rt() { return __builtin_amdgcn_s_memrealtime(); }
__device__ __forceinline__ unsigned f2bf(float f) { unsigned u = __builtin_bit_cast(unsigned, f); return (u + 0x7fffu + ((u >> 16) & 1u)) >> 16; }
typedef float f32x2_hw __attribute__((ext_vector_type(2))); typedef __bf16 bf16x2_hw __attribute__((ext_vector_type(2)));
__device__ __forceinline__ unsigned pk2(float lo, float hi) { const f32x2_hw v = {lo, hi}; const bf16x2_hw b = __builtin_convertvector(v, bf16x2_hw); return __builtin_bit_cast(unsigned, b); }

#define XB_TMO      128
#define XB_XCNT(j)  (256  + 64 * (j))
#define XB_XSUB(j)  (1280 + 64 * (j))
#define XB_XGEN(j)  (2304 + 64 * (j))
#define XB_TOP      3328
#define XB_TOPGEN   3392
#define XCD_BAR_WORDS 3456
#define XB_SPIN_CAP (1u << 18)

__device__ __forceinline__ unsigned xb_ld(unsigned* p)              { return __hip_atomic_load(p, __ATOMIC_RELAXED, __HIP_MEMORY_SCOPE_AGENT); }
__device__ __forceinline__ unsigned xb_add(unsigned* p, unsigned v) { return __hip_atomic_fetch_add(p, v, __ATOMIC_RELAXED, __HIP_MEMORY_SCOPE_AGENT); }
__device__ __forceinline__ unsigned xb_xcc_id() { return (unsigned)__builtin_amdgcn_s_getreg((3 << 11) | 20) & 0xFu; }
#define XB_SPIN(cond, bar) do { unsigned _sp = 0; while (cond) { __builtin_amdgcn_s_sleep(1); \
    if ((++_sp & 255u) == 0u) { if (xb_ld(&(bar)[XB_TMO])) break; if (_sp > XB_SPIN_CAP) { atomicAdd(&(bar)[XB_TMO], 1u); break; } } } } while (0)

struct XcdBarrier {
    unsigned* bar; unsigned x;
    volatile LAS unsigned* st;
};

__device__ __forceinline__ XcdBarrier xcd_barrier_post(unsigned* bar, volatile LAS unsigned* st) {
    XcdBarrier b; b.bar = bar; b.x = xb_xcc_id(); b.st = st;
    if (threadIdx.x == 0) (void)xb_add(&bar[XB_XCNT(b.x)], 1u);
    return b;
}
__device__ __forceinline__ void xcd_barrier_complete(unsigned* bar, unsigned x, unsigned& nloc, unsigned& nx) {
    const unsigned G = gridDim.x * gridDim.y * gridDim.z;
    unsigned sum, cnt, mine, sp = 0u;
    for (;;) {
        sum = 0u; cnt = 0u; mine = 0u;
#pragma unroll
        for (unsigned j = 0; j < 16; ++j) { const unsigned c = xb_ld(&bar[XB_XCNT(j)]); sum += c; cnt += (c > 0u) ? 1u : 0u; mine = (j == x) ? c : mine; }
        if (sum == G) break;
        __builtin_amdgcn_s_sleep(1);
        if ((++sp & 255u) == 0u) { if (xb_ld(&bar[XB_TMO])) break; if (sp > XB_SPIN_CAP) { atomicAdd(&bar[XB_TMO], 1u); break; } }
    }
    nloc = mine > 0u ? mine : 1u; nx = cnt > 0u ? cnt : 1u;
}

__device__ __forceinline__ void xcd_barrier(const XcdBarrier& b) {
    asm volatile("s_waitcnt vmcnt(0)" ::: "memory");
    __syncthreads();
    if (threadIdx.x == 0) {
        unsigned* bar = b.bar;
        __builtin_amdgcn_s_waitcnt(0);
        unsigned nloc = b.st[0], nx = b.st[1];
        if (nloc == 0u) { xcd_barrier_complete(bar, b.x, nloc, nx); b.st[0] = nloc; b.st[1] = nx; }
        const unsigned old = xb_add(&bar[XB_XSUB(b.x)], 1u);
        const unsigned gen = old / nloc;
        if (old + 1u == (gen + 1u) * nloc) {
            __builtin_amdgcn_fence(__ATOMIC_RELEASE, "agent");
            asm volatile("s_waitcnt vmcnt(0)" ::: "memory");
            const unsigned og = xb_add(&bar[XB_TOP], 1u);
            const unsigned tg = og / nx;
            if (og + 1u == (tg + 1u) * nx) xb_add(&bar[XB_TOPGEN], 1u);
            else XB_SPIN(xb_ld(&bar[XB_TOPGEN]) == tg, bar);
            __builtin_amdgcn_fence(__ATOMIC_ACQUIRE, "agent");
            xb_add(&bar[XB_XGEN(b.x)], 1u);
            asm volatile("s_waitcnt vmcnt(0)" ::: "memory");
        } else {
            XB_SPIN(xb_ld(&bar[XB_XGEN(b.x)]) == gen, bar);
            __builtin_amdgcn_fence(__ATOMIC_ACQUIRE, "agent");
            asm volatile("s_waitcnt vmcnt(0)" ::: "memory");
        }
    }
    __syncthreads();
}

struct Frame {
    LAS unsigned char* lds;
    volatile LAS unsigned* MISC;
    gu32* ctl;
    int tid, lane, wave;
    int vcu, G;
    unsigned char* ws;
    const float *x, *c, *w_ada, *b_ada, *g_mix, *w_in, *g_sgu, *w_sp, *b_sp, *b_fg, *g_osgu, *g_ofox, *w_out, *g_ffn, *w_rg, *b_rg, *w_re, *b_re, *w_gate, *w_up, *w_down, *g_fin;
    float* out;
};
#define DPP_ADD(v, ctrl) ((v) + __builtin_bit_cast(float, __builtin_amdgcn_update_dpp(0, __builtin_bit_cast(int, (v)), (ctrl), 0xf, 0xf, false)))
__device__ __forceinline__ float wave_sum(float v) {
    v = DPP_ADD(v, 0xB1); v = DPP_ADD(v, 0x4E); v = DPP_ADD(v, 0x141); v = DPP_ADD(v, 0x140);
    const int iv = __builtin_bit_cast(int, v);
    const float a = __builtin_bit_cast(float, __builtin_amdgcn_readlane(iv, 0)), b = __builtin_bit_cast(float, __builtin_amdgcn_readlane(iv, 16)), c = __builtin_bit_cast(float, __builtin_amdgcn_readlane(iv, 32)), e = __builtin_bit_cast(float, __builtin_amdgcn_readlane(iv, 48));
    return (a + b) + (c + e);
}
#define DPP_MOV(v, ctrl) __builtin_bit_cast(float, __builtin_amdgcn_update_dpp(0, __builtin_bit_cast(int, (v)), (ctrl), 0xf, 0xf, false))
#define SWZ_ADD(v, pat) ((v) + __builtin_bit_cast(float, __builtin_amdgcn_ds_swizzle(__builtin_bit_cast(int, (v)), (pat))))
__device__ __forceinline__ float sum_b2_b5(float v) { v = SWZ_ADD(v, 0x101F); v = SWZ_ADD(v, 0x201F); v = SWZ_ADD(v, 0x401F);
    const auto rr = __builtin_amdgcn_permlane32_swap(__float_as_uint(v), __float_as_uint(v), false, false); return __uint_as_float(rr[0]) + __uint_as_float(rr[1]); }
__device__ __forceinline__ void wave_sum8_t(const float (&v)[8], int lane, float& r0, float& r1) {
    const bool b0 = (lane & 1) != 0, b1 = (lane & 2) != 0; float a[4], c[2];
#pragma unroll
    for (int i = 0; i < 4; ++i) { const float keep = b0 ? v[i + 4] : v[i], send = b0 ? v[i] : v[i + 4]; a[i] = keep + DPP_MOV(send, 0xB1); }
#pragma unroll
    for (int i = 0; i < 2; ++i) { const float keep = b1 ? a[i + 2] : a[i], send = b1 ? a[i] : a[i + 2]; c[i] = keep + DPP_MOV(send, 0x4E); }
    r0 = sum_b2_b5(c[0]); r1 = sum_b2_b5(c[1]);
}
__device__ __forceinline__ void wave_sum4_all(float (&v)[4], int lane) {
    const bool b0 = (lane & 1) != 0, b1 = (lane & 2) != 0; float a[2];
#pragma unroll
    for (int i = 0; i < 2; ++i) { const float keep = b0 ? v[i + 2] : v[i], send = b0 ? v[i] : v[i + 2]; a[i] = keep + DPP_MOV(send, 0xB1); }
    const float keep = b1 ? a[1] : a[0], send = b1 ? a[0] : a[1]; float c = keep + DPP_MOV(send, 0x4E);
    c = sum_b2_b5(c); const int ic = __builtin_bit_cast(int, c);
    v[0] = __builtin_bit_cast(float, __builtin_amdgcn_readlane(ic, 0)); v[1] = __builtin_bit_cast(float, __builtin_amdgcn_readlane(ic, 2)); v[2] = __builtin_bit_cast(float, __builtin_amdgcn_readlane(ic, 1)); v[3] = __builtin_bit_cast(float, __builtin_amdgcn_readlane(ic, 3));
}
__device__ __forceinline__ float wave_max(float v) {
#pragma unroll
    for (int o = 1; o < 64; o <<= 1) v = fmaxf(v, __shfl_xor(v, o));
    return v;
}
__device__ __forceinline__ int lane_id_fresh() { int t, l; asm volatile("v_mbcnt_lo_u32_b32 %0, -1, 0" : "=v"(t)); asm volatile("v_mbcnt_hi_u32_b32 %0, -1, %1" : "=v"(l) : "v"(t)); return l; }
typedef unsigned u32x2nt __attribute__((ext_vector_type(2)));
__device__ __forceinline__ uint2 nt_load(const uint2* p) { const u32x2nt v = __builtin_nontemporal_load((const u32x2nt*)p); uint2 r; r.x = v.x; r.y = v.y; return r; }
__device__ __forceinline__ uint4 nt_load(const uint4* p) { const v4u v = __builtin_nontemporal_load((const v4u*)p); uint4 r; r.x = v.x; r.y = v.y; r.z = v.z; r.w = v.w; return r; }
__device__ __forceinline__ float bf2f(unsigned short h) { return __uint_as_float((unsigned)h << 16); }

__device__ __forceinline__ void p0_tr_item(const float* W, int ldw, int k0, int n0, bf16* dst, int ldt, const float* kscale, LAS float* scr, int lane) {
    typedef float f32x2_t __attribute__((ext_vector_type(2)));
    f32x2_t tv[32];
#pragma unroll
    for (int i = 0; i < 32; ++i) { const int kk = 2 * i + (lane >> 5); tv[i] = __builtin_nontemporal_load((const f32x2_t*)(W + (size_t)(k0 + kk) * ldw + n0 + 2 * (lane & 31))); }
    if (kscale) {
#pragma unroll
        for (int i = 0; i < 32; ++i) tv[i] = tv[i] * kscale[k0 + 2 * i + (lane >> 5)]; }
#pragma unroll
    for (int i = 0; i < 32; ++i) { LAS float* p = scr + (2 * i + (lane >> 5)) * 65 + 2 * (lane & 31); p[0] = tv[i].x; p[1] = tv[i].y; }
    LDS_WAIT(); asm volatile("" ::: "memory");
    const int c = lane & 7;
#pragma unroll
    for (int j = 0; j < 8; ++j) { const int n = (lane >> 3) + 8 * j; const LAS float* s = scr + (8 * c) * 65 + n;
        v4u o; o.x = pk2(s[0 * 65], s[1 * 65]); o.y = pk2(s[2 * 65], s[3 * 65]); o.z = pk2(s[4 * 65], s[5 * 65]); o.w = pk2(s[6 * 65], s[7 * 65]);
        *(GAS v4u*)(dst + (size_t)n * ldt + 8 * c) = o; }
    LDS_WAIT(); asm volatile("" ::: "memory");
}
__device__ __forceinline__ void p0_tr_item8(const float* W, int ldw, int k0, int n0, unsigned char* dst, int ldt, float scale, LAS float* scr, int lane) {
    typedef float f32x2_t __attribute__((ext_vector_type(2))); typedef int v2i_t __attribute__((ext_vector_type(2)));
    f32x2_t tv[32];
#pragma unroll
    for (int i = 0; i < 32; ++i) { const int kk = 2 * i + (lane >> 5); tv[i] = __builtin_nontemporal_load((const f32x2_t*)(W + (size_t)(k0 + kk) * ldw + n0 + 2 * (lane & 31))); }
#pragma unroll
    for (int i = 0; i < 32; ++i) { LAS float* p = scr + (2 * i + (lane >> 5)) * 65 + 2 * (lane & 31); p[0] = __builtin_amdgcn_fmed3f(tv[i].x * scale, -448.f, 448.f); p[1] = __builtin_amdgcn_fmed3f(tv[i].y * scale, -448.f, 448.f); }
    LDS_WAIT(); asm volatile("" ::: "memory");
    const int c = lane & 7;
#pragma unroll
    for (int j = 0; j < 8; ++j) { const int n = (lane >> 3) + 8 * j; const LAS float* s = scr + (8 * c) * 65 + n; int p0 = 0, p1 = 0;
        p0 = __builtin_amdgcn_cvt_pk_fp8_f32(s[0 * 65], s[1 * 65], p0, false); p0 = __builtin_amdgcn_cvt_pk_fp8_f32(s[2 * 65], s[3 * 65], p0, true);
        p1 = __builtin_amdgcn_cvt_pk_fp8_f32(s[4 * 65], s[5 * 65], p1, false); p1 = __builtin_amdgcn_cvt_pk_fp8_f32(s[6 * 65], s[7 * 65], p1, true);
        *(v2i_t*)(dst + (size_t)n * ldt + 8 * c) = (v2i_t){p0, p1}; }
    LDS_WAIT(); asm volatile("" ::: "memory");
}
__device__ __forceinline__ void p0_prologue(Frame& F) {
    LAS float* scr = (LAS float*)(F.lds + RING_OFF + F.wave * 16896);
    const int gw = F.vcu * NWAVES + F.wave, NGW = F.G * NWAVES;
    bf16* WIN = (bf16*)(F.ws + WS_WIN); bf16* WOUT = (bf16*)(F.ws + WS_WOUT); bf16* WGU = (bf16*)(F.ws + WS_WGU); bf16* WD = (bf16*)(F.ws + WS_WD);
    constexpr int I_ADA = 16 * 24;
    constexpr int I_IN = (D / 64) * (NPROJ / 64);
    constexpr int I_OUT = (D / 64) * (D / 64);
    constexpr int I_GU1 = (D / 64) * (DEXP / 64);
    constexpr int I_GU = NEXP * 2 * I_GU1;
    constexpr int I_DC1 = (DEXP / 64) * (D / 64);
    constexpr int I_DC = NEXP * I_DC1;
    constexpr int I_SM = 8 * 128 * 128 / 512;
    constexpr int NITEMS = I_ADA + I_IN + I_OUT + I_SM;
    for (int it = gw; it < NITEMS; it += NGW) {
        int r = it;
        if (r < I_ADA) {
            const int kp = r / 24, cg = r % 24; const int n = cg * 256 + F.lane * 4;
            f32x4 a0 = {0.f, 0.f, 0.f, 0.f}, a1 = a0, a2 = a0, a3 = a0;
#pragma unroll
            for (int q = 0; q < 4; ++q) { const int idx = q * 64 + F.lane; const float cv = F.c[(idx >> 6) * D + kp * 64 + (idx & 63)]; scr[idx] = cv / (1.f + __expf(-cv)); }
            LDS_WAIT(); asm volatile("" ::: "memory");
#pragma unroll 2
            for (int k0 = 0; k0 < 64; k0 += 32) { f32x4 w[32];
#pragma unroll
                for (int kk = 0; kk < 32; ++kk) w[kk] = __builtin_nontemporal_load((const f32x4*)(F.w_ada + (size_t)(kp * 64 + k0 + kk) * NADA + n));
#pragma unroll
                for (int kk = 0; kk < 32; ++kk) { a0 += w[kk] * scr[k0 + kk]; a1 += w[kk] * scr[64 + k0 + kk]; a2 += w[kk] * scr[128 + k0 + kk]; a3 += w[kk] * scr[192 + k0 + kk]; } }
            LDS_WAIT(); asm volatile("" ::: "memory");
            float* P = (float*)(F.ws + WS_ADAP) + (size_t)kp * 4 * NADA + n;
            *(f32x4*)(P) = a0; *(f32x4*)(P + NADA) = a1; *(f32x4*)(P + 2 * NADA) = a2; *(f32x4*)(P + 3 * NADA) = a3;
            continue; }
        r -= I_ADA;
        if (r < I_IN) { const int kb = r / (NPROJ / 64), nb = r % (NPROJ / 64); p0_tr_item(F.w_in, LDW_IN, 64 * kb, 64 * nb, WIN + (size_t)(64 * nb) * D + 64 * kb, D, nullptr, scr, F.lane); continue; }
        r -= I_IN;
        if (r < I_OUT) { const int kb = r / (D / 64), nb = r % (D / 64); const int k0 = 64 * kb;
            p0_tr_item(F.w_out, D, k0, 64 * nb, WOUT + (size_t)(64 * nb) * D + (k0 < DH ? k0 + DH : k0 - DH), D, k0 < DH ? F.g_osgu : F.g_ofox - DH, scr, F.lane); continue; }
        r -= I_OUT;
        { bf16* WSM = (bf16*)(F.ws + WS_WSM);
#pragma unroll
          for (int j = 0; j < 8; ++j) { const int idx = r * 512 + j * 64 + F.lane; const int tt = (idx >> 7) & 127, ss = idx & 127; const float v = F.w_sp[idx]; WSM[idx] = (bf16)f2bf(ss <= tt ? v : 0.f); } }
    }
}

__device__ __forceinline__ void p3_convert(Frame& F) {
    int lane = lane_id_fresh();
    LAS float* scr = (LAS float*)(F.lds + RING_OFF + F.wave * 16896);
    bf16* WGU = (bf16*)(F.ws + WS_WGU); bf16* WD = (bf16*)(F.ws + WS_WD);
    constexpr int I_GU1 = (D / 64) * (DEXP / 64), I_GU = NEXP * 2 * I_GU1, I_DC1 = (DEXP / 64) * (D / 64), I_DC = NEXP * I_DC1, NIT = I_GU + I_DC;
    const int s = F.vcu & 7; const int cnt8 = s == 0 ? 50 : s == 1 ? 35 : s == 2 ? 28 : s == 7 ? 15 : 16; const int pre8 = s == 0 ? 0 : s == 1 ? 50 : s == 2 ? 85 : 113 + 16 * (s - 3);
    static_assert(NIT == 32 * 192, "item split");
    const int lo = (F.vcu >> 3) * 192 + pre8;
    __syncthreads();
    for (int it = lo + F.wave; it < lo + cnt8; it += NWAVES) {
        int r = it;
        if (r < I_GU) { const int e = r / (2 * I_GU1), r2 = r % (2 * I_GU1), isup = r2 / I_GU1, r3 = r2 % I_GU1; const int kb = r3 / (DEXP / 64), nb = r3 % (DEXP / 64); const int n0 = 64 * nb;
            const float* W = (isup ? F.w_up : F.w_gate) + (size_t)e * D * DEXP; const int drow = (n0 >> 7) * 256 + isup * 128 + (n0 & 127);
#if MOE_FP8
            p0_tr_item8(W, DEXP, 64 * kb, n0, (unsigned char*)WGU + ((size_t)e * 1024 + drow) * D + 64 * kb, D, 64.f, scr, lane); continue; }
#else
            p0_tr_item(W, DEXP, 64 * kb, n0, WGU + ((size_t)e * 1024 + drow) * D + 64 * kb, D, nullptr, scr, lane); continue; }
#endif
        r -= I_GU;
        if (r < I_DC) { const int e = r / I_DC1, r3 = r % I_DC1; const int kb = r3 / (D / 64), nb = r3 % (D / 64);
#if MOE_FP8
            p0_tr_item8(F.w_down + (size_t)e * DEXP * D, D, 64 * kb, 64 * nb, (unsigned char*)WD + ((size_t)e * D + 64 * nb) * DEXP + 64 * kb, DEXP, 64.f, scr, lane); continue; }
#else
            p0_tr_item(F.w_down + (size_t)e * DEXP * D, D, 64 * kb, 64 * nb, WD + ((size_t)e * D + 64 * nb) * DEXP + 64 * kb, DEXP, nullptr, scr, lane); continue; }
#endif
    }
    __syncthreads();
}
__device__ __forceinline__ void p1_load(Frame& F, f32x4 (&v)[2][4], int ch, int rl) {
#pragma unroll
    for (int rr = 0; rr < 2; ++rr) { const f32x4* xr = (const f32x4*)(F.x + (size_t)(ch * 128 + rl + 8 * rr) * D) + F.lane;
#pragma unroll
        for (int j = 0; j < 4; ++j) v[rr][j] = __builtin_nontemporal_load(xr + 64 * j); }
}
__device__ __forceinline__ void p1_rows(Frame& F, f32x4 (&v)[2][4], int ch, int rl, const LAS float* modA, const LAS float* modB, const LAS float* wf, LAS float* gi, bf16* XN) {
            float s[2] = {0.f, 0.f};
#pragma unroll
            for (int rr = 0; rr < 2; ++rr)
#pragma unroll
                for (int j = 0; j < 4; ++j) s[rr] += (v[rr][j].x * v[rr][j].x + v[rr][j].y * v[rr][j].y) + (v[rr][j].z * v[rr][j].z + v[rr][j].w * v[rr][j].w);
#pragma unroll
            for (int rr = 0; rr < 2; ++rr) { const int m = ch * 128 + rl + 8 * rr;
                const float rstd = 1.f / sqrtf(wave_sum(s[rr]) * (1.f / D) + EPS);
                float fl[8];
#pragma unroll
                for (int q = 0; q < 8; ++q) fl[q] = 0.f;
                unsigned long long* o8 = (unsigned long long*)(XN + (size_t)m * D) + F.lane;
#pragma unroll
                for (int j = 0; j < 4; ++j) { const int k0 = 4 * F.lane + 256 * j; float h[4];
#pragma unroll
                    for (int e = 0; e < 4; ++e) { h[e] = v[rr][j][e] * rstd * modA[k0 + e] + modB[k0 + e];
#pragma unroll
                        for (int q = 0; q < 8; ++q) fl[q] += h[e] * wf[q * D + k0 + e]; }
                    o8[64 * j] = (unsigned long long)pk2(h[0], h[1]) | ((unsigned long long)pk2(h[2], h[3]) << 32); }
                float r0, r1; wave_sum8_t(fl, F.lane, r0, r1);
                if (F.lane < 4) { const int q0 = 4 * (F.lane & 1) + 2 * (F.lane >> 1);
#pragma unroll
                    for (int e = 0; e < 2; ++e) { const float z = (e ? r1 : r0) + F.b_fg[q0 + e];
                        const float sp = fmaxf(-z, 0.f) + log1pf(expf(-fabsf(z)));
                        gi[(rl + 8 * rr) * 8 + q0 + e] = sp * LOG2E; } } }
}
__device__ __forceinline__ void p1_prenorm(Frame& F) {
    const float* ADAP = (const float*)(F.ws + WS_ADAP); float* ADA = (float*)(F.ws + WS_ADA);
    for (int i = blockIdx.x * (NWAVES * 64) + F.tid; i < BATCH * NADA; i += F.G * NWAVES * 64) { float s = F.b_ada[i % NADA];
#pragma unroll
        for (int p = 0; p < 16; ++p) s += ADAP[(size_t)p * BATCH * NADA + i];
        ADA[i] = s; }
    LAS float* modA = (LAS float*)(F.lds);
    LAS float* modB = modA + 1024;
    LAS float* wf = modB + 1024;
    LAS float* gi = wf + 8192;
    bf16* XN = (bf16*)(F.ws + WS_XN); float* LC = (float*)(F.ws + WS_LC); float* CT = (float*)(F.ws + WS_CT);
    for (int ch = blockIdx.x; ch < M / 128; ch += F.G) {
        const int b = ch / (T / 128);
        __syncthreads();
        for (int k = F.tid; k < D; k += NWAVES * 64) { float sh = F.b_ada[k], sc = F.b_ada[D + k];
#pragma unroll
            for (int p = 0; p < 16; ++p) { sh += ADAP[((size_t)p * BATCH + b) * NADA + k]; sc += ADAP[((size_t)p * BATCH + b) * NADA + D + k]; }
            modA[k] = F.g_mix[k] * (1.f + sc); modB[k] = sh; }
        for (int i = F.tid; i < D * 8; i += NWAVES * 64) wf[(i & 7) * D + (i >> 3)] = F.w_in[(size_t)(i >> 3) * LDW_IN + NPROJ + (i & 7)];
        __syncthreads();
        { f32x4 va[2][4], vb[2][4];
            p1_load(F, va, ch, F.wave);
#pragma unroll 1
            for (int it = 0; it < 4; ++it) {
                p1_load(F, vb, ch, F.wave + 16 * (2 * it + 1));
                p1_rows(F, va, ch, F.wave + 16 * (2 * it), modA, modB, wf, gi, XN);
                if (it < 3) p1_load(F, va, ch, F.wave + 16 * (2 * it + 2));
                p1_rows(F, vb, ch, F.wave + 16 * (2 * it + 1), modA, modB, wf, gi, XN);
            } }
        __syncthreads();
        { const int h = F.wave; float* lc = LC + ((size_t)b * NH + h) * T + (ch % (T / 128)) * 128;
            const float a0 = gi[(2 * F.lane) * 8 + h], a1 = gi[(2 * F.lane + 1) * 8 + h]; float sc = a0 + a1;
#pragma unroll
            for (int o = 1; o < 64; o <<= 1) { const float t = __shfl_up(sc, o); if (F.lane >= o) sc += t; }
            lc[2 * F.lane] = sc - a1; lc[2 * F.lane + 1] = sc;
            if (F.lane == 63) CT[((size_t)b * NH + h) * (T / 128) + (ch % (T / 128))] = sc; }
    }
    __syncthreads();
}

__device__ __forceinline__ void p3_sgu_naive(Frame& F) {
    const bf16* U = (const bf16*)(F.ws + WS_U); const bf16* VS = U + (size_t)M * DH; const bf16* WSM = (const bf16*)(F.ws + WS_WSM);
    bf16* Y = (bf16*)(F.ws + WS_Y); float* SSQY = (float*)(F.ws + WS_SSQY);
    LAS bf16* vn = (LAS bf16*)(F.lds);
    const int h = F.wave, c = F.tid;
    for (int ch = blockIdx.x; ch < M / 128; ch += F.G) {
        __syncthreads();
        const float gs = F.g_sgu[h * 64 + F.lane];
        for (int s = 0; s < 128; ++s) { const size_t m = (size_t)ch * 128 + s; const float val = bf2f(VS[m * DH + c]); const float q = wave_sum(val * val);
            vn[s * DH + c] = (bf16)f2bf(val * (1.f / sqrtf(q * (1.f / 64.f) + EPS)) * gs); }
        __syncthreads();
        for (int t = 0; t < 128; ++t) { float z = F.b_sp[h * 128 + t]; const bf16* wrow = WSM + ((size_t)h * 128 + t) * 128;
            for (int s = 0; s <= t; ++s) z += bf2f(wrow[s]) * bf2f(vn[s * DH + c]);
            const size_t m = (size_t)ch * 128 + t; const float y = bf2f(U[m * DH + c]) * z;
            Y[m * D + DH + c] = (bf16)f2bf(y); const float q = wave_sum(y * y); if (F.lane == 0) SSQY[m * 16 + h] = q; }
    }
    __syncthreads();
}
__device__ __forceinline__ void p3_sgu(Frame& F) {
    typedef short s16x4_t __attribute__((ext_vector_type(4))); typedef float f32x16_t __attribute__((ext_vector_type(16)));
    const bf16* U = (const bf16*)(F.ws + WS_U); const bf16* VS = U + (size_t)M * DH; const bf16* WSM = (const bf16*)(F.ws + WS_WSM);
    bf16* Y = (bf16*)(F.ws + WS_Y); float* SSQY = (float*)(F.ws + WS_SSQY);
    constexpr int RS = 144;
    const int h = F.wave, lane = F.lane, c8 = lane & 7, kg = lane >> 5, t32 = lane & 31;
    LAS unsigned char* vreg = F.lds + h * (128 * RS);
    LAS float* bsl = (LAS float*)(F.lds + 8 * 128 * RS) + h * 128;
    float gsc[8];
#pragma unroll
    for (int e = 0; e < 8; ++e) gsc[e] = F.g_sgu[h * 64 + c8 * 8 + e];
    const int trb = (8 * (lane >> 5) + ((lane & 15) >> 2)) * RS + (16 * ((lane >> 4) & 1) + 4 * (lane & 3)) * 2;
    for (int ch = blockIdx.x; ch < M / 128; ch += F.G) {
        const size_t row0 = (size_t)ch * 128;
        asm volatile("s_waitcnt lgkmcnt(0)" ::: "memory");
        uint4 pre[16];
#pragma unroll
        for (int it = 0; it < 16; ++it) pre[it] = nt_load((const uint4*)(VS + (row0 + it * 8 + (lane >> 3)) * DH + h * 64 + c8 * 8));
#pragma unroll
        for (int it = 0; it < 16; ++it) { const int r = it * 8 + (lane >> 3); const uint4 w = pre[it]; const unsigned ww[4] = {w.x, w.y, w.z, w.w};
            float v[8]; float q = 0.f;
#pragma unroll
            for (int e = 0; e < 4; ++e) { v[2 * e] = __uint_as_float(ww[e] << 16); v[2 * e + 1] = __uint_as_float(ww[e] & 0xffff0000u); q += v[2 * e] * v[2 * e] + v[2 * e + 1] * v[2 * e + 1]; }
            q = DPP_ADD(q, 0xB1); q = DPP_ADD(q, 0x4E); q = DPP_ADD(q, 0x141);
            const float rstd = 1.f / sqrtf(q * (1.f / 64.f) + EPS);
            v4u o; o.x = pk2(v[0] * rstd * gsc[0], v[1] * rstd * gsc[1]); o.y = pk2(v[2] * rstd * gsc[2], v[3] * rstd * gsc[3]); o.z = pk2(v[4] * rstd * gsc[4], v[5] * rstd * gsc[5]); o.w = pk2(v[6] * rstd * gsc[6], v[7] * rstd * gsc[7]);
            *(LAS v4u*)(vreg + r * RS + c8 * 16) = o; }
        bsl[lane] = F.b_sp[h * 128 + lane]; bsl[lane + 64] = F.b_sp[h * 128 + 64 + lane];
        asm volatile("s_waitcnt lgkmcnt(0)" ::: "memory");
        f32x16_t acc[4][2];
#pragma unroll
        for (int tb = 0; tb < 4; ++tb) { acc[tb][0] = f32x16_t{}; acc[tb][1] = f32x16_t{}; }
#pragma unroll
        for (int tb = 0; tb < 4; ++tb)
#pragma unroll
            for (int ks = 0; ks < 2 * tb + 2; ++ks) {
                const bf16x8 a = *(const bf16x8*)(WSM + ((size_t)(h * 128 + 32 * tb + t32)) * 128 + 16 * ks + 8 * kg);
#pragma unroll
                for (int db = 0; db < 2; ++db) {
                    const s16x4_t lo = __builtin_bit_cast(s16x4_t, __builtin_amdgcn_ds_read_tr16_b64_v4i16((LAS s16x4_t*)(vreg + trb + (16 * ks) * RS + db * 64)));
                    const s16x4_t hi = __builtin_bit_cast(s16x4_t, __builtin_amdgcn_ds_read_tr16_b64_v4i16((LAS s16x4_t*)(vreg + trb + (16 * ks + 4) * RS + db * 64)));
                    const bf16x8 bfr = {lo[0], lo[1], lo[2], lo[3], hi[0], hi[1], hi[2], hi[3]};
                    acc[tb][db] = __builtin_amdgcn_mfma_f32_32x32x16_bf16(a, bfr, acc[tb][db], 0, 0, 0); } }
        asm volatile("s_waitcnt lgkmcnt(0)" ::: "memory");
#pragma unroll
        for (int tb = 0; tb < 4; ++tb)
#pragma unroll
            for (int db = 0; db < 2; ++db)
#pragma unroll
                for (int r = 0; r < 16; ++r) { const int t = 32 * tb + (r & 3) + 8 * (r >> 2) + 4 * kg;
                    *(LAS unsigned short*)(vreg + t * RS + (32 * db + t32) * 2) = (unsigned short)f2bf(acc[tb][db][r] + bsl[t]); }
        asm volatile("s_waitcnt lgkmcnt(0)" ::: "memory");
#pragma unroll
        for (int it = 0; it < 16; ++it) pre[it] = nt_load((const uint4*)(U + (row0 + it * 8 + (lane >> 3)) * DH + h * 64 + c8 * 8));
#pragma unroll
        for (int it = 0; it < 16; ++it) { const int r = it * 8 + (lane >> 3); const v4u zz = *(const LAS v4u*)(vreg + r * RS + c8 * 16); const uint4 uu = pre[it];
            const unsigned zw[4] = {zz.x, zz.y, zz.z, zz.w}, uw[4] = {uu.x, uu.y, uu.z, uu.w}; unsigned ow[4]; float q = 0.f;
#pragma unroll
            for (int e = 0; e < 4; ++e) { const float y0 = __uint_as_float(zw[e] << 16) * __uint_as_float(uw[e] << 16), y1 = __uint_as_float(zw[e] & 0xffff0000u) * __uint_as_float(uw[e] & 0xffff0000u);
                q += y0 * y0 + y1 * y1; ow[e] = pk2(y0, y1); }
            q = DPP_ADD(q, 0xB1); q = DPP_ADD(q, 0x4E); q = DPP_ADD(q, 0x141);
            v4u o; o.x = ow[0]; o.y = ow[1]; o.z = ow[2]; o.w = ow[3];
            *(v4u*)(Y + (row0 + r) * D + DH + h * 64 + c8 * 8) = o;
            if (c8 == 0) SSQY[(row0 + r) * 16 + h] = q; }
    }
    asm volatile("s_waitcnt lgkmcnt(0)" ::: "memory");
    __syncthreads();
}
__device__ __forceinline__ void p3_attn_naive(Frame& F) {
    const bf16* Q = (const bf16*)(F.ws + WS_U) + (size_t)2 * M * DH; const bf16* K = Q + (size_t)M * DH; const bf16* V = K + (size_t)M * DH;
    const float* LC = (const float*)(F.ws + WS_LC); const float* CT = (const float*)(F.ws + WS_CT);
    bf16* Y = (bf16*)(F.ws + WS_Y); float* SSQY = (float*)(F.ws + WS_SSQY);
    LAS float* Gabs = (LAS float*)(F.lds);
    LAS float* pre = Gabs + T;
    for (int item = blockIdx.x; item < BATCH * NH * 8; item += F.G) {
        const int bh = item >> 3, r = item & 7, b = bh / NH, h = bh % NH;
        __syncthreads();
        if (F.tid < 64) { float a = 0.f; for (int c2 = 0; c2 < F.tid; ++c2) a += CT[bh * 64 + c2]; pre[F.tid] = a; }
        __syncthreads();
        for (int t = F.tid; t < T; t += NWAVES * 64) Gabs[t] = pre[t >> 7] + LC[(size_t)bh * T + t];
        __syncthreads();
        for (int n = F.wave; n < T / 8; n += NWAVES) {
            const int i = 8 * n + r; const size_t rowi = (size_t)b * T + i;
            float qf[64];
            { const uint4* q4 = (const uint4*)(Q + rowi * DH + h * HD);
#pragma unroll
              for (int c4 = 0; c4 < 8; ++c4) { const uint4 w = q4[c4]; const unsigned ww[4] = {w.x, w.y, w.z, w.w};
#pragma unroll
                  for (int e = 0; e < 4; ++e) { qf[c4 * 8 + 2 * e] = __uint_as_float(ww[e] << 16); qf[c4 * 8 + 2 * e + 1] = __uint_as_float(ww[e] & 0xffff0000u); } } }
            const float Gi = Gabs[i];
            float mx = -1e30f, l = 0.f; float o[64];
#pragma unroll
            for (int d = 0; d < 64; ++d) o[d] = 0.f;
            for (int j = F.lane; j <= i; j += 64) {
                const size_t rowj = (size_t)b * T + j; const uint4* k4 = (const uint4*)(K + rowj * DH + h * HD); const uint4* v4 = (const uint4*)(V + rowj * DH + h * HD);
                float s = 0.f;
#pragma unroll
                for (int c4 = 0; c4 < 8; ++c4) { const uint4 w = k4[c4]; const unsigned ww[4] = {w.x, w.y, w.z, w.w};
#pragma unroll
                    for (int e = 0; e < 4; ++e) { s += qf[c4 * 8 + 2 * e] * __uint_as_float(ww[e] << 16); s += qf[c4 * 8 + 2 * e + 1] * __uint_as_float(ww[e] & 0xffff0000u); } }
                s += Gabs[j] - Gi;
                if (s > mx) { const float f = __builtin_amdgcn_exp2f(mx - s); l *= f;
#pragma unroll
                    for (int d = 0; d < 64; ++d) o[d] *= f;
                    mx = s; }
                const float p = __builtin_amdgcn_exp2f(s - mx); l += p;
#pragma unroll
                for (int c4 = 0; c4 < 8; ++c4) { const uint4 w = v4[c4]; const unsigned ww[4] = {w.x, w.y, w.z, w.w};
#pragma unroll
                    for (int e = 0; e < 4; ++e) { o[c4 * 8 + 2 * e] += p * __uint_as_float(ww[e] << 16); o[c4 * 8 + 2 * e + 1] += p * __uint_as_float(ww[e] & 0xffff0000u); } }
            }
            const float Mx = wave_max(mx); const float f = __builtin_amdgcn_exp2f(mx - Mx); l *= f; const float L = wave_sum(l);
            float y = 0.f;
#pragma unroll
            for (int d = 0; d < 64; ++d) { const float od = wave_sum(o[d] * f); y = (F.lane == d) ? od : y; }
            y = y / L;
            Y[rowi * D + h * HD + F.lane] = (bf16)f2bf(y);
            const float q = wave_sum(y * y); if (F.lane == 0) SSQY[rowi * 16 + 8 + h] = q;
        }
    }
    __syncthreads();
}
__device__ __forceinline__ void p2_kx(Frame& F) {
    const float* LC = (const float*)(F.ws + WS_LC); const float* CT = (const float*)(F.ws + WS_CT);
    unsigned long long* KX8 = (unsigned long long*)(F.ws + WS_KX8); float* GF = (float*)(F.ws + WS_GF);
    const int gw = F.vcu * NWAVES + F.wave, NGW = F.G * NWAVES;
    for (int pr = gw; pr < BATCH * NH * (T / 128); pr += NGW) { const int bh = pr >> 6, ch = pr & 63;
        const float base = wave_sum(F.lane < ch ? CT[bh * 64 + F.lane] : 0.f);
#pragma unroll
        for (int e = 0; e < 2; ++e) { const size_t t = (size_t)bh * T + ch * 128 + e * 64 + F.lane; const float G = base + LC[t];
            const unsigned gh = f2bf(G); const float r1 = G - __uint_as_float(gh << 16); const unsigned gm = f2bf(r1); const float r2 = r1 - __uint_as_float(gm << 16); const unsigned gl = f2bf(r2);
            KX8[t] = (unsigned long long)(gh | (gm << 16)) | ((unsigned long long)(gl | (0x3F80u << 16)) << 32); GF[t] = G; } }
}
__device__ __forceinline__ void p6_load(Frame& F, f32x4 (&xv)[2][4], uint2 (&mv)[2][4], const bf16* MIX, int mrow) {
#pragma unroll
    for (int rr = 0; rr < 2; ++rr) { const size_t m = (size_t)mrow + rr; const f32x4* xr = (const f32x4*)(F.x + m * D) + F.lane; const uint2* mr = (const uint2*)(MIX + m * D) + F.lane;
#pragma unroll
        for (int j = 0; j < 4; ++j) { xv[rr][j] = __builtin_nontemporal_load(xr + 64 * j); mv[rr][j] = nt_load(mr + 64 * j); } }
}
__device__ __forceinline__ void p6_rows(Frame& F, f32x4 (&xv)[2][4], uint2 (&mv)[2][4], int m0, int r0, int RPW, const f32x4 (&cg1)[4], const f32x4 (&cA)[4], const f32x4 (&cB)[4],
                                        const LAS float* wrg, const LAS float* wre, LAS unsigned* lcnt, LAS unsigned* rinfo, bf16* H2, bf16* X1, float* TW) {
#pragma unroll
        for (int rr = 0; rr < 2; ++rr) { const int m = m0 + r0 + rr; float s = 0.f;
#pragma unroll
            for (int j = 0; j < 4; ++j) { f32x4 mx; mx[0] = __uint_as_float(mv[rr][j].x << 16); mx[1] = __uint_as_float(mv[rr][j].x & 0xffff0000u); mx[2] = __uint_as_float(mv[rr][j].y << 16); mx[3] = __uint_as_float(mv[rr][j].y & 0xffff0000u);
                xv[rr][j] = xv[rr][j] + cg1[j] * mx;
                ((unsigned long long*)(X1 + (size_t)m * D) + F.lane)[64 * j] = (unsigned long long)pk2(xv[rr][j].x, xv[rr][j].y) | ((unsigned long long)pk2(xv[rr][j].z, xv[rr][j].w) << 32);
                s += (xv[rr][j].x * xv[rr][j].x + xv[rr][j].y * xv[rr][j].y) + (xv[rr][j].z * xv[rr][j].z + xv[rr][j].w * xv[rr][j].w); }
            const float rstd = 1.f / sqrtf(wave_sum(s) * (1.f / D) + EPS);
            float lg[4] = {0.f, 0.f, 0.f, 0.f};
#if MOE_FP8
            int* o4 = (int*)((unsigned char*)H2 + (size_t)m * D) + F.lane;
#else
            unsigned long long* o8 = (unsigned long long*)(H2 + (size_t)m * D) + F.lane;
#endif
#pragma unroll
            for (int j = 0; j < 4; ++j) { const int k0 = 4 * F.lane + 256 * j; xv[rr][j] = xv[rr][j] * rstd * cA[j] + cB[j];
#if MOE_FP8
                { int p = 0; p = __builtin_amdgcn_cvt_pk_fp8_f32(__builtin_amdgcn_fmed3f(xv[rr][j].x, -448.f, 448.f), __builtin_amdgcn_fmed3f(xv[rr][j].y, -448.f, 448.f), p, false);
                  p = __builtin_amdgcn_cvt_pk_fp8_f32(__builtin_amdgcn_fmed3f(xv[rr][j].z, -448.f, 448.f), __builtin_amdgcn_fmed3f(xv[rr][j].w, -448.f, 448.f), p, true); o4[64 * j] = p; }
#else
                o8[64 * j] = (unsigned long long)pk2(xv[rr][j].x, xv[rr][j].y) | ((unsigned long long)pk2(xv[rr][j].z, xv[rr][j].w) << 32);
#endif
#pragma unroll
                for (int q = 0; q < 4; ++q) { const f32x4 w = *(const LAS f32x4*)(wrg + q * D + k0); lg[q] += (xv[rr][j].x * w.x + xv[rr][j].y * w.y) + (xv[rr][j].z * w.z + xv[rr][j].w * w.w); } }
            wave_sum4_all(lg, F.lane);
#pragma unroll
            for (int q = 0; q < 4; ++q) lg[q] += F.b_rg[q];
            int gs = 0; float best = lg[0];
#pragma unroll
            for (int q = 1; q < 4; ++q) if (lg[q] > best) { best = lg[q]; gs = q; }
            float den = 0.f;
#pragma unroll
            for (int q = 0; q < 4; ++q) den += expf(lg[q] - best);
            const float psel = 1.f / den;
            gs = __builtin_amdgcn_readfirstlane(gs);
            float le[4] = {0.f, 0.f, 0.f, 0.f}; const LAS float* wg = wre + gs * 4 * D;
#pragma unroll
            for (int j = 0; j < 4; ++j) { const int k0 = 4 * F.lane + 256 * j;
#pragma unroll
                for (int q = 0; q < 4; ++q) { const f32x4 w = *(const LAS f32x4*)(wg + q * D + k0); le[q] += (xv[rr][j].x * w.x + xv[rr][j].y * w.y) + (xv[rr][j].z * w.z + xv[rr][j].w * w.w); } }
            wave_sum4_all(le, F.lane);
#pragma unroll
            for (int q = 0; q < 4; ++q) le[q] += F.b_re[gs * 4 + q];
            int i0 = 0; float v0 = le[0];
#pragma unroll
            for (int q = 1; q < 4; ++q) if (le[q] > v0) { v0 = le[q]; i0 = q; }
            int i1 = -1; float v1 = -INFINITY;
#pragma unroll
            for (int q = 0; q < 4; ++q) if (q != i0 && le[q] > v1) { v1 = le[q]; i1 = q; }
            const float e1 = expf(v1 - v0); const float w0 = psel / (1.f + e1), w1 = psel * e1 / (1.f + e1);
            const int ea = i0 < i1 ? i0 : i1, eb = i0 < i1 ? i1 : i0; const float wa = i0 < i1 ? w0 : w1, wb = i0 < i1 ? w1 : w0;
            const int pair = ea == 0 ? eb - 1 : (ea == 1 ? eb + 1 : 5); const int cls = gs * 6 + pair;
            if (F.lane == 0) { TW[(size_t)m * 2] = wa; TW[(size_t)m * 2 + 1] = wb;
                const unsigned lr = __hip_atomic_fetch_add(lcnt + cls, 1u, __ATOMIC_RELAXED, __HIP_MEMORY_SCOPE_WORKGROUP);
                rinfo[F.wave * RPW + r0 + rr] = (unsigned)cls | (lr << 8); }
        }
}
__device__ __forceinline__ void p6_route(Frame& F) {
    const float* ADA = (const float*)(F.ws + WS_ADA); const bf16* MIX = (const bf16*)(F.ws + WS_MIX);
    bf16* H2 = (bf16*)(F.ws + WS_H2); bf16* X1 = (bf16*)(F.ws + WS_X1); int* INV = (int*)(F.ws + WS_INV); float* TW = (float*)(F.ws + WS_TW);
    LAS float* wrg = (LAS float*)(F.lds);
    LAS float* wre = wrg + 4 * D;
    LAS unsigned* lcnt = (LAS unsigned*)(wre + 16 * D);
    LAS unsigned* rinfo = lcnt + 32;
    __syncthreads();
    if (F.tid < 32) lcnt[F.tid] = 0u;
    for (int i = F.tid; i < 4 * D; i += NWAVES * 64) wrg[(i & 3) * D + (i >> 2)] = F.w_rg[i];
    for (int i = F.tid; i < 16 * D; i += NWAVES * 64) { const int g = i / (4 * D), r = i % (4 * D); wre[g * 4 * D + (r & 3) * D + (r >> 2)] = F.w_re[i]; }
    __syncthreads();
    const int gw = F.vcu * NWAVES + F.wave, NGW = F.G * NWAVES; const int RPW = M / NGW;
    const int m0 = gw * RPW; const int b = m0 / T;
    f32x4 cg1[4], cA[4], cB[4];
#pragma unroll
    for (int j = 0; j < 4; ++j) { const int k0 = 4 * F.lane + 256 * j; cg1[j] = *(const f32x4*)(ADA + (size_t)b * NADA + 2 * D + k0);
        const f32x4 g = *(const f32x4*)(F.g_ffn + k0), sc = *(const f32x4*)(ADA + (size_t)b * NADA + 4 * D + k0); cA[j] = g * (1.f + sc); cB[j] = *(const f32x4*)(ADA + (size_t)b * NADA + 3 * D + k0); }
    { f32x4 xa[2][4], xb[2][4]; uint2 ma[2][4], mb[2][4];
        p6_load(F, xa, ma, MIX, m0);
#pragma unroll 1
        for (int r0 = 0; r0 < RPW; r0 += 4) {
            p6_load(F, xb, mb, MIX, m0 + r0 + 2);
            p6_rows(F, xa, ma, m0, r0, RPW, cg1, cA, cB, wrg, wre, lcnt, rinfo, H2, X1, TW);
            if (r0 + 4 < RPW) p6_load(F, xa, ma, MIX, m0 + r0 + 4);
            p6_rows(F, xb, mb, m0, r0 + 2, RPW, cg1, cA, cB, wrg, wre, lcnt, rinfo, H2, X1, TW);
        } }
    __syncthreads();
    if (F.tid < NCLS) { const unsigned n = lcnt[F.tid]; lcnt[F.tid] = n ? __hip_atomic_fetch_add((unsigned*)(F.ctl + CW_CNT + F.tid * CNT_STRIDE), n, __ATOMIC_RELAXED, __HIP_MEMORY_SCOPE_AGENT) : 0u; }
    __syncthreads();
    for (int i = F.tid; i < NWAVES * RPW; i += NWAVES * 64) { const unsigned ri = rinfo[i]; const int cls = (int)(ri & 255u);
        INV[(size_t)cls * M + lcnt[cls] + (ri >> 8)] = (F.vcu * NWAVES + i / RPW) * RPW + i % RPW; }
    __syncthreads();
}
__device__ __forceinline__ void moe_tables(Frame& F) {
    LAS unsigned* lcnt = (LAS unsigned*)(F.lds + LCNT_OFF);
    __syncthreads();
    if (F.tid < NCLS) lcnt[F.tid] = __hip_atomic_load(F.ctl + CW_CNT + F.tid * CNT_STRIDE, RLX_AGENT);
    __syncthreads();
    if (F.tid == 0) { LAS unsigned char* tcls = F.lds + TCLS_OFF; LAS unsigned char* tfirst = F.lds + TFIRST_OFF; int nt = 0;
        for (int c = 0; c < NCLS; ++c) { const int n = ((int)lcnt[c] + 255) >> 8; tfirst[c] = (unsigned char)nt; for (int k = 0; k < n && nt < MAXTILES; ++k) tcls[nt++] = (unsigned char)c; }
        F.MISC[16] = (unsigned)nt; }
    __syncthreads();
}
template <class Order> __device__ __forceinline__ void moe_fill_up(Frame& F, const Order& S) {
    const int* INV = (const int*)(F.ws + WS_INV); const float* TW = (const float*)(F.ws + WS_TW); LAS unsigned* toku = (LAS unsigned*)(F.lds + TOKU_OFF); LAS unsigned* tokw = (LAS unsigned*)(F.lds + TOKW_OFF);
    for (int i = 0; i < 5; ++i) { pg8::Unit u; if (!S.next(i, u)) break;
        if (F.tid < 256) { const int rank = u.rank0 + F.tid; int tok = 0; unsigned wp = 0u;
            if (rank < u.cnt) { tok = INV[(size_t)u.cls * M + rank]; wp = pk2(TW[(size_t)tok * 2], TW[(size_t)tok * 2 + 1]); }
            toku[i * 256 + F.tid] = (unsigned)tok * (unsigned)(D * MOE_ESZ); tokw[i * 256 + F.tid] = wp; } }
    __syncthreads();
}
template <class Order> __device__ __forceinline__ void moe_fill_down(Frame& F, const Order& S) {
    const int* INV = (const int*)(F.ws + WS_INV); LAS int* tokd = (LAS int*)(F.lds + TOKU_OFF);
    for (int i = 0; i < 5; ++i) { pg8::Unit u; if (!S.next(i, u)) break;
        if (F.tid < 256) { const int rank = u.rank0 + F.tid; tokd[i * 256 + F.tid] = rank < u.cnt ? INV[(size_t)u.cls * M + rank] : -1; } }
    __syncthreads();
}
__device__ __forceinline__ void p10_final(Frame& F) {
    const float* ADA = (const float*)(F.ws + WS_ADA); const bf16* X1 = (const bf16*)(F.ws + WS_X1); const bf16* MOE = (const bf16*)(F.ws + WS_MOE);
    const int gw = F.vcu * NWAVES + F.wave, NGW = F.G * NWAVES; const int RPW = M / NGW; const int m0 = gw * RPW; const int b = m0 / T;
    f32x4 cg2[4], cgf[4];
#pragma unroll
    for (int j = 0; j < 4; ++j) { const int k0 = 4 * F.lane + 256 * j; cg2[j] = *(const f32x4*)(ADA + (size_t)b * NADA + 5 * D + k0); cgf[j] = *(const f32x4*)(F.g_fin + k0); }
    for (int r0 = 0; r0 < RPW; r0 += 4) {
        uint2 mv[4][4], ev[4][4];
#pragma unroll
        for (int rr = 0; rr < 4; ++rr) { const size_t m = (size_t)m0 + r0 + rr; const uint2* mr = (const uint2*)(X1 + m * D) + F.lane; const uint2* er = (const uint2*)(MOE + m * D) + F.lane;
#pragma unroll
            for (int j = 0; j < 4; ++j) { mv[rr][j] = nt_load(mr + 64 * j); ev[rr][j] = nt_load(er + 64 * j); } }
#pragma unroll
        for (int rr = 0; rr < 4; ++rr) { const size_t m = (size_t)m0 + r0 + rr; float s = 0.f; f32x4 xv[4];
#pragma unroll
            for (int j = 0; j < 4; ++j) { f32x4 mx, ex; mx[0] = __uint_as_float(mv[rr][j].x << 16); mx[1] = __uint_as_float(mv[rr][j].x & 0xffff0000u); mx[2] = __uint_as_float(mv[rr][j].y << 16); mx[3] = __uint_as_float(mv[rr][j].y & 0xffff0000u);
                ex[0] = __uint_as_float(ev[rr][j].x << 16); ex[1] = __uint_as_float(ev[rr][j].x & 0xffff0000u); ex[2] = __uint_as_float(ev[rr][j].y << 16); ex[3] = __uint_as_float(ev[rr][j].y & 0xffff0000u);
                xv[j] = mx + cg2[j] * ex; s += (xv[j].x * xv[j].x + xv[j].y * xv[j].y) + (xv[j].z * xv[j].z + xv[j].w * xv[j].w); }
            const float rstd = 1.f / sqrtf(wave_sum(s) * (1.f / D) + EPS);
            f32x4* orow = (f32x4*)(F.out + m * D) + F.lane;
#pragma unroll
            for (int j = 0; j < 4; ++j) __builtin_nontemporal_store(xv[j] * rstd * cgf[j], orow + 64 * j); }
    }
}

#define REFRESH() do { F.lane = lane_id_fresh(); F.tid = F.wave * 64 + F.lane; } while (0)
struct Args { const float* in[22]; float* out; unsigned char* ws; int ph_lo, ph_hi; };
__global__ void __launch_bounds__(NWAVES * 64, 2) mk_fwd(Args args) {
    extern __shared__ __attribute__((aligned(16))) unsigned char lds[];
    Frame F;
    F.lds = (LAS unsigned char*)lds;
    F.MISC = (volatile LAS unsigned*)(F.lds + MISC_OFF);
    F.tid = threadIdx.x; F.lane = F.tid & 63; F.wave = __builtin_amdgcn_readfirstlane(F.tid >> 6);
    F.G = gridDim.x; { const int bx = blockIdx.x; F.vcu = (F.G % 8 == 0) ? (bx % 8) * (F.G / 8) + bx / 8 : bx; }
    F.ws = args.ws; F.ctl = (gu32*)(args.ws + WS_CTL); F.out = args.out;
    F.x = args.in[0]; F.c = args.in[1]; F.w_ada = args.in[2]; F.b_ada = args.in[3]; F.g_mix = args.in[4]; F.w_in = args.in[5]; F.g_sgu = args.in[6]; F.w_sp = args.in[7]; F.b_sp = args.in[8]; F.b_fg = args.in[9];
    F.g_osgu = args.in[10]; F.g_ofox = args.in[11]; F.w_out = args.in[12]; F.g_ffn = args.in[13]; F.w_rg = args.in[14]; F.b_rg = args.in[15]; F.w_re = args.in[16]; F.b_re = args.in[17];
    F.w_gate = args.in[18]; F.w_up = args.in[19]; F.w_down = args.in[20]; F.g_fin = args.in[21];
    for (int u = F.tid; u < (LDS_BYTES - LDSCTL_OFF) / 4; u += NWAVES * 64) ((LAS unsigned*)(F.lds + LDSCTL_OFF))[u] = 0u;
    __syncthreads();
    XcdBarrier bar; bar.bar = (unsigned*)(F.ctl + CW_BAR); bar.x = 0; bar.st = nullptr;
    if (N_LAUNCHES == 1) bar = xcd_barrier_post((unsigned*)(F.ctl + CW_BAR), F.MISC + 8);
#define GRID_BAR() do { if (N_LAUNCHES == 1) xcd_barrier(bar); } while (0)
#if PROBE_MASK
#define PROBE_BEGIN(k) do { if (((PROBE_MASK) >> (k)) & 1) { if (blockIdx.x == 0 && F.tid == 0) F.MISC[22] = (unsigned)rt(); } } while (0)
#define PROBE_END(k) do { if (((PROBE_MASK) >> (k)) & 1) { if (blockIdx.x == 0 && F.tid == 0) F.MISC[20] = F.MISC[20] + ((unsigned)rt() - F.MISC[22]); } } while (0)
#else
#define PROBE_BEGIN(k) do {} while (0)
#define PROBE_END(k) do {} while (0)
#endif
    const int lo = args.ph_lo, hi = args.ph_hi;
#define IN(k) (lo <= (k) && (k) < hi)
#define BOTH(k) (IN(k) && IN((k) + 1))
    bf16* const XN = (bf16*)(F.ws + WS_XN); bf16* const U = (bf16*)(F.ws + WS_U); bf16* const Y = (bf16*)(F.ws + WS_Y);
    float* const ADA = (float*)(F.ws + WS_ADA);

    if (IN(0)) { PROBE_BEGIN(0); p0_prologue(F); if (BOTH(0)) GRID_BAR(); PROBE_END(0); }
    if (IN(1)) { REFRESH(); PROBE_BEGIN(1); p1_prenorm(F); if (BOTH(1)) GRID_BAR(); PROBE_END(1); }
    if (IN(2)) { REFRESH(); PROBE_BEGIN(2);
        p2_kx(F);
        pg8::Gemm g{XN, (const bf16*)(F.ws + WS_WIN), D, D, D, 127, 127}; pg8::StaticOrder S; S.init(M, NPROJ, D, D, F.G, (int)blockIdx.x);
        pg8::EpiProj E{U, (unsigned*)(F.ctl + CW_QKB)};
        pg8::gemm_phase<pg8::EpiProj, pg8::StaticOrder, true, true>(F.lds + RING_OFF, g, S, E, F.tid);
        if (BOTH(2)) GRID_BAR(); PROBE_END(2);
    }
    if (IN(3)) { REFRESH(); PROBE_BEGIN(3);
        PROBE_BEGIN(4);
#if NAIVE_SGU
        p3_sgu_naive(F);
#else
        p3_sgu(F);
#endif
        PROBE_END(4);
#if NAIVE_ATTN
        p3_attn_naive(F);
#else
        static_assert(attn_body::LDS_BYTES <= RING_BYTES, "attention LDS map");
        { const attn_body::bf16* Qp = (const attn_body::bf16*)(F.ws + WS_U) + (size_t)2 * M * DH;
          const attn_body::AttnTensors AT{Qp, Qp + (size_t)M * DH, Qp + (size_t)2 * M * DH, (attn_body::bf16*)(F.ws + WS_Y), (const unsigned long long*)(F.ws + WS_KX8), (const float*)(F.ws + WS_GF), (const float*)(F.ctl + CW_QKB), (float*)(F.ws + WS_SSQY)};
          const attn_body::StaticOrder S((int)F.G, (int)blockIdx.x);
          attn_body::AttnUnit u;
          for (int i = 0; S.next(i, u); ++i) {
              if (i == ((F.vcu >> 1) & 3)) p3_convert(F);
              attn_body::attn_unit<8>(u.bh / attn_body::NHEAD, u.bh % attn_body::NHEAD, u.qb, AT.Q, AT.K, AT.V, AT.O, AT.KX8, AT.GF, AT.QKB, AT.SSQ, (char*)lds + RING_OFF, F.tid); } }
#endif
        if (IN(3) && IN(5)) GRID_BAR(); PROBE_END(3); }
    if (IN(5)) { REFRESH(); PROBE_BEGIN(5);
        pg8::Gemm g{Y, (const bf16*)(F.ws + WS_WOUT), D, D, D, 127, 127}; pg8::StaticOrder S; S.init(M, D, D, D, F.G, (int)blockIdx.x);
        { const float* SSQY = (const float*)(F.ws + WS_SSQY); LAS float* rsr = (LAS float*)(F.lds + TOKU_OFF);
          __syncthreads();
          for (int i = 0; i < 4; ++i) { pg8::Unit u; if (!S.next(i, u)) break;
              if (F.tid < 256) { const f32x4* p = (const f32x4*)(SSQY + (size_t)(u.pm * 256 + F.tid) * 16); const f32x4 s0 = p[0], s1 = p[1], f0 = p[2], f1 = p[3];
                  const float a = ((s0[0] + s0[1]) + (s0[2] + s0[3])) + ((s1[0] + s1[1]) + (s1[2] + s1[3])), c = ((f0[0] + f0[1]) + (f0[2] + f0[3])) + ((f1[0] + f1[1]) + (f1[2] + f1[3]));
                  const float rs = 1.f / sqrtf(a * (1.f / 512.f) + EPS), rf = 1.f / sqrtf(c * (1.f / 512.f) + EPS); rsr[(i * 256 + F.tid) * 2] = rs; rsr[(i * 256 + F.tid) * 2 + 1] = rf / rs; } }
          __syncthreads(); }
        pg8::EpiMix E{(bf16*)(F.ws + WS_MIX), (const LAS float*)(F.lds + TOKU_OFF)};
        pg8::gemm_phase<pg8::EpiMix, pg8::StaticOrder, true, true>(F.lds + RING_OFF, g, S, E, F.tid);
        if (BOTH(5)) GRID_BAR(); PROBE_END(5);
    }
    if (IN(6)) { REFRESH(); PROBE_BEGIN(6); p6_route(F); if (IN(6) && IN(8)) GRID_BAR(); PROBE_END(6); }
    if (IN(8)) { REFRESH(); PROBE_BEGIN(8);
        moe_tables(F);
        pg8::Gemm g{(const bf16*)(F.ws + WS_H2), (const bf16*)(F.ws + WS_WGU), D * MOE_ESZ / 2, D * MOE_ESZ / 2, D * MOE_ESZ / 2, 127, 121};
        pg8::MoeUpOrder S{F.G, (int)blockIdx.x, (int)F.MISC[16], F.lds + TCLS_OFF, F.lds + TFIRST_OFF, (const LAS unsigned*)(F.lds + LCNT_OFF), (const LAS unsigned*)(F.lds + TOKU_OFF)};
        moe_fill_up(F, S);
        pg8::EpiUp E{(bf16*)(F.ws + WS_ACT), (const LAS unsigned*)(F.lds + TOKW_OFF)};
        pg8::gemm_phase<pg8::EpiUp, pg8::MoeUpOrder, true, true, MOE_FP8 != 0>(F.lds + RING_OFF, g, S, E, F.tid);
        if (BOTH(8)) GRID_BAR(); PROBE_END(8);
    }
    if (IN(9)) { REFRESH(); PROBE_BEGIN(9);
        if (!IN(8)) moe_tables(F);
        pg8::Gemm g{(const bf16*)(F.ws + WS_ACT), (const bf16*)(F.ws + WS_WD), D * MOE_ESZ / 2, DEXP * MOE_ESZ / 2, D * MOE_ESZ / 2, 125, 121};
        pg8::MoeDownOrder S{F.G, (int)blockIdx.x, (int)F.MISC[16], F.lds + TCLS_OFF, F.lds + TFIRST_OFF, (const LAS unsigned*)(F.lds + LCNT_OFF)};
        moe_fill_down(F, S);
        pg8::EpiDown E{(bf16*)(F.ws + WS_MOE), (const LAS int*)(F.lds + TOKU_OFF)};
        pg8::gemm_phase<pg8::EpiDown, pg8::MoeDownOrder, true, true, MOE_FP8 != 0>(F.lds + RING_OFF, g, S, E, F.tid);
        if (BOTH(9)) GRID_BAR(); PROBE_END(9);
    }
    if (IN(10)) { REFRESH(); PROBE_BEGIN(10); p10_final(F); PROBE_END(10); }
#if PROBE_MASK
    if (blockIdx.x == 0 && F.tid == 0) { const unsigned long long t0 = rt(); const unsigned long long w = (unsigned long long)F.MISC[20] * (PROBE_MULT); while (rt() - t0 < w) __builtin_amdgcn_s_sleep(32); }
#endif
#undef IN
#undef BOTH
}

extern "C" void kernel_launch(void* const* d_in, const int* in_sizes, int n_in, void* d_out, int out_size, void* d_ws, size_t ws_size, hipStream_t stream) {
    static int grid = 0;
    if (grid == 0) {
        if (n_in != 22 || in_sizes[0] != M * D || out_size != M * D || ws_size < WS_END) { fprintf(stderr, "kernel_launch: unexpected shapes (n_in %d, in0 %d, out %d, ws %zu); nothing launched\n", n_in, n_in > 0 ? in_sizes[0] : -1, out_size, ws_size); grid = -1; return; }
        int dev = 0, cus = 0, per_cu = 0;
        if (hipGetDevice(&dev) != hipSuccess || hipDeviceGetAttribute(&cus, hipDeviceAttributeMultiprocessorCount, dev) != hipSuccess) { fprintf(stderr, "kernel_launch: device query failed\n"); grid = -1; return; }
        if (hipFuncSetAttribute((const void*)mk_fwd, hipFuncAttributeMaxDynamicSharedMemorySize, LDS_BYTES) != hipSuccess) { fprintf(stderr, "kernel_launch: hipFuncSetAttribute failed\n"); grid = -1; return; }
        if (hipOccupancyMaxActiveBlocksPerMultiprocessor(&per_cu, (const void*)mk_fwd, NWAVES * 64, LDS_BYTES) != hipSuccess || per_cu < 1) { fprintf(stderr, "kernel_launch: occupancy query reports %d workgroups per CU\n", per_cu); (void)hipGetLastError(); grid = -1; return; }
        grid = cus;
        if (grid != 256) { fprintf(stderr, "kernel_launch: built for a 256-CU device (static unit orders), found %d CUs; nothing launched\n", cus); grid = -1; return; }
    }
    if (grid < 0) return;
    if (hipMemsetAsync((char*)d_ws + WS_CTL, 0, CTL_ZERO_BYTES, stream) != hipSuccess) { fprintf(stderr, "kernel_launch: hipMemsetAsync failed\n"); return; }
    Args a{};
    for (int i = 0; i < 22; ++i) a.in[i] = (const float*)d_in[i];
    a.out = (float*)d_out; a.ws = (unsigned char*)d_ws;
    if (N_LAUNCHES == 1) {
        a.ph_lo = 0; a.ph_hi = N_PHASES;
        void* kargs[] = {&a};
        const hipError_t le = hipLaunchCooperativeKernel((const void*)mk_fwd, dim3(grid), dim3(NWAVES * 64), kargs, LDS_BYTES, stream);
        if (le != hipSuccess) fprintf(stderr, "kernel_launch: cooperative launch failed: %s (grid %d)\n", hipGetErrorName(le), grid);
    } else {
        for (int li = 0; li < N_PHASES; ++li) { a.ph_lo = li; a.ph_hi = li + 1;
            hipLaunchKernelGGL(mk_fwd, dim3(grid), dim3(NWAVES * 64), LDS_BYTES, stream, a);
            const hipError_t le = hipPeekAtLastError();
            if (le != hipSuccess) { fprintf(stderr, "kernel_launch: launch %d failed: %s\n", li, hipGetErrorName(le)); break; } }
    }
}
```
